# Optimizing an MI355X kernel written in HIP

```python
import math
import jax, jax.numpy as jnp
from jax import lax
import numpy as np

D_MODEL = 1024
BATCH = 8
SEQ = 4096
DEPTH = 1

GRID_W = 64
ATT_HEADS = 8
ATT_KV_HEADS = 2
ATT_HEAD_DIM = 64
ATT_WIDTH = ATT_HEADS * ATT_HEAD_DIM
ATT_KV_WIDTH = ATT_KV_HEADS * ATT_HEAD_DIM
Q_BLOCK = 128
ROPE_THETA = 10000.0
HG_HEADS = 4
HG_DK = 128
HG_DV = 128
HG_WIDTH_K = HG_HEADS * HG_DK
HG_WIDTH_V = HG_HEADS * HG_DV
HG_CHUNK = 64
N_BRANCH = 2
IN_SPLITS = (ATT_WIDTH, ATT_KV_WIDTH, ATT_KV_WIDTH,
             HG_WIDTH_K, HG_WIDTH_K, HG_WIDTH_K, HG_WIDTH_V, HG_WIDTH_V,
             N_BRANCH * D_MODEL)
IN_WIDTH = sum(IN_SPLITS)
PEER_HEADS = 8
PEER_NKEYS = 128
PEER_N_EXPERTS = PEER_NKEYS * PEER_NKEYS
PEER_DKEY = 256
PEER_TOPK = 16
PEER_TOKEN_BLOCK = 128
PLE_DIM = 256
EPS = 1e-6

kernel_name = "hybrid_gqa_hgrn2_peer_encoder_block"


def rmsnorm(x, g):
    xf = x.astype(jnp.float32)
    y = xf * lax.rsqrt(jnp.mean(xf * xf, axis=-1, keepdims=True) + EPS)
    return (y * g.astype(jnp.float32)).astype(x.dtype)


def axial_rope_tables(seq_len):
    rows = seq_len // GRID_W
    row = jnp.repeat(jnp.arange(rows), GRID_W).astype(jnp.float32)
    col = jnp.tile(jnp.arange(GRID_W), rows).astype(jnp.float32)
    axis_dim = ATT_HEAD_DIM // 2
    rot_half = axis_dim // 2
    inv = ROPE_THETA ** (-jnp.arange(rot_half, dtype=jnp.float32) / rot_half)
    ang = jnp.stack([row[:, None] * inv, col[:, None] * inv], axis=1)
    return jnp.cos(ang), jnp.sin(ang)


def apply_axial_rope(x, cos, sin):
    B, S, H, hd = x.shape
    xr = x.reshape(B, S, H, 2, 2, hd // 4).astype(jnp.float32)
    x1, x2 = xr[..., 0, :], xr[..., 1, :]
    c = cos[None, :, None]
    s = sin[None, :, None]
    out = jnp.stack([x1 * c - x2 * s, x1 * s + x2 * c], axis=-2)
    return out.reshape(B, S, H, hd).astype(x.dtype)


def gqa_attention(q, k, v):
    B, S = q.shape[:2]
    G = ATT_HEADS // ATT_KV_HEADS
    nb = S // Q_BLOCK
    scale = ATT_HEAD_DIM ** -0.5
    qb = q.reshape(B, nb, Q_BLOCK, ATT_KV_HEADS, G, ATT_HEAD_DIM).transpose(1, 0, 2, 3, 4, 5)

    def one_block(qblk):
        s = jnp.einsum('bqkgd,bskd->bkgqs', qblk, k, preferred_element_type=jnp.float32) * scale
        pr = jax.nn.softmax(s, axis=-1)
        return jnp.einsum('bkgqs,bskd->bqkgd', pr.astype(v.dtype), v)

    o = lax.map(one_block, qb)
    return o.transpose(1, 0, 2, 3, 4, 5).reshape(B, S, ATT_WIDTH)


def gla_chunk_scan(q, k, v, log_f):
    B, S, H, dk = q.shape
    dv = v.shape[-1]
    C = HG_CHUNK
    nc = S // C

    def to_chunks(a):
        return a.reshape(B, nc, C, H, a.shape[-1]).transpose(1, 0, 3, 2, 4)

    qc, kc, vc, gc = to_chunks(q), to_chunks(k), to_chunks(v), to_chunks(log_f)
    lower = jnp.tril(jnp.ones((C, C), dtype=bool))[:, :, None]

    def step(state, inp):
        qi, ki, vi, gi = inp
        b = jnp.cumsum(gi.astype(jnp.float32), axis=2)
        diff = b[:, :, :, None, :] - b[:, :, None, :, :]
        decay = jnp.exp(jnp.where(lower, diff, -jnp.inf))
        A = jnp.einsum('bhtd,bhsd,bhtsd->bhts', qi.astype(jnp.float32), ki.astype(jnp.float32), decay)
        o_intra = jnp.einsum('bhts,bhse->bhte', A, vi.astype(jnp.float32))
        o_inter = jnp.einsum('bhtd,bhde->bhte', qi.astype(jnp.float32) * jnp.exp(b), state)
        b_last = b[:, :, -1:, :]
        k_dec = ki.astype(jnp.float32) * jnp.exp(b_last - b)
        new_state = state * jnp.exp(b_last[:, :, 0, :])[..., None] + \
            jnp.einsum('bhsd,bhse->bhde', k_dec, vi.astype(jnp.float32))
        return new_state, o_intra + o_inter

    state0 = jnp.zeros((B, H, dk, dv), jnp.float32)
    _, o = lax.scan(step, state0, (qc, kc, vc, gc))
    return o.transpose(1, 0, 3, 2, 4).reshape(B, S, H, dv)


def hgrn2_bidirectional(hq, hf_f, hf_b, hi, hg, lb, out_norm):
    B, S = hq.shape[:2]
    q = jax.nn.silu(hq).reshape(B, S, HG_HEADS, HG_DK)
    i_in = hi.reshape(B, S, HG_HEADS, HG_DV)

    def gates(fpre, lbd):
        f = lbd + (1.0 - lbd) * jax.nn.sigmoid(fpre.astype(jnp.float32))
        f = f.reshape(B, S, HG_HEADS, HG_DK)
        return 1.0 - f, jnp.log(f)

    k_f, lf_f = gates(hf_f, lb[0])
    k_b, lf_b = gates(hf_b, lb[1])
    o_fwd = gla_chunk_scan(q, k_f, i_in, lf_f)
    flip = lambda a: jnp.flip(a, axis=1)
    o_bwd = flip(gla_chunk_scan(flip(q), flip(k_b), flip(i_in), flip(lf_b)))
    o = rmsnorm(o_fwd + o_bwd, out_norm)
    o = o * jax.nn.silu(hg.astype(jnp.float32).reshape(B, S, HG_HEADS, HG_DV))
    return o.reshape(B, S, HG_WIDTH_V).astype(hq.dtype)


def peer_ffn(h, w_q, sub_keys, u, v):
    B, S, D = h.shape
    T = B * S
    K = PEER_TOPK
    ht = h.reshape(T, D)
    q = (ht @ w_q).reshape(T, PEER_HEADS, 2, PEER_DKEY // 2)
    s = jnp.einsum('thpc,hpnc->thpn', q, sub_keys, preferred_element_type=jnp.float32)
    v1, i1 = lax.top_k(s[:, :, 0], K)
    v2, i2 = lax.top_k(s[:, :, 1], K)
    cand = (v1[..., :, None] + v2[..., None, :]).reshape(T, PEER_HEADS, K * K)
    cand_idx = (i1[..., :, None] * PEER_NKEYS + i2[..., None, :]).reshape(T, PEER_HEADS, K * K)
    top_s, pos = lax.top_k(cand, K)
    idx = jnp.take_along_axis(cand_idx, pos, axis=-1)
    g = jax.nn.softmax(top_s, axis=-1)
    nb = T // PEER_TOKEN_BLOCK

    def one_block(args):
        xb, ib, gb = args
        ue = jnp.take(u, ib, axis=0)
        a = jnp.einsum('thkd,td->thk', ue, xb, preferred_element_type=jnp.float32)
        w = jax.nn.gelu(a) * gb
        ve = jnp.take(v, ib, axis=0)
        return jnp.einsum('thk,thkd->td', w.astype(ve.dtype), ve)

    out = lax.map(one_block, (ht.reshape(nb, PEER_TOKEN_BLOCK, D),
                              idx.reshape(nb, PEER_TOKEN_BLOCK, PEER_HEADS, K),
                              g.reshape(nb, PEER_TOKEN_BLOCK, PEER_HEADS, K)))
    return out.reshape(B, S, D).astype(h.dtype)


def setup_inputs(seed: int = 0) -> dict:
    key = jax.random.key(seed)
    ks = jax.random.split(key, 24)
    f32 = jnp.float32
    nrm = lambda k, shape, scale: jax.random.normal(k, shape, f32) * scale
    gain = lambda k, shape: 1.0 + 0.02 * jax.random.normal(k, shape, f32)
    return {
        "x": nrm(ks[0], (BATCH, SEQ, D_MODEL), 1.0),
        "p": nrm(ks[1], (DEPTH, BATCH, SEQ, PLE_DIM), 1.0),
        "norm_mix": gain(ks[2], (DEPTH, D_MODEL)),
        "w_in": nrm(ks[3], (DEPTH, D_MODEL, IN_WIDTH), D_MODEL ** -0.5),
        "q_norm": gain(ks[4], (DEPTH, ATT_HEAD_DIM)),
        "k_norm": gain(ks[5], (DEPTH, ATT_HEAD_DIM)),
        "hg_lb_raw": nrm(ks[6], (DEPTH + 1, 2, HG_WIDTH_K), 0.1),
        "hg_out_norm": gain(ks[7], (DEPTH, HG_DV)),
        "w_up_att": nrm(ks[8], (DEPTH, ATT_WIDTH, D_MODEL), ATT_WIDTH ** -0.5),
        "w_up_hg": nrm(ks[9], (DEPTH, HG_WIDTH_V, D_MODEL), HG_WIDTH_V ** -0.5),
        "w_out": nrm(ks[10], (DEPTH, D_MODEL, D_MODEL), D_MODEL ** -0.5),
        "norm_ffn": gain(ks[11], (DEPTH, D_MODEL)),
        "peer_wq": nrm(ks[12], (DEPTH, D_MODEL, PEER_HEADS * PEER_DKEY), D_MODEL ** -0.5),
        "peer_subkeys": nrm(ks[13], (DEPTH, PEER_HEADS, 2, PEER_NKEYS, PEER_DKEY // 2), (PEER_DKEY // 2) ** -0.5),
        "peer_u": nrm(ks[14], (DEPTH, PEER_N_EXPERTS, D_MODEL), D_MODEL ** -0.5),
        "peer_v": nrm(ks[15], (DEPTH, PEER_N_EXPERTS, D_MODEL), 0.3),
        "norm_ple": gain(ks[16], (DEPTH, D_MODEL)),
        "ple_gate": nrm(ks[17], (DEPTH, D_MODEL, D_MODEL), D_MODEL ** -0.5),
        "ple_proj": nrm(ks[18], (DEPTH, PLE_DIM, D_MODEL), PLE_DIM ** -0.5),
    }


def reference(x, p, norm_mix, w_in, q_norm, k_norm, hg_lb_raw, hg_out_norm, w_up_att, w_up_hg,
              w_out, norm_ffn, peer_wq, peer_subkeys, peer_u, peer_v, norm_ple, ple_gate, ple_proj):
    B, S, D = x.shape
    cos, sin = axial_rope_tables(S)
    lb_all = jnp.cumsum(jax.nn.softmax(hg_lb_raw.astype(jnp.float32), axis=0), axis=0)
    offsets = [int(o) for o in np.cumsum(IN_SPLITS)[:-1]]
    for i in range(DEPTH):
        h = rmsnorm(x, norm_mix[i])
        proj = h @ w_in[i]
        aq, ak, av, hq, hf_f, hf_b, hi, hg, gate_pre = jnp.split(proj, offsets, axis=-1)
        q = rmsnorm(aq.reshape(B, S, ATT_HEADS, ATT_HEAD_DIM), q_norm[i])
        k = rmsnorm(ak.reshape(B, S, ATT_KV_HEADS, ATT_HEAD_DIM), k_norm[i])
        v = av.reshape(B, S, ATT_KV_HEADS, ATT_HEAD_DIM)
        q = apply_axial_rope(q, cos, sin)
        k = apply_axial_rope(k, cos, sin)
        y_att = gqa_attention(q, k, v) @ w_up_att[i]
        y_hg = hgrn2_bidirectional(hq, hf_f, hf_b, hi, hg, lb_all[i], hg_out_norm[i]) @ w_up_hg[i]
        gts = jax.nn.sigmoid(gate_pre.astype(jnp.float32)).reshape(B, S, N_BRANCH, D)
        merged = (gts[:, :, 0] * y_att + gts[:, :, 1] * y_hg).astype(x.dtype)
        x = x + merged @ w_out[i]
        x = x + peer_ffn(rmsnorm(x, norm_ffn[i]), peer_wq[i], peer_subkeys[i], peer_u[i], peer_v[i])
        g_ple = jax.nn.sigmoid(rmsnorm(x, norm_ple[i]) @ ple_gate[i])
        x = x + g_ple * (p[i] @ ple_proj[i])
    return x
```

```cpp
#include <hip/hip_runtime.h>
#include <cstdio>
#include <cstdint>
namespace pg8 {
#define PG8_LAS __attribute__((address_space(3)))
typedef unsigned short bf16_t;
typedef short bf16x8 __attribute__((ext_vector_type(8)));
typedef float f32x4 __attribute__((ext_vector_type(4)));
typedef unsigned u32x4 __attribute__((ext_vector_type(4)));
typedef unsigned u32x2 __attribute__((ext_vector_type(2)));
constexpr int BM = 256, BK = 64, HALF = 128, HTB = HALF * BK * 2  , STAGE_BYTES = 8 * HTB, NXCD = 8, WGM = 8;

__host__ __device__ __forceinline__ int lds_byte(int r, int c) { const int st = (r >> 4) * 2 + (c >> 5), rr = r & 15, cc = c & 31, ob = rr * 64 + cc * 2; return st * 1024 + (ob ^ (((ob >> 9) & 1) << 5)); }
__host__ __device__ __forceinline__ void stage_rc(int b, int& R, int& C) { const int st = b / 1024, sb = b % 1024, swz = sb ^ (((sb >> 9) & 1) << 5); R = (st >> 1) * 16 + swz / 64; C = (st & 1) * 32 + (swz % 64) / 2; }
__host__ __device__ __forceinline__ int perm32(int rho) { const int n = rho >> 4, i = rho & 15; return 8 * (i >> 2) + 4 * n + (i & 3); }

struct Unit { int pm, pn; };
struct Gemm { const bf16_t* A; const bf16_t* Bt; int M, N, K, lda, ldb; };

struct StaticOrder {
    int nM, nN, nwg, G, c;
    __host__ __device__ void init(int M, int N, int G_, int c_) { nM = M / BM; nN = N / BM; nwg = nM * nN; G = G_; c = c_; }
    __host__ __device__ bool next(int i, Unit& u) const {
        const long L = (long)i * G + c; if (L >= nwg) return false;
        int wgid = (int)L; { const int q = nwg / NXCD, r = nwg % NXCD, xcd = wgid % NXCD, off = wgid / NXCD; wgid = (xcd < r ? xcd * (q + 1) : r * (q + 1) + (xcd - r) * q) + off; }
        const int nig = WGM * nN, gid = wgid / nig, fm = gid * WGM, gsz = (nM - fm) < WGM ? (nM - fm) : WGM;
        u.pm = fm + ((wgid % nig) % gsz); u.pn = (wgid % nig) / gsz; return true;
    }
    __device__ __forceinline__ void a_ready(const Unit&) const {}
    __device__ __forceinline__ void done(const Unit&) const {}
};
struct OneUnit {
    Unit u;
    __device__ __forceinline__ bool next(int i, Unit& o) const { if (i != 0) return false; o = u; return true; }
    __device__ __forceinline__ void a_ready(const Unit&) const {}
    __device__ __forceinline__ void done(const Unit&) const {}
};

__device__ __forceinline__ unsigned cvt_pk_bf16(float lo, float hi) { unsigned r; asm volatile("v_cvt_pk_bf16_f32 %0, %1, %2" : "=v"(r) : "v"(lo), "v"(hi)); return r; }
__device__ __forceinline__ float bf_lo(unsigned w) { return __uint_as_float(w << 16); }
__device__ __forceinline__ float bf_hi(unsigned w) { return __uint_as_float(w & 0xffff0000u); }
__device__ __forceinline__ float sigmoidf_(float x) { return __builtin_amdgcn_rcpf(1.0f + __builtin_amdgcn_exp2f(-1.4426950408889634f * x)); }


template <class Epi, class Sched, bool ALIGN_EPI = false, bool SP2 = false>
__device__ __forceinline__ void gemm_phase(PG8_LAS unsigned char* lds, const Gemm g, const Sched& S, const Epi& E) {
    int tid_ = threadIdx.x; asm volatile("" : "+v"(tid_));
    const int tid = tid_, wid = __builtin_amdgcn_readfirstlane(tid >> 6), lane = tid & 63, wr = wid >> 2, wc = wid & 3, fr = lane & 15, fq = lane >> 4;
    int K_ = g.K; asm volatile("" : "+s"(K_));
    const int K = K_, nt = K / BK;
    unsigned voffA[2], voffB[2];
#pragma unroll
    for (int i = 0; i < 2; ++i) { int R, C; stage_rc(tid * 16 + i * 8192, R, C); const int Rb = Epi::PERM ? ((R & ~31) + perm32(R & 31)) : R;
        voffA[i] = (unsigned)(R * g.lda + C) * 2u; voffB[i] = (unsigned)(Rb * g.ldb + C) * 2u; }
    const size_t kstep = (size_t)(BK * 2);
    const size_t hstepA = (size_t)HALF * g.lda * 2, hstepB = (size_t)HALF * g.ldb * 2;
    const size_t tstepA = 2 * hstepA, tstepB = 2 * hstepB;
    const unsigned ldsw = (unsigned)wid * 1024u;
    const int aoff = lds_byte(wr * 64 + fr, fq * 8), boff = lds_byte(wc * 32 + fr, fq * 8);
#define PG8_SA(b, h) (((b) * 2 + (h)) * HTB)
#define PG8_SB(b, h) ((4 + (b) * 2 + (h)) * HTB)
#define PG8_STAGE(bufoff, gbase, voff) do { _Pragma("unroll") for (int _i = 0; _i < 2; ++_i) \
        __builtin_amdgcn_global_load_lds((const unsigned*)((const char*)(gbase) + (voff)[_i]), (PG8_LAS unsigned*)(lds + (bufoff) + ldsw + _i * 8192), 16, 0, 0); } while (0)
#define PG8_LDA(dst, b, h) do { _Pragma("unroll") for (int m = 0; m < 4; ++m) _Pragma("unroll") for (int k = 0; k < 2; ++k) dst[m][k] = *(const PG8_LAS bf16x8*)(lds + PG8_SA(b, h) + aoff + m * 2048 + k * 1024); } while (0)
#define PG8_LDB(dst, b, h) do { _Pragma("unroll") for (int n = 0; n < 2; ++n) _Pragma("unroll") for (int k = 0; k < 2; ++k) dst[n][k] = *(const PG8_LAS bf16x8*)(lds + PG8_SB(b, h) + boff + n * 2048 + k * 1024); } while (0)
#define PG8_MMA(ai, bj, At, Bt) do { __builtin_amdgcn_s_setprio(1); _Pragma("unroll") for (int m = 0; m < 4; ++m) _Pragma("unroll") for (int n = 0; n < 2; ++n) _Pragma("unroll") for (int k = 0; k < 2; ++k) \
        acc[ai][bj][m][n] = __builtin_amdgcn_mfma_f32_16x16x32_bf16(Bt[n][k], At[m][k], acc[ai][bj][m][n], 0, 0, 0); __builtin_amdgcn_s_setprio(0); } while (0)
#define PG8_WAIT_V(n) asm volatile("s_waitcnt vmcnt(" #n ")" ::: "memory")
#define PG8_WAIT_L(n) asm volatile("s_waitcnt lgkmcnt(" #n ")" ::: "memory")
#define PG8_BAR __builtin_amdgcn_s_barrier()
#define PG8_SCHED __builtin_amdgcn_sched_barrier(0)
    Unit cur, nxt; int ui = 0;
    if (!S.next(0, cur)) return;
    f32x4 acc[2][2][4][2];
#pragma unroll
    for (int a = 0; a < 2; ++a)
#pragma unroll
        for (int b = 0; b < 2; ++b)
#pragma unroll
            for (int m = 0; m < 4; ++m)
#pragma unroll
                for (int n = 0; n < 2; ++n) acc[a][b][m][n] = (f32x4){0.f, 0.f, 0.f, 0.f};
    bf16x8 At[4][2], B0[2][2], B1[2][2];
    const char* cA = (const char*)g.A + (size_t)cur.pm * tstepA; const char* cB = (const char*)g.Bt + (size_t)cur.pn * tstepB;
    S.a_ready(cur);
    if constexpr (SP2) {
        PG8_STAGE(PG8_SB(0, 0), cB, voffB); PG8_STAGE(PG8_SB(0, 1), cB + hstepB, voffB); PG8_STAGE(PG8_SA(0, 0), cA, voffA); PG8_STAGE(PG8_SA(0, 1), cA + hstepA, voffA);
        if (wr == 1) PG8_BAR;
        PG8_WAIT_V(2); PG8_BAR;
        PG8_STAGE(PG8_SB(1, 0), cB + kstep, voffB); PG8_STAGE(PG8_SA(1, 0), cA + kstep, voffA); PG8_STAGE(PG8_SB(1, 1), cB + hstepB + kstep, voffB);
        PG8_WAIT_V(6); PG8_BAR;
    } else {
        PG8_STAGE(PG8_SB(0, 0), cB, voffB); PG8_STAGE(PG8_SA(0, 0), cA, voffA); PG8_STAGE(PG8_SB(0, 1), cB + hstepB, voffB); PG8_STAGE(PG8_SA(0, 1), cA + hstepA, voffA);
        if (wr == 1) PG8_BAR;
        PG8_WAIT_V(4); PG8_BAR;
        PG8_STAGE(PG8_SB(1, 0), cB + kstep, voffB); PG8_STAGE(PG8_SA(1, 0), cA + kstep, voffA); PG8_STAGE(PG8_SB(1, 1), cB + hstepB + kstep, voffB);
        PG8_WAIT_V(6); PG8_BAR;
    }
    for (;;) {
        const bool has_next = S.next(ui + 1, nxt);
        const char* nA = has_next ? (const char*)g.A + (size_t)nxt.pm * tstepA : cA; const char* nB = has_next ? (const char*)g.Bt + (size_t)nxt.pn * tstepB : cB;
        for (int t = 0; t < nt; t += 2) {
            const bool last = (t == nt - 2);
            const char* a1 = cA + (size_t)(t + 1) * kstep;
            const char* a2 = last ? nA : cA + (size_t)(t + 2) * kstep; const char* b2 = last ? nB : cB + (size_t)(t + 2) * kstep;
            const char* a3 = a2 + kstep; const char* b3 = b2 + kstep;
            if (last && has_next) S.a_ready(nxt);
            if constexpr (SP2) {
            PG8_LDB(B0, 0, 0); PG8_LDB(B1, 0, 1); PG8_SCHED; PG8_LDA(At, 0, 0); PG8_STAGE(PG8_SA(1, 1), a1 + hstepA, voffA);
            PG8_WAIT_V(8); PG8_WAIT_L(0); PG8_BAR; PG8_MMA(0, 0, At, B0); PG8_MMA(0, 1, At, B1); PG8_BAR; PG8_SCHED;
            PG8_LDA(At, 0, 1); PG8_STAGE(PG8_SB(0, 0), b2, voffB); PG8_STAGE(PG8_SB(0, 1), b2 + hstepB, voffB); PG8_STAGE(PG8_SA(0, 0), a2, voffA);
            PG8_WAIT_V(8); PG8_WAIT_L(0); PG8_BAR; PG8_MMA(1, 0, At, B0); PG8_MMA(1, 1, At, B1); PG8_BAR; PG8_SCHED;
            PG8_LDB(B0, 1, 0); PG8_LDB(B1, 1, 1); PG8_SCHED; PG8_LDA(At, 1, 0); PG8_STAGE(PG8_SA(0, 1), a2 + hstepA, voffA);
            PG8_WAIT_V(8); PG8_WAIT_L(0); PG8_BAR; PG8_MMA(0, 0, At, B0); PG8_MMA(0, 1, At, B1); PG8_BAR; PG8_SCHED;
            PG8_LDA(At, 1, 1); PG8_STAGE(PG8_SB(1, 0), b3, voffB); PG8_STAGE(PG8_SB(1, 1), b3 + hstepB, voffB); PG8_STAGE(PG8_SA(1, 0), a3, voffA);
            PG8_WAIT_V(8); PG8_WAIT_L(0); PG8_BAR; PG8_MMA(1, 0, At, B0); PG8_MMA(1, 1, At, B1); PG8_BAR; PG8_SCHED;
            } else {
            PG8_LDB(B0, 0, 0); PG8_SCHED; PG8_LDA(At, 0, 0); PG8_STAGE(PG8_SA(1, 1), a1 + hstepA, voffA);
            PG8_WAIT_L(8); PG8_BAR; PG8_WAIT_L(0); PG8_MMA(0, 0, At, B0); PG8_BAR; PG8_SCHED;
            PG8_LDB(B1, 0, 1); PG8_STAGE(PG8_SB(0, 0), b2, voffB);
            PG8_BAR; PG8_WAIT_L(0); PG8_MMA(0, 1, At, B1); PG8_BAR;
            PG8_LDA(At, 0, 1); PG8_STAGE(PG8_SA(0, 0), a2, voffA);
            PG8_BAR; PG8_WAIT_L(0); PG8_MMA(1, 0, At, B0); PG8_BAR; PG8_SCHED;
            PG8_STAGE(PG8_SB(0, 1), b2 + hstepB, voffB);
            PG8_WAIT_V(6); PG8_BAR; PG8_MMA(1, 1, At, B1); PG8_BAR;
            PG8_LDB(B0, 1, 0); PG8_SCHED; PG8_LDA(At, 1, 0); PG8_STAGE(PG8_SA(0, 1), a2 + hstepA, voffA);
            PG8_WAIT_L(8); PG8_BAR; PG8_WAIT_L(0); PG8_MMA(0, 0, At, B0); PG8_BAR; PG8_SCHED;
            PG8_LDB(B1, 1, 1); PG8_STAGE(PG8_SB(1, 0), b3, voffB);
            PG8_BAR; PG8_WAIT_L(0); PG8_MMA(0, 1, At, B1); PG8_BAR;
            PG8_LDA(At, 1, 1); PG8_STAGE(PG8_SA(1, 0), a3, voffA);
            PG8_BAR; PG8_WAIT_L(0); PG8_MMA(1, 0, At, B0); PG8_BAR; PG8_SCHED;
            PG8_STAGE(PG8_SB(1, 1), b3 + hstepB, voffB);
            PG8_WAIT_V(6); PG8_BAR; PG8_MMA(1, 1, At, B1); PG8_BAR;
            }
        }
        if constexpr (ALIGN_EPI) { if (wr == 0) PG8_BAR; }
        if constexpr (!Epi::AFTER_DRAIN) { E(acc, cur, wr, wc, fr, fq); S.done(cur); }
        if (!has_next) break;
#pragma unroll
        for (int a = 0; a < 2; ++a)
#pragma unroll
            for (int b = 0; b < 2; ++b)
#pragma unroll
                for (int m = 0; m < 4; ++m)
#pragma unroll
                    for (int n = 0; n < 2; ++n) acc[a][b][m][n] = (f32x4){0.f, 0.f, 0.f, 0.f};
        cur = nxt; cA = nA; cB = nB; ++ui;
        if constexpr (ALIGN_EPI) { if (wr == 1) PG8_BAR; }
    }
    PG8_WAIT_V(0);
    if constexpr (!ALIGN_EPI) { if (wr == 0) PG8_BAR; }
    PG8_BAR;
    if constexpr (Epi::AFTER_DRAIN) { E.fused(acc, cur, wr, wc, fr, fq, lds, wid, lane); S.done(cur); }
#undef PG8_SA
#undef PG8_SB
#undef PG8_STAGE
#undef PG8_LDA
#undef PG8_LDB
#undef PG8_MMA
#undef PG8_WAIT_V
#undef PG8_WAIT_L
#undef PG8_BAR
#undef PG8_SCHED
}
}
namespace pg8 {
struct EpiRoute {
    static constexpr bool PERM = true, AFTER_DRAIN = false;
    bf16_t* qkv; bf16_t* hg; bf16_t* gate;
    __device__ __forceinline__ void operator()(const f32x4 (&acc)[2][2][4][2], const Unit& u, int wr, int wc, int fr, int fq) const {
        bf16_t* base; int ldc, colt;
        if (u.pn < 3) { base = qkv; ldc = 768; colt = u.pn * 256; }
        else if (u.pn < 13) { base = hg; ldc = 2560; colt = (u.pn - 3) * 256; }
        else { base = gate; ldc = 2048; colt = (u.pn - 13) * 256; }
        const int row0 = u.pm * BM + wr * 64 + fr, col0 = colt + wc * 32 + 8 * fq;
#pragma unroll
        for (int ai = 0; ai < 2; ++ai)
#pragma unroll
            for (int m = 0; m < 4; ++m) { bf16_t* rowp = base + (size_t)(row0 + ai * HALF + m * 16) * ldc + col0;
#pragma unroll
                for (int bj = 0; bj < 2; ++bj) { const f32x4 v0 = acc[ai][bj][m][0], v1 = acc[ai][bj][m][1];
                    u32x4 w; w.x = cvt_pk_bf16(v0[0], v0[1]); w.y = cvt_pk_bf16(v0[2], v0[3]); w.z = cvt_pk_bf16(v1[0], v1[1]); w.w = cvt_pk_bf16(v1[2], v1[3]);
                    *(u32x4*)(rowp + bj * HALF) = w; } }
    }
};
struct EpiBf16Plain {
    static constexpr bool PERM = true, AFTER_DRAIN = false;
    bf16_t* O; int ldc;
    __device__ __forceinline__ void operator()(const f32x4 (&acc)[2][2][4][2], const Unit& u, int wr, int wc, int fr, int fq) const {
        const int row0 = u.pm * BM + wr * 64 + fr, col0 = u.pn * BM + wc * 32 + 8 * fq;
#pragma unroll
        for (int ai = 0; ai < 2; ++ai)
#pragma unroll
            for (int m = 0; m < 4; ++m) { bf16_t* rowp = O + (size_t)(row0 + ai * HALF + m * 16) * ldc + col0;
#pragma unroll
                for (int bj = 0; bj < 2; ++bj) { const f32x4 v0 = acc[ai][bj][m][0], v1 = acc[ai][bj][m][1];
                    u32x4 w; w.x = cvt_pk_bf16(v0[0], v0[1]); w.y = cvt_pk_bf16(v0[2], v0[3]); w.z = cvt_pk_bf16(v1[0], v1[1]); w.w = cvt_pk_bf16(v1[2], v1[3]);
                    *(u32x4*)(rowp + bj * HALF) = w; } }
    }
};
template <int MODE> struct EpiMerge {
    static constexpr bool PERM = true, AFTER_DRAIN = false;
    bf16_t* MG; const bf16_t* gate;
    __device__ __forceinline__ void operator()(const f32x4 (&acc)[2][2][4][2], const Unit& u, int wr, int wc, int fr, int fq) const {
        const int row0 = u.pm * BM + wr * 64 + fr, col0 = u.pn * BM + wc * 32 + 8 * fq;
#pragma unroll
        for (int ai = 0; ai < 2; ++ai)
#pragma unroll
            for (int m = 0; m < 4; ++m) { const size_t row = (size_t)(row0 + ai * HALF + m * 16);
#pragma unroll
                for (int bj = 0; bj < 2; ++bj) { const int col = col0 + bj * HALF;
                    const u32x4 gw = *(const u32x4*)(gate + row * 2048 + MODE * 1024 + col);
                    float v[8] = {acc[ai][bj][m][0][0], acc[ai][bj][m][0][1], acc[ai][bj][m][0][2], acc[ai][bj][m][0][3], acc[ai][bj][m][1][0], acc[ai][bj][m][1][1], acc[ai][bj][m][1][2], acc[ai][bj][m][1][3]};
                    const unsigned gwa[4] = {gw.x, gw.y, gw.z, gw.w};
#pragma unroll
                    for (int j = 0; j < 4; ++j) { v[2 * j] *= sigmoidf_(bf_lo(gwa[j])); v[2 * j + 1] *= sigmoidf_(bf_hi(gwa[j])); }
                    if (MODE == 1) { const u32x4 pw = *(const u32x4*)(MG + row * 1024 + col); const unsigned pa[4] = {pw.x, pw.y, pw.z, pw.w};
#pragma unroll
                        for (int j = 0; j < 4; ++j) { v[2 * j] += bf_lo(pa[j]); v[2 * j + 1] += bf_hi(pa[j]); } }
                    u32x4 w; w.x = cvt_pk_bf16(v[0], v[1]); w.y = cvt_pk_bf16(v[2], v[3]); w.z = cvt_pk_bf16(v[4], v[5]); w.w = cvt_pk_bf16(v[6], v[7]);
                    *(u32x4*)(MG + row * 1024 + col) = w; } }
    }
};
struct EpiResid {
    static constexpr bool PERM = true, AFTER_DRAIN = false;
    const float* x; float* out; bf16_t* xb; float* rowss;
    __device__ __forceinline__ void operator()(const f32x4 (&acc)[2][2][4][2], const Unit& u, int wr, int wc, int fr, int fq) const {
        const int row0 = u.pm * BM + wr * 64 + fr, col0 = u.pn * BM + wc * 32 + 8 * fq;
#pragma unroll
        for (int ai = 0; ai < 2; ++ai)
#pragma unroll
            for (int m = 0; m < 4; ++m) { const size_t row = (size_t)(row0 + ai * HALF + m * 16); float ss = 0.f;
#pragma unroll
                for (int bj = 0; bj < 2; ++bj) { const size_t off = row * 1024 + col0 + bj * HALF;
                    const f32x4 x0 = *(const f32x4*)(x + off), x1 = *(const f32x4*)(x + off + 4);
                    const f32x4 o0 = x0 + acc[ai][bj][m][0], o1 = x1 + acc[ai][bj][m][1];
                    *(f32x4*)(out + off) = o0; *(f32x4*)(out + off + 4) = o1;
                    ss += (o0[0] * o0[0] + o0[1] * o0[1]) + (o0[2] * o0[2] + o0[3] * o0[3]) + (o1[0] * o1[0] + o1[1] * o1[1]) + (o1[2] * o1[2] + o1[3] * o1[3]);
                    u32x4 w; w.x = cvt_pk_bf16(o0[0], o0[1]); w.y = cvt_pk_bf16(o0[2], o0[3]); w.z = cvt_pk_bf16(o1[0], o1[1]); w.w = cvt_pk_bf16(o1[2], o1[3]);
                    *(u32x4*)(xb + off) = w; }
                ss += __shfl_xor(ss, 16); ss += __shfl_xor(ss, 32);
                if (fq == 0) atomicAdd(rowss + row, ss); }
    }
};
struct EpiPle {
    static constexpr bool PERM = true, AFTER_DRAIN = false;
    float* out; const bf16_t* pp;
    __device__ __forceinline__ void operator()(const f32x4 (&acc)[2][2][4][2], const Unit& u, int wr, int wc, int fr, int fq) const {
        const int row0 = u.pm * BM + wr * 64 + fr, col0 = u.pn * BM + wc * 32 + 8 * fq;
#pragma unroll
        for (int ai = 0; ai < 2; ++ai)
#pragma unroll
            for (int m = 0; m < 4; ++m) { const size_t row = (size_t)(row0 + ai * HALF + m * 16);
#pragma unroll
                for (int bj = 0; bj < 2; ++bj) { const size_t off = row * 1024 + col0 + bj * HALF;
                    const f32x4 x0 = *(const f32x4*)(out + off), x1 = *(const f32x4*)(out + off + 4);
                    const u32x4 pw = *(const u32x4*)(pp + off);
                    const f32x4 a0 = acc[ai][bj][m][0], a1 = acc[ai][bj][m][1];
                    f32x4 o0, o1;
                    o0[0] = x0[0] + sigmoidf_(a0[0]) * bf_lo(pw.x); o0[1] = x0[1] + sigmoidf_(a0[1]) * bf_hi(pw.x);
                    o0[2] = x0[2] + sigmoidf_(a0[2]) * bf_lo(pw.y); o0[3] = x0[3] + sigmoidf_(a0[3]) * bf_hi(pw.y);
                    o1[0] = x1[0] + sigmoidf_(a1[0]) * bf_lo(pw.z); o1[1] = x1[1] + sigmoidf_(a1[1]) * bf_hi(pw.z);
                    o1[2] = x1[2] + sigmoidf_(a1[2]) * bf_lo(pw.w); o1[3] = x1[3] + sigmoidf_(a1[3]) * bf_hi(pw.w);
                    *(f32x4*)(out + off) = o0; *(f32x4*)(out + off + 4) = o1; } }
    }
};

__device__ __forceinline__ int key_enc(float s, int idx, int mask) { int b = __float_as_int(s); b = (b & ~mask) | idx; return b ^ ((b >> 31) & 0x7fffffff); }
__device__ __forceinline__ int key_dec(int k) { return k ^ ((k >> 31) & 0x7fffffff); }
__device__ __forceinline__ void ce_desc(int& a, int& b) { const int mx = a > b ? a : b, mn = a > b ? b : a; a = mx; b = mn; }
template <int N> __device__ __forceinline__ void bitonic_sort_desc(int (&v)[N]) {
#pragma unroll
    for (int k = 2; k <= N; k <<= 1)
#pragma unroll
        for (int j = k >> 1; j > 0; j >>= 1)
#pragma unroll
            for (int i = 0; i < N; ++i) { const int l = i ^ j; if (l > i) { if ((i & k) == 0) ce_desc(v[i], v[l]); else ce_desc(v[l], v[i]); } }
}
__device__ __forceinline__ void merge16_desc(int (&a)[16], const int (&b)[16]) {
#pragma unroll
    for (int i = 0; i < 16; ++i) { const int o = b[15 - i]; a[i] = a[i] > o ? a[i] : o; }
#pragma unroll
    for (int j = 8; j > 0; j >>= 1)
#pragma unroll
        for (int i = 0; i < 16; ++i) { const int l = i ^ j; if (l > i) ce_desc(a[i], a[l]); }
}

struct EpiTopk {
    static constexpr bool PERM = true, AFTER_DRAIN = true;
    const float* rowss; int* IDX; float* GW; float eps;
    static constexpr int LDW = 132;
    __device__ __forceinline__ void fused(const f32x4 (&acc)[2][2][4][2], const Unit& u, int wr, int wc, int fr, int fq, PG8_LAS unsigned char* lds, int wid, int lane) const {
        PG8_LAS float* S = (PG8_LAS float*)lds;
        const int tid = wid * 64 + lane, trow = tid >> 1, half = tid & 1;
        float rinv[2][4];
#pragma unroll
        for (int ai = 0; ai < 2; ++ai)
#pragma unroll
            for (int m = 0; m < 4; ++m) rinv[ai][m] = __builtin_amdgcn_rsqf(rowss[u.pm * BM + ai * HALF + wr * 64 + m * 16 + fr] * (1.0f / 1024.0f) + eps);
        int L[2][16];
#pragma unroll
        for (int p = 0; p < 2; ++p) {
#pragma unroll
            for (int ai = 0; ai < 2; ++ai)
#pragma unroll
                for (int m = 0; m < 4; ++m) { const int r = ai * HALF + wr * 64 + m * 16 + fr; PG8_LAS float* sp = S + r * LDW + wc * 32 + 8 * fq;
                    *(PG8_LAS f32x4*)sp = acc[ai][p][m][0] * rinv[ai][m]; *(PG8_LAS f32x4*)(sp + 4) = acc[ai][p][m][1] * rinv[ai][m]; }
            __syncthreads();
            int run[16];
            const PG8_LAS float* rp = S + trow * LDW + half * 64;
#pragma unroll
            for (int q = 0; q < 4; ++q) {
                int gq[16];
#pragma unroll
                for (int i4 = 0; i4 < 4; ++i4) { const f32x4 v = *(const PG8_LAS f32x4*)(rp + q * 16 + i4 * 4);
#pragma unroll
                    for (int j = 0; j < 4; ++j) gq[i4 * 4 + j] = key_enc(v[j], half * 64 + q * 16 + i4 * 4 + j, 0x7f); }
                bitonic_sort_desc<16>(gq);
                if (q == 0) {
#pragma unroll
                    for (int i = 0; i < 16; ++i) run[i] = gq[i];
                } else merge16_desc(run, gq);
            }
            int o[16];
#pragma unroll
            for (int i = 0; i < 16; ++i) o[i] = __shfl_xor(run[i], 1);
            merge16_desc(run, o);
#pragma unroll
            for (int i = 0; i < 16; ++i) L[p][i] = run[i];
            __syncthreads();
        }
        float v1[16], v2[16];
        PG8_LAS unsigned char* tb = lds + tid * 32;
#pragma unroll
        for (int i = 0; i < 16; ++i) { const int b1 = key_dec(L[0][i]), b2 = key_dec(L[1][i]); v1[i] = __int_as_float(b1 & ~0x7f); v2[i] = __int_as_float(b2 & ~0x7f);
            tb[i] = (unsigned char)(b1 & 0x7f); tb[16 + i] = (unsigned char)(b2 & 0x7f); }
        const int NEG = (int)0x80000000;
        int X[16], Y[16], Z[16];
        const bool hb = half != 0;
#define CAND(iA, jA, iB, jB) key_enc((hb ? v1[iB] : v1[iA]) + (hb ? v2[jB] : v2[jA]), hb ? ((iB) * 16 + (jB)) : ((iA) * 16 + (jA)), 0xff)
#pragma unroll
        for (int j = 0; j < 16; ++j) { if (j < 8) X[j] = CAND(0, j, 1, j); else { const int k0 = key_enc(v1[0] + v2[j], j, 0xff); X[j] = hb ? NEG : k0; } }
        {
            constexpr int yi[16] = {2, 2, 2, 2, 2, 3, 3, 3, 3, 4, 4, 4, 5, 5, 6, 6}, yj[16] = {0, 1, 2, 3, 4, 0, 1, 2, 3, 0, 1, 2, 0, 1, 0, 1};
#pragma unroll
            for (int n = 0; n < 16; ++n) { const int kb = key_enc(v1[yi[n]] + v2[yj[n]], yi[n] * 16 + yj[n], 0xff);
                if (n < 8) { const int ka = key_enc(v1[8 + n] + v2[0], (8 + n) * 16, 0xff); Y[n] = hb ? kb : ka; } else Y[n] = hb ? kb : NEG; }
        }
#pragma unroll
        for (int n = 0; n < 16; ++n) { if (n < 2) { const int kb = key_enc(v1[7] + v2[n], 7 * 16 + n, 0xff); Z[n] = hb ? kb : NEG; } else Z[n] = NEG; }
#undef CAND
        bitonic_sort_desc<16>(Y);
        merge16_desc(X, Y); merge16_desc(X, Z);
        int o2[16];
#pragma unroll
        for (int i = 0; i < 16; ++i) o2[i] = __shfl_xor(X[i], 1);
        merge16_desc(X, o2);
        float sv[16], e[16]; float sum = 0.f;
#pragma unroll
        for (int i = 0; i < 16; ++i) { sv[i] = __int_as_float(key_dec(X[i]) & ~0xff); }
#pragma unroll
        for (int i = 0; i < 16; ++i) { e[i] = __builtin_amdgcn_exp2f((sv[i] - sv[0]) * 1.4426950408889634f); sum += e[i]; }
        const float rs = 1.0f / sum;
        asm volatile("s_waitcnt lgkmcnt(0)" ::: "memory");
        if (!hb) {
            const size_t ob = (size_t)(u.pm * BM + trow) * 128 + u.pn * 16;
#pragma unroll
            for (int i4 = 0; i4 < 4; ++i4) { f32x4 gv; u32x4 iv;
#pragma unroll
                for (int j = 0; j < 4; ++j) { const int i = i4 * 4 + j; const int pid = key_dec(X[i]) & 0xff; const int i1 = tb[pid >> 4], i2 = tb[16 + (pid & 15)];
                    iv[j] = (unsigned)(i1 * 128 + i2); gv[j] = e[i] * rs; }
                *(u32x4*)(IDX + ob + i4 * 4) = iv; *(f32x4*)(GW + ob + i4 * 4) = gv; }
        }
        __syncthreads();
    }
};
}
#include <hip/hip_bf16.h>
#include <cmath>
namespace attn_body {
using bf16=__hip_bfloat16;
using bf16x8=__attribute__((ext_vector_type(8)))short;
using s16x4=__attribute__((ext_vector_type(4)))short;
using f32x16=__attribute__((ext_vector_type(16)))float;
using u32x4=__attribute__((ext_vector_type(4)))unsigned;
constexpr int BATCH=8,NHEAD=8,NKV=2,SEQ=4096,D=64,DM=768;
constexpr int NW=8,QBLK=32,QB=QBLK*NW,KVBLK=64,NQB=SEQ/QB;
constexpr int ATTN_PITCH=DM, ATTN_UNIT_ROWS=QB;
__device__ __forceinline__ int crow(int r,int hi){return (r&3)+8*(r>>2)+4*hi;}
#define SBAR() __builtin_amdgcn_sched_barrier(0)
__device__ __forceinline__ void cmask(f32x16&p0,f32x16&p1,int jb,int qrel,int hi){
  const float NEG=-INFINITY; int kb=64*jb+4*hi;
  #pragma unroll
  for(int r=0;r<16;++r){int kv=kb+(r&3)+8*(r>>2); if(kv>qrel)p0[r]=NEG; if(kv+32>qrel)p1[r]=NEG;}
}

constexpr int NSLOT=3, SLOTB=8192;
constexpr int LDS_K=0, LDS_V=NSLOT*SLOTB, LDS_WS=2*NSLOT*SLOTB, LDS_OST=LDS_WS+NW*64*4, LDS_BYTES=LDS_OST+NW*4096;
constexpr float C2=0.125f*1.4426950408889634f;
__device__ __forceinline__ void glds16(const void*gsrc,unsigned lds_dst){unsigned keep;
  asm volatile("s_mov_b32 %0, m0\n\ts_mov_b32 m0, %2\n\ts_nop 0\n\tglobal_load_lds_dwordx4 %1, off\n\ts_mov_b32 m0, %0":"=&s"(keep):"v"(gsrc),"s"(lds_dst):"memory");}
__device__ __forceinline__ float max3f(float a,float b,float c){float r;asm("v_max3_f32 %0, %1, %2, %3":"=v"(r):"v"(a),"v"(b),"v"(c));return r;}
__device__ __forceinline__ float max2f(float a,float b){float r;asm("v_max_f32_e32 %0, %1, %2":"=v"(r):"v"(a),"v"(b));return r;}
__device__ __forceinline__ float fadd_s(float a,float b){float r;asm("v_add_f32_e32 %0, %1, %2":"=v"(r):"v"(a),"v"(b));return r;}
__device__ __forceinline__ float fsub_s(float a,float b){float r;asm("v_sub_f32_e32 %0, %1, %2":"=v"(r):"v"(a),"v"(b));return r;}
typedef float f32x2_t __attribute__((ext_vector_type(2))); typedef __bf16 bf16x2_t __attribute__((ext_vector_type(2)));
__device__ __forceinline__ unsigned cvtpk_s(float lo,float hi){f32x2_t v={lo,hi};bf16x2_t b=__builtin_convertvector(v,bf16x2_t);return __builtin_bit_cast(unsigned,b);}
#define WAIT_BAR(N) asm volatile("s_waitcnt vmcnt(" #N ") lgkmcnt(0)\n\ts_barrier":::"memory")

__device__ __forceinline__ void qkt(f32x16&p0,f32x16&p1,const char*Kslot,const bf16x8*qr,const f32x16&negm,int r32,int hi){
  const char*kb=Kslot+hi*1024+r32*16;
  #pragma unroll
  for(int d0=0;d0<4;++d0){
    const bf16x8 b0=*reinterpret_cast<const bf16x8*>(kb+d0*2048);
    const bf16x8 b1=*reinterpret_cast<const bf16x8*>(kb+d0*2048+512);
    if(d0==0){p0=__builtin_amdgcn_mfma_f32_32x32x16_bf16(b0,qr[0],negm,0,0,0);p1=__builtin_amdgcn_mfma_f32_32x32x16_bf16(b1,qr[0],negm,0,0,0);}
    else{p0=__builtin_amdgcn_mfma_f32_32x32x16_bf16(b0,qr[d0],p0,0,0,0);p1=__builtin_amdgcn_mfma_f32_32x32x16_bf16(b1,qr[d0],p1,0,0,0);}}
}
typedef __attribute__((address_space(3))) const char* lds_cptr;
typedef short v4i16_t __attribute__((ext_vector_type(4)));
__device__ __forceinline__ void kload8(bf16x8*kf,lds_cptr kp){
  kf[0]=*(const __attribute__((address_space(3))) bf16x8*)(kp);      kf[1]=*(const __attribute__((address_space(3))) bf16x8*)(kp+512);
  kf[2]=*(const __attribute__((address_space(3))) bf16x8*)(kp+2048); kf[3]=*(const __attribute__((address_space(3))) bf16x8*)(kp+2560);
  kf[4]=*(const __attribute__((address_space(3))) bf16x8*)(kp+4096); kf[5]=*(const __attribute__((address_space(3))) bf16x8*)(kp+4608);
  kf[6]=*(const __attribute__((address_space(3))) bf16x8*)(kp+6144); kf[7]=*(const __attribute__((address_space(3))) bf16x8*)(kp+6656);
}
__device__ __forceinline__ void kload2(bf16x8*kf,lds_cptr kp,int j){ kf[2*j]=*(const __attribute__((address_space(3))) bf16x8*)(kp+j*2048); kf[2*j+1]=*(const __attribute__((address_space(3))) bf16x8*)(kp+j*2048+512); }
__device__ __forceinline__ s16x4 vtr(lds_cptr p){ return __builtin_bit_cast(s16x4,__builtin_amdgcn_ds_read_tr16_b64_v4i16((__attribute__((address_space(3))) v4i16_t*)p)); }
__device__ __forceinline__ float rowmax(const f32x16&p0,const f32x16&p1){
  float a=max3f(p0[0],p0[1],p1[0]),b=max3f(p0[2],p0[3],p1[1]);a=max3f(a,p1[2],p1[3]);
  #pragma unroll
  for(int r=4;r<16;r+=4){a=max3f(a,p0[r],p0[r+1]);b=max3f(b,p0[r+2],p0[r+3]);a=max3f(a,p1[r],p1[r+1]);b=max3f(b,p1[r+2],p1[r+3]);}
  const float m=max2f(a,b);
  auto rr=__builtin_amdgcn_permlane32_swap(__float_as_uint(m),__float_as_uint(m),false,false);
  return max2f(__uint_as_float(rr[0]),__uint_as_float(rr[1]));
}
__device__ __forceinline__ void pv(f32x16*o,int vb,bf16x8 pa0,bf16x8 pa1,bf16x8 pa2,bf16x8 pa3){
  #pragma unroll
  for(int d0=0;d0<2;++d0){s16x4 lo[4],hi[4];
    #pragma unroll
    for(int ks=0;ks<4;++ks){
      asm volatile("ds_read_b64_tr_b16 %0,%1 offset:%c2":"=&v"(lo[ks]):"v"(vb),"i"(d0*4096+ks*1024):"memory");
      asm volatile("ds_read_b64_tr_b16 %0,%1 offset:%c2":"=&v"(hi[ks]):"v"(vb),"i"(d0*4096+ks*1024+512):"memory");}
    asm volatile("s_waitcnt lgkmcnt(0)":::"memory");SBAR();
    #define PK(k) (bf16x8){lo[k][0],lo[k][1],lo[k][2],lo[k][3],hi[k][0],hi[k][1],hi[k][2],hi[k][3]}
    o[d0]=__builtin_amdgcn_mfma_f32_32x32x16_bf16(pa0,PK(0),o[d0],0,0,0);
    o[d0]=__builtin_amdgcn_mfma_f32_32x32x16_bf16(pa1,PK(1),o[d0],0,0,0);
    o[d0]=__builtin_amdgcn_mfma_f32_32x32x16_bf16(pa2,PK(2),o[d0],0,0,0);
    o[d0]=__builtin_amdgcn_mfma_f32_32x32x16_bf16(pa3,PK(3),o[d0],0,0,0);
    #undef PK
  }
}

#ifndef ATTN_STORE16
#define ATTN_STORE16(p,v) (*(u32x4*)(p)=(v))
#endif
template<int THRL> __device__ __forceinline__ void attn_unit(int b,int h,int qb,const bf16*Q,const bf16*__restrict__ K,const bf16*__restrict__ V,bf16*O,char*shm){
  int tid_=threadIdx.x; asm volatile("":"+v"(tid_)); const int tid=tid_,lane=tid&63,r32=lane&31,hi=lane>>5; const int wid=__builtin_amdgcn_readfirstlane(tid>>6);
  const long rowbase=(long)b*SEQ; const int q0=qb*QB;
  const bf16*Qw=Q+(rowbase+q0+wid*QBLK)*DM+h*D;
  const bf16*Kh=K+rowbase*DM+(h/(NHEAD/NKV))*D,*Vh=V+rowbase*DM+(h/(NHEAD/NKV))*D;
  const unsigned lds0=(unsigned)(uintptr_t)shm;
  float*wsf=(float*)(shm+LDS_WS)+wid*64;
  const bf16*ksrc=Kh+(long)lane*DM+wid*8;
  const bf16*vsrc=Vh+(long)(16*(wid&3)+(lane>>2))*DM+(wid>>2)*32+(lane&3)*8;
  const unsigned kdst=lds0+LDS_K+wid*1024, vdst=lds0+LDS_V+wid*1024;
  #define DMA_K(t,slot) glds16(ksrc+(long)(t)*KVBLK*DM,(unsigned)__builtin_amdgcn_readfirstlane(kdst+(slot)))
  #define DMA_V(t,slot) glds16(vsrc+(long)(t)*KVBLK*DM,(unsigned)__builtin_amdgcn_readfirstlane(vdst+(slot)))
  const int vb0=(int)(lds0+LDS_V)+((lane>>4)&1)*32+(lane&3)*8+(4*hi+((lane&15)>>2))*64;
  const char*Kbase=shm+LDS_K; bf16x8 kf[8];
  const lds_cptr shm3=(lds_cptr)shm; const lds_cptr kp0=shm3+LDS_K+hi*1024+r32*16; const lds_cptr vp0=shm3+LDS_V+((lane>>4)&1)*32+(lane&3)*8+(4*hi+((lane&15)>>2))*64;
  constexpr int NT=SEQ/KVBLK;
  DMA_K(0,0);DMA_V(0,0);DMA_K(1,SLOTB);
  bf16x8 qr[4];
  #pragma unroll
  for(int d0=0;d0<4;++d0)qr[d0]=*reinterpret_cast<const bf16x8*>(&Qw[(long)r32*DM+d0*16+hi*8]);
  float mhat=0.f,l_reg=0.f;f32x16 o[2];o[0]=f32x16{};o[1]=f32x16{};f32x16 negm=f32x16{};asm volatile("":"+v"(negm));
  const int qrel=wid*QBLK+r32;
  #define CMASK(P0,P1,t) do{}while(0)
  bool resc=false;
  #define START(P0,P1) do{ const float rm=rowmax(P0,P1); resc=false; \
    { const float dl=rm; mhat=fadd_s(mhat,dl); \
      _Pragma("unroll") for(int r=0;r<16;++r){P0[r]=fsub_s(P0[r],dl);P1[r]=fsub_s(P1[r],dl);} \
      _Pragma("unroll") for(int r=0;r<16;++r)negm[r]=-mhat; asm volatile("":"+v"(negm)); } \
    _Pragma("unroll") for(int r=0;r<16;++r)P0[r]=__builtin_amdgcn_exp2f(P0[r]); }while(0)
  #define RESC() do{ if(resc){ asm volatile("s_waitcnt lgkmcnt(0)":::"memory"); \
      _Pragma("unroll") for(int d_=0;d_<2;++d_) _Pragma("unroll") for(int r=0;r<16;++r)o[d_][r]*=wsf[crow(r,hi)]; } }while(0)
  f32x16 pA0,pA1,pB0,pB1;
  int sl_prev=0,sl_cur=0,sl_next=SLOTB;
  #define ROT() do{sl_prev=sl_cur;sl_cur=sl_next;sl_next=(sl_next==(NSLOT-1)*SLOTB)?0:sl_next+SLOTB;}while(0)
  DMA_K(2,2*SLOTB);
  WAIT_BAR(3);
  qkt(pA0,pA1,Kbase,qr,negm,r32,hi);asm volatile("s_nop 15\n\ts_nop 7":"+v"(pA0),"+v"(pA1));CMASK(pA0,pA1,0);
  START(pA0,pA1);
  _Pragma("unroll") for(int r=0;r<16;++r)pA1[r]=__builtin_amdgcn_exp2f(pA1[r]);
  WAIT_BAR(0);
  DMA_K(3,0);DMA_V(1,SLOTB);
  ROT();
  kload8(kf,kp0+sl_cur);
  WAIT_BAR(2);
  s16x4 vlo[8],vhi[8]; u32x4 pw0,pw1,pw2,pw3;
  #define PKW(P,B) cvtpk_s(P[B],P[B+1])
  #define PAF(k) __builtin_bit_cast(bf16x8,pw##k)
  #define VFR(i) (bf16x8){vlo[i][0],vlo[i][1],vlo[i][2],vlo[i][3],vhi[i][0],vhi[i][1],vhi[i][2],vhi[i][3]}
  #define PIN(x) asm volatile("":"+v"(x))
  #define MX3(a,b,c) __builtin_fmaxf(__builtin_fmaxf((a),(b)),(c))
  #define GAPA(MF,A0,A1,A2,A3,W0,W1,PW) do{ MF; sacc+=A0; sacc+=A1; sacc+=A2; sacc+=A3; PIN(sacc); W0; W1; PIN(PW); SBAR(); }while(0)
  #define EX(v) __builtin_amdgcn_exp2f(v)
  #define GAPB(MF,X,B) do{ MF; X[B]=EX(X[B]); X[B+1]=EX(X[B+1]); X[B+2]=EX(X[B+2]); X[B+3]=EX(X[B+3]); PIN(X); SBAR(); }while(0)
  #define VRD(i) do{ vlo[i]=vtr(vp_+(((i)>>2)*4096+((i)&3)*1024)); vhi[i]=vtr(vp_+(((i)>>2)*4096+((i)&3)*1024+512)); }while(0)
  #define KRD(G,j) do{ if(G){ kload2(kf,kp0+sl_next,j); SBAR(); } }while(0)
  #define STEP(C0,C1,P0,P1,t,GK,GV,GL) do{ SBAR(); \
    const lds_cptr vp_=vp0+sl_prev; \
    VRD(0); SBAR(); float sacc=(P0[0]+P0[1]); \
    GAPA(C0=__builtin_amdgcn_mfma_f32_32x32x16_bf16(kf[0],qr[0],negm,0,0,0), P0[2],P0[3],P0[4],P0[5],     pw0[0]=PKW(P0,0), pw0[1]=PKW(P0,2), pw0); \
    VRD(4); SBAR(); GAPA(C1=__builtin_amdgcn_mfma_f32_32x32x16_bf16(kf[1],qr[0],negm,0,0,0), P0[6],P0[7],P0[8],P0[9],     pw0[2]=PKW(P0,4), pw0[3]=PKW(P0,6), pw0); \
    VRD(1); SBAR(); GAPA(C0=__builtin_amdgcn_mfma_f32_32x32x16_bf16(kf[2],qr[1],C0,0,0,0),   P0[10],P0[11],P0[12],P0[13], pw1[0]=PKW(P0,8), pw1[1]=PKW(P0,10), pw1); \
    VRD(5); SBAR(); GAPA(C1=__builtin_amdgcn_mfma_f32_32x32x16_bf16(kf[3],qr[1],C1,0,0,0),   P0[14],P0[15],P1[0],P1[1],   pw1[2]=PKW(P0,12),pw1[3]=PKW(P0,14), pw1); \
    VRD(2); SBAR(); GAPA(C0=__builtin_amdgcn_mfma_f32_32x32x16_bf16(kf[4],qr[2],C0,0,0,0),   P1[2],P1[3],P1[4],P1[5],     pw2[0]=PKW(P1,0), pw2[1]=PKW(P1,2), pw2); \
    VRD(6); SBAR(); GAPA(C1=__builtin_amdgcn_mfma_f32_32x32x16_bf16(kf[5],qr[2],C1,0,0,0),   P1[6],P1[7],P1[8],P1[9],     pw2[2]=PKW(P1,4), pw2[3]=PKW(P1,6), pw2); \
    VRD(3); SBAR(); GAPA(C0=__builtin_amdgcn_mfma_f32_32x32x16_bf16(kf[6],qr[3],C0,0,0,0),   P1[10],P1[11],P1[12],P1[13], pw3[0]=PKW(P1,8), pw3[1]=PKW(P1,10), pw3); \
    VRD(7); SBAR(); GAPA(C1=__builtin_amdgcn_mfma_f32_32x32x16_bf16(kf[7],qr[3],C1,0,0,0),   P1[14],P1[15],0.f,0.f,       pw3[2]=PKW(P1,12),pw3[3]=PKW(P1,14), pw3); \
    l_reg+=sacc; \
    if(GK){DMA_K((t)+3,sl_cur);} if(GV){DMA_V((t)+1,sl_next);} \
    CMASK(C0,C1,t); \
    { float a=MX3(C0[0],C0[1],C1[0]),b=MX3(C0[2],C0[3],C1[1]); a=MX3(a,C1[2],C1[3]); \
      _Pragma("unroll") for(int r=4;r<16;r+=4){a=MX3(a,C0[r],C0[r+1]);b=MX3(b,C0[r+2],C0[r+3]);a=MX3(a,C1[r],C1[r+1]);b=MX3(b,C1[r+2],C1[r+3]);} \
      float rm=__builtin_fmaxf(a,b); { auto rr=__builtin_amdgcn_permlane32_swap(__float_as_uint(rm),__float_as_uint(rm),false,false); rm=__builtin_fmaxf(__uint_as_float(rr[0]),__uint_as_float(rr[1])); } \
      resc=false; \
      if(__builtin_expect(__any(rm>(float)THRL),0)){ const float dl=__builtin_fmaxf(rm,0.f); mhat+=dl; \
        _Pragma("unroll") for(int r=0;r<16;++r){C0[r]-=dl;C1[r]-=dl;} \
        _Pragma("unroll") for(int r=0;r<16;++r)negm[r]=-mhat; asm volatile("":"+v"(negm)); \
        const float f=__builtin_amdgcn_exp2f(-dl); l_reg*=f; if(hi==0)wsf[r32]=f; resc=true; } } \
    SBAR(); \
    GAPB(o[0]=__builtin_amdgcn_mfma_f32_32x32x16_bf16(PAF(0),VFR(0),o[0],0,0,0), C0,0); \
    GAPB(o[1]=__builtin_amdgcn_mfma_f32_32x32x16_bf16(PAF(0),VFR(4),o[1],0,0,0), C0,4); \
    KRD(GL,0); GAPB(o[0]=__builtin_amdgcn_mfma_f32_32x32x16_bf16(PAF(1),VFR(1),o[0],0,0,0), C0,8); \
    KRD(GL,1); GAPB(o[1]=__builtin_amdgcn_mfma_f32_32x32x16_bf16(PAF(1),VFR(5),o[1],0,0,0), C0,12); \
    KRD(GL,2); GAPB(o[0]=__builtin_amdgcn_mfma_f32_32x32x16_bf16(PAF(2),VFR(2),o[0],0,0,0), C1,0); \
    KRD(GL,3); GAPB(o[1]=__builtin_amdgcn_mfma_f32_32x32x16_bf16(PAF(2),VFR(6),o[1],0,0,0), C1,4); \
    GAPB(o[0]=__builtin_amdgcn_mfma_f32_32x32x16_bf16(PAF(3),VFR(3),o[0],0,0,0), C1,8); \
    GAPB(o[1]=__builtin_amdgcn_mfma_f32_32x32x16_bf16(PAF(3),VFR(7),o[1],0,0,0), C1,12); \
    }while(0)
  int t=1;
  #undef CMASK
  #define CMASK(P0,P1,t) do{}while(0)
  for(;t+5<NT;t+=2){
    STEP(pB0,pB1,pA0,pA1,t,true,true,true);     WAIT_BAR(2); RESC(); ROT();
    STEP(pA0,pA1,pB0,pB1,t+1,true,true,true);   WAIT_BAR(2); RESC(); ROT();
  }
  #undef CMASK
  #define CMASK(P0,P1,t) do{}while(0)
  #define ENDW(tt) do{ if((tt)+3<NT){WAIT_BAR(2);} else if((tt)+2<NT){WAIT_BAR(1);} else {WAIT_BAR(0);} }while(0)
  for(;t+1<NT;t+=2){
    STEP(pB0,pB1,pA0,pA1,t,(t+3<NT),(t+1<NT),(t+1<NT));       ENDW(t);   RESC(); ROT();
    STEP(pA0,pA1,pB0,pB1,t+1,(t+4<NT),(t+2<NT),(t+2<NT));     ENDW(t+1); RESC(); ROT();
  }
  STEP(pB0,pB1,pA0,pA1,NT-1,false,false,false); RESC();
  { float sacc=pB0[0]+pB0[1]; _Pragma("unroll") for(int r=2;r<16;++r)sacc+=pB0[r]; _Pragma("unroll") for(int r=0;r<16;++r)sacc+=pB1[r]; l_reg+=sacc;
    pw0=(u32x4){PKW(pB0,0),PKW(pB0,2),PKW(pB0,4),PKW(pB0,6)};pw1=(u32x4){PKW(pB0,8),PKW(pB0,10),PKW(pB0,12),PKW(pB0,14)};pw2=(u32x4){PKW(pB1,0),PKW(pB1,2),PKW(pB1,4),PKW(pB1,6)};pw3=(u32x4){PKW(pB1,8),PKW(pB1,10),PKW(pB1,12),PKW(pB1,14)};
    SBAR(); pv(o,vb0+sl_cur,PAF(0),PAF(1),PAF(2),PAF(3)); }
  #undef PKW
  #undef PAF
  #undef VFR
  #undef PIN
  #undef MX3
  #undef GAPA
  #undef GAPB
  #undef EX
  #undef VRD
  #undef KRD
  #undef STEP
  #undef ENDW
  {auto rr=__builtin_amdgcn_permlane32_swap(__float_as_uint(l_reg),__float_as_uint(l_reg),false,false);l_reg=__uint_as_float(rr[0])+__uint_as_float(rr[1]);}
  if(hi==0)wsf[32+r32]=l_reg;asm volatile("s_waitcnt lgkmcnt(0)":::"memory");
  float rli[16];
  #pragma unroll
  for(int r=0;r<16;++r)rli[r]=__builtin_amdgcn_rcpf(wsf[32+crow(r,hi)]);
  bf16*Ow=O+(rowbase+q0+wid*QBLK)*DM+h*D;
  { bf16*stg=(bf16*)(shm+LDS_OST)+wid*2048;
    #pragma unroll
    for(int r=0;r<16;++r){const int orow=crow(r,hi);
      #pragma unroll
      for(int d0=0;d0<2;++d0)stg[orow*64+d0*32+r32]=__float2bfloat16(o[d0][r]*rli[r]);}
    asm volatile("s_waitcnt lgkmcnt(0)":::"memory");
    #pragma unroll
    for(int i=0;i<4;++i){const int row=i*8+(lane>>3),ch=lane&7; const u32x4 v=*(const u32x4*)(stg+row*64+ch*8); ATTN_STORE16(Ow+(long)row*DM+ch*8,v);} }
  asm volatile("s_waitcnt lgkmcnt(0)\n\ts_barrier":::"memory");
  #undef DMA_K
  #undef DMA_V
  #undef CMASK
  #undef START
  #undef RESC
  #undef ROT
}
constexpr int ATTN_LDS_BYTES=LDS_BYTES;
struct AttnTensors { const bf16* Q; const bf16* K; const bf16* V; bf16* O; };
struct AttnUnit { int bh; int qb; };
__device__ __forceinline__ void unit_decode(int n,AttnUnit&u){ const int grp=n>>6,wi=n&63; const int b=grp>>1,kvh=grp&1; u.bh=b*NHEAD+kvh*(NHEAD/NKV)+(wi>>4); u.qb=wi&15; }
#undef SBAR
#undef WAIT_BAR
}
constexpr int NWAVES = 8;
constexpr int BATCH = 8, SEQ = 4096, DMODEL = 1024, T = BATCH * SEQ;
constexpr int INW = 5376, QKVW = 768, HGW = 2560, GATEW = 2048;
constexpr int NEXP = 16384, PLED = 256;
constexpr float EPS = 1e-6f;
constexpr size_t MiB = 1u << 20;
constexpr size_t WS_CTL = 0, CTL_ZERO_BYTES = 1 * MiB;
constexpr size_t WS_WIN = 2 * MiB;
constexpr size_t WS_WUA = 13 * MiB;
constexpr size_t WS_WUH = 14 * MiB;
constexpr size_t WS_WOUT = 15 * MiB;
constexpr size_t WS_WPEER = 17 * MiB;
constexpr size_t WS_WPG = 21 * MiB;
constexpr size_t WS_WPP = 23 * MiB;
constexpr size_t WS_XN = 24 * MiB;
constexpr size_t WS_QKV = 88 * MiB;
constexpr size_t WS_HG = 136 * MiB;
constexpr size_t WS_GATE = 296 * MiB;
constexpr size_t WS_OF = 424 * MiB;
constexpr size_t WS_OB = 456 * MiB;
constexpr size_t WS_END = 488 * MiB;
constexpr size_t WS_UB = WS_HG, WS_VB = WS_HG + 32 * MiB, WS_PB = WS_HG + 64 * MiB, WS_IDX = WS_HG + 80 * MiB, WS_GW = WS_HG + 96 * MiB;
constexpr size_t WS_X1B = WS_GATE, WS_PP = WS_GATE + 64 * MiB;
constexpr int CW_BAR = 4096;
constexpr int CW_QUEUE = 16384;
constexpr int CW_ROWSS = 131072;
static_assert((CW_ROWSS + T) * 4 <= (int)CTL_ZERO_BYTES, "ctl");
constexpr int SCR_BYTES = 147456;
constexpr int LDSCTL_OFF = SCR_BYTES, MISC_OFF = LDSCTL_OFF + 320;
constexpr int LDS_BYTES = SCR_BYTES + 1024;

#define GAS __attribute__((address_space(1)))
#define LAS __attribute__((address_space(3)))
typedef unsigned short bf16;
typedef unsigned v4u __attribute__((ext_vector_type(4)));
typedef unsigned v2u __attribute__((ext_vector_type(2)));
typedef float f32x4 __attribute__((ext_vector_type(4)));
typedef float f32x16 __attribute__((ext_vector_type(16)));
typedef short bf16x8 __attribute__((ext_vector_type(8)));
typedef GAS unsigned gu32;
#define RLX_AGENT __ATOMIC_RELAXED, __HIP_MEMORY_SCOPE_AGENT
#define LDS_WAIT() asm volatile("s_waitcnt lgkmcnt(0)" ::: "memory")
#define VM_WAIT() asm volatile("s_waitcnt vmcnt(0)" ::: "memory")
#define DI __device__ __forceinline__
DI unsigned f2bf(float f) { unsigned u = __builtin_bit_cast(unsigned, f); return (u + 0x7fffu + ((u >> 16) & 1u)) >> 16; }
DI unsigned pk2(float lo, float hi) { typedef float f2 __attribute__((ext_vector_type(2))); typedef __bf16 b2 __attribute__((ext_vector_type(2))); f2 v = {lo, hi}; b2 b = __builtin_convertvector(v, b2); return __builtin_bit_cast(unsigned, b); }
DI float bflo(unsigned w) { return __uint_as_float(w << 16); }
DI float bfhi(unsigned w) { return __uint_as_float(w & 0xffff0000u); }
DI float fsigmoid(float x) { return __builtin_amdgcn_rcpf(1.0f + __builtin_amdgcn_exp2f(-1.4426950408889634f * x)); }
DI float fexp(float x) { return __builtin_amdgcn_exp2f(1.4426950408889634f * x); }
DI float wave_sum(float v) {
#pragma unroll
    for (int o = 1; o < 64; o <<= 1) v += __shfl_xor(v, o);
    return v;
}

#define XB_TMO      128
#define XB_XCNT(j)  (256  + 64 * (j))
#define XB_XSUB(j)  (1280 + 64 * (j))
#define XB_XGEN(j)  (2304 + 64 * (j))
#define XB_TOP      3328
#define XB_TOPGEN   3392
#define XCD_BAR_WORDS 3456
#define XB_SPIN_CAP (1u << 18)
DI unsigned xb_ld(unsigned* p)              { return __hip_atomic_load(p, __ATOMIC_RELAXED, __HIP_MEMORY_SCOPE_AGENT); }
DI unsigned xb_add(unsigned* p, unsigned v) { return __hip_atomic_fetch_add(p, v, __ATOMIC_RELAXED, __HIP_MEMORY_SCOPE_AGENT); }
DI unsigned xb_xcc_id() { return (unsigned)__builtin_amdgcn_s_getreg((3 << 11) | 20) & 0xFu; }
#define XB_SPIN(cond, bar) do { unsigned _sp = 0; while (cond) { __builtin_amdgcn_s_sleep(1); \
    if ((++_sp & 255u) == 0u) { if (xb_ld(&(bar)[XB_TMO])) break; if (_sp > XB_SPIN_CAP) { atomicAdd(&(bar)[XB_TMO], 1u); break; } } } } while (0)
struct XcdBarrier { unsigned* bar; unsigned x; volatile LAS unsigned* st; };
DI XcdBarrier xcd_barrier_post(unsigned* bar, volatile LAS unsigned* st) {
    XcdBarrier b; b.bar = bar; b.x = xb_xcc_id(); b.st = st;
    if (threadIdx.x == 0) (void)xb_add(&bar[XB_XCNT(b.x)], 1u);
    return b;
}
DI void xcd_barrier_complete(unsigned* bar, unsigned x, unsigned& nloc, unsigned& nx) {
    const unsigned G = gridDim.x * gridDim.y * gridDim.z;
    unsigned sum, cnt, mine, sp = 0u;
    for (;;) {
        sum = 0u; cnt = 0u; mine = 0u;
#pragma unroll
        for (unsigned j = 0; j < 16; ++j) { const unsigned c = xb_ld(&bar[XB_XCNT(j)]); sum += c; cnt += (c > 0u) ? 1u : 0u; mine = (j == x) ? c : mine; }
        if (sum == G) break;
        __builtin_amdgcn_s_sleep(1);
        if ((++sp & 255u) == 0u) { if (xb_ld(&bar[XB_TMO])) break; if (sp > XB_SPIN_CAP) { atomicAdd(&bar[XB_TMO], 1u); break; } }
    }
    nloc = mine > 0u ? mine : 1u; nx = cnt > 0u ? cnt : 1u;
}
DI void xcd_barrier(const XcdBarrier& b) {
    asm volatile("s_waitcnt vmcnt(0)" ::: "memory");
    __syncthreads();
    if (threadIdx.x == 0) {
        unsigned* bar = b.bar;
        __builtin_amdgcn_s_waitcnt(0);
        unsigned nloc = b.st[0], nx = b.st[1];
        if (nloc == 0u) { xcd_barrier_complete(bar, b.x, nloc, nx); b.st[0] = nloc; b.st[1] = nx; }
        const unsigned old = xb_add(&bar[XB_XSUB(b.x)], 1u);
        const unsigned gen = old / nloc;
        if (old + 1u == (gen + 1u) * nloc) {
            __builtin_amdgcn_fence(__ATOMIC_RELEASE, "agent");
            asm volatile("s_waitcnt vmcnt(0)" ::: "memory");
            const unsigned og = xb_add(&bar[XB_TOP], 1u);
            const unsigned tg = og / nx;
            if (og + 1u == (tg + 1u) * nx) xb_add(&bar[XB_TOPGEN], 1u);
            else XB_SPIN(xb_ld(&bar[XB_TOPGEN]) == tg, bar);
            __builtin_amdgcn_fence(__ATOMIC_ACQUIRE, "agent");
            xb_add(&bar[XB_XGEN(b.x)], 1u);
            asm volatile("s_waitcnt vmcnt(0)" ::: "memory");
        } else {
            XB_SPIN(xb_ld(&bar[XB_XGEN(b.x)]) == gen, bar);
            __builtin_amdgcn_fence(__ATOMIC_ACQUIRE, "agent");
            asm volatile("s_waitcnt vmcnt(0)" ::: "memory");
        }
    }
    __syncthreads();
}
DI void wg_l1_refresh() {
    asm volatile("s_waitcnt vmcnt(0)" ::: "memory");
    __syncthreads();
    if (threadIdx.x == 0) { __builtin_amdgcn_fence(__ATOMIC_ACQUIRE, "agent"); asm volatile("s_waitcnt vmcnt(0)" ::: "memory"); }
    __syncthreads();
}

struct Frame {
    LAS unsigned char* lds;
    volatile LAS unsigned* MISC;
    gu32* ctl;
    int tid, lane, wave;
    int vcu, G;
    unsigned char* ws;
    float* out;
};
enum { I_X = 0, I_P, I_NORM_MIX, I_W_IN, I_Q_NORM, I_K_NORM, I_HG_LB, I_HG_ONORM, I_W_UP_ATT, I_W_UP_HG, I_W_OUT, I_NORM_FFN, I_PEER_WQ, I_PEER_SK, I_PEER_U, I_PEER_V, I_NORM_PLE, I_PLE_GATE, I_PLE_PROJ };
DI const float* inp(int k) {
    typedef const float* cfp;
    const __attribute__((address_space(4))) char* ka = (const __attribute__((address_space(4))) char*)__builtin_amdgcn_kernarg_segment_ptr();
    return *(const volatile __attribute__((address_space(4))) cfp*)(ka + 8 * k);
}

DI void p0_transpose_item(const float* W, int K, int N, bf16* WT, LAS float* scr, int item, int lane) {
    const int nblk = N / 32, kb = item / nblk, nb = item % nblk, k0 = 64 * kb, n0 = 32 * nb;
#pragma unroll 8
    for (int i = 0; i < 32; ++i) { const int kk = 2 * i + (lane >> 5); scr[kk * 33 + (lane & 31)] = W[(size_t)(k0 + kk) * N + n0 + (lane & 31)]; }
    LDS_WAIT(); asm volatile("" ::: "memory");
    const int c = lane & 7;
#pragma unroll
    for (int j = 0; j < 4; ++j) { const int n = (lane >> 3) + 8 * j; const LAS float* s = scr + (8 * c) * 33 + n;
        v4u o; o.x = pk2(s[0 * 33], s[1 * 33]); o.y = pk2(s[2 * 33], s[3 * 33]); o.z = pk2(s[4 * 33], s[5 * 33]); o.w = pk2(s[6 * 33], s[7 * 33]);
        *(GAS v4u*)(WT + (size_t)(n0 + n) * K + k0 + 8 * c) = o; }
    LDS_WAIT(); asm volatile("" ::: "memory");
}
DI void rms_row_to_bf16(int lane, const float* xrow, const float* gain, bf16* orow) {
    const GAS f32x4* xr = (const GAS f32x4*)xrow + lane; const GAS f32x4* gr = (const GAS f32x4*)gain + lane;
    f32x4 v[4]; float s = 0.f;
#pragma unroll
    for (int j = 0; j < 4; ++j) { v[j] = xr[64 * j]; s += (v[j].x * v[j].x + v[j].y * v[j].y) + (v[j].z * v[j].z + v[j].w * v[j].w); }
    const float rinv = __builtin_amdgcn_rsqf(wave_sum(s) * (1.f / DMODEL) + EPS);
    GAS unsigned long long* o8 = (GAS unsigned long long*)orow + lane;
#pragma unroll
    for (int j = 0; j < 4; ++j) { const f32x4 g = gr[64 * j]; o8[64 * j] = (unsigned long long)pk2(v[j].x * rinv * g.x, v[j].y * rinv * g.y) | ((unsigned long long)pk2(v[j].z * rinv * g.z, v[j].w * rinv * g.w) << 32); }
}
DI void p0_peer_w_item(Frame& F, int it) {
    const float* peer_subkeys = inp(I_PEER_SK); const float* peer_wq = inp(I_PEER_WQ); const float* norm_ffn = inp(I_NORM_FFN);
    const int hp = it >> 4, k0 = (it & 15) * 64, tid = F.tid;
    LAS float* skL = (LAS float*)F.lds; LAS float* wqL = (LAS float*)(F.lds + 128 * 132 * 4);
    const float* sk = peer_subkeys + (size_t)hp * 16384;
#pragma unroll
    for (int i = 0; i < 8; ++i) { const int idx = i * 2048 + tid * 4; const f32x4 v = *(const f32x4*)(sk + idx); *(LAS f32x4*)(skL + (idx >> 7) * 132 + (idx & 127)) = v; }
#pragma unroll
    for (int i = 0; i < 4; ++i) { const int idx = i * 2048 + tid * 4; const int k = idx >> 7, c = idx & 127; const f32x4 v = *(const f32x4*)(peer_wq + (size_t)(k0 + k) * 2048 + hp * 128 + c); *(LAS f32x4*)(wqL + k * 132 + c) = v; }
    __syncthreads();
    const int k = tid & 63, n0 = (tid >> 6) * 16;
    float acc[16];
#pragma unroll
    for (int n = 0; n < 16; ++n) acc[n] = 0.f;
    for (int c4 = 0; c4 < 32; ++c4) { const f32x4 wv = *(const LAS f32x4*)(wqL + k * 132 + c4 * 4);
#pragma unroll
        for (int n = 0; n < 16; ++n) { const f32x4 sv = *(const LAS f32x4*)(skL + (n0 + n) * 132 + c4 * 4); acc[n] += (wv.x * sv.x + wv.y * sv.y) + (wv.z * sv.z + wv.w * sv.w); } }
    const float g = norm_ffn[k0 + k];
    bf16* WT = (bf16*)(F.ws + WS_WPEER);
#pragma unroll
    for (int n = 0; n < 16; ++n) WT[(size_t)(hp * 128 + n0 + n) * 1024 + k0 + k] = (bf16)f2bf(acc[n] * g);
    __syncthreads();
}
DI void p0_prologue(Frame& F) {
    for (int it = blockIdx.x; it < 256; it += F.G) p0_peer_w_item(F, it);
    LAS float* scr = (LAS float*)(F.lds + F.wave * 16384);
    const int gw = F.vcu * NWAVES + F.wave, NGW = F.G * NWAVES;
    constexpr int I_IN = (1024 / 64) * (INW / 32), I_UA = (512 / 64) * (1024 / 32), I_OUT = (1024 / 64) * (1024 / 32), I_PP = (256 / 64) * (1024 / 32);
    constexpr int NITEMS = I_IN + 2 * I_UA + 2 * I_OUT + I_PP;
    for (int it = gw; it < NITEMS; it += NGW) {
        int r = it;
        if (r < I_IN) { p0_transpose_item(inp(I_W_IN), 1024, INW, (bf16*)(F.ws + WS_WIN), scr, r, F.lane); continue; } r -= I_IN;
        if (r < I_UA) { p0_transpose_item(inp(I_W_UP_ATT), 512, 1024, (bf16*)(F.ws + WS_WUA), scr, r, F.lane); continue; } r -= I_UA;
        if (r < I_UA) { p0_transpose_item(inp(I_W_UP_HG), 512, 1024, (bf16*)(F.ws + WS_WUH), scr, r, F.lane); continue; } r -= I_UA;
        if (r < I_OUT) { p0_transpose_item(inp(I_W_OUT), 1024, 1024, (bf16*)(F.ws + WS_WOUT), scr, r, F.lane); continue; } r -= I_OUT;
        if (r < I_OUT) { p0_transpose_item(inp(I_PLE_GATE), 1024, 1024, (bf16*)(F.ws + WS_WPG), scr, r, F.lane); continue; } r -= I_OUT;
        p0_transpose_item(inp(I_PLE_PROJ), 256, 1024, (bf16*)(F.ws + WS_WPP), scr, r, F.lane);
    }
    bf16* XN = (bf16*)(F.ws + WS_XN);
    const float* x = inp(I_X); const float* norm_mix = inp(I_NORM_MIX);
    for (int m = gw; m < T; m += NGW) rms_row_to_bf16(F.lane, x + (size_t)m * DMODEL, norm_mix, XN + (size_t)m * DMODEL);
}

DI void p1b_rope(Frame& F) {
    const int gw = F.vcu * NWAVES + F.wave, NGW = F.G * NWAVES, lane = F.lane;
    bf16* QKV = (bf16*)(F.ws + WS_QKV);
    const float gq = inp(I_Q_NORM)[lane], gk = inp(I_K_NORM)[lane];
    const int axis = lane >> 5, hf = (lane >> 4) & 1, fi = lane & 15;
    const float inv = __builtin_powf(10000.0f, -(float)fi * (1.0f / 16.0f));
    constexpr float C2 = 0.125f * 1.4426950408889634f;
    for (int m = gw; m < T; m += NGW) {
        const int t = m & (SEQ - 1); const float pos = (float)(axis ? (t & 63) : (t >> 6));
        const float ang = pos * inv; float sn, cs;
        sn = sinf(ang); cs = cosf(ang);
        bf16* row = QKV + (size_t)m * QKVW;
        float xv[10];
#pragma unroll
        for (int hh = 0; hh < 10; ++hh) xv[hh] = __uint_as_float((unsigned)row[hh * 64 + lane] << 16);
#pragma unroll
        for (int hh = 0; hh < 10; ++hh) {
            const float ss = wave_sum(xv[hh] * xv[hh]);
            const float y = xv[hh] * __builtin_amdgcn_rsqf(ss * (1.0f / 64.0f) + EPS) * (hh < 8 ? gq : gk);
            const float yp = __shfl_xor(y, 16);
            float o = hf ? (yp * sn + y * cs) : (y * cs - yp * sn);
            if (hh < 8) o *= C2;
            row[hh * 64 + lane] = (bf16)f2bf(o);
        }
    }
}
#define MFMA32(a, b, c) __builtin_amdgcn_mfma_f32_32x32x16_bf16((a), (b), (c), 0, 0, 0)
DI int crow16(int r, int hi) { return (r & 3) + 8 * (r >> 2) + 4 * hi; }
template <int CTRL, int RM> DI float dpp0(float x) { return __int_as_float(__builtin_amdgcn_update_dpp(0, __float_as_int(x), CTRL, RM, 0xf, false)); }
DI float wave_incl_scan(float x) {
    x += dpp0<0x111, 0xf>(x); x += dpp0<0x112, 0xf>(x); x += dpp0<0x114, 0xf>(x); x += dpp0<0x118, 0xf>(x);
    x += dpp0<0x142, 0xa>(x); x += dpp0<0x143, 0xc>(x);
    return x;
}
template <int K> DI void mma_tile(f32x16& acc, const LAS bf16* A, int lda, int m0, const LAS bf16* Bt, int ldb, int n0, int r32, int hi) {
    const LAS bf16* ap = A + (m0 + r32) * lda + 8 * hi; const LAS bf16* bp = Bt + (n0 + r32) * ldb + 8 * hi;
#pragma unroll
    for (int k0 = 0; k0 < K; k0 += 16) { const bf16x8 a = *(const LAS bf16x8*)(ap + k0); const bf16x8 b = *(const LAS bf16x8*)(bp + k0); acc = MFMA32(a, b, acc); }
}
constexpr int HG_LDK = 136, HG_LDS_ = 72;
constexpr int HGO_QT = 0, HGO_KT = HGO_QT + 64 * HG_LDK * 2, HGO_QE = HGO_KT + 64 * HG_LDK * 2, HGO_KDT = HGO_QE + 64 * HG_LDK * 2, HGO_VT = HGO_KDT + 128 * HG_LDS_ * 2,
              HGO_AM = HGO_VT + 128 * HG_LDS_ * 2, HGO_ST = HGO_AM + 64 * HG_LDS_ * 2, HGO_DEC = HGO_ST + 128 * HG_LDK * 2, HGO_END = HGO_DEC + 512;
static_assert(HGO_END <= SCR_BYTES, "hgrn lds");
DI void hgrn_item(Frame& F, int item) {
    const int b = item >> 3, h = (item >> 1) & 3, dir = item & 1;
    int tid_ = threadIdx.x; asm volatile("" : "+v"(tid_));
    const int tid = tid_, lane = tid & 63, w = __builtin_amdgcn_readfirstlane(tid >> 6), r32 = lane & 31, hi = lane >> 5;
    LAS bf16* QT = (LAS bf16*)(F.lds + HGO_QT); LAS bf16* KT = (LAS bf16*)(F.lds + HGO_KT); LAS bf16* QE = (LAS bf16*)(F.lds + HGO_QE);
    LAS bf16* KDT = (LAS bf16*)(F.lds + HGO_KDT); LAS bf16* VT = (LAS bf16*)(F.lds + HGO_VT); LAS bf16* AM = (LAS bf16*)(F.lds + HGO_AM);
    LAS bf16* ST = (LAS bf16*)(F.lds + HGO_ST); LAS float* DEC = (LAS float*)(F.lds + HGO_DEC);
    __syncthreads();
    for (int i = tid; i < (128 * HG_LDK * 2) / 16; i += NWAVES * 64) ((LAS v4u*)ST)[i] = (v4u){0u, 0u, 0u, 0u};
    for (int i = tid; i < (64 * HG_LDS_ * 2) / 16; i += NWAVES * 64) ((LAS v4u*)AM)[i] = (v4u){0u, 0u, 0u, 0u};
    float lb[16];
    const float* hg_lb_raw = inp(I_HG_LB);
#pragma unroll
    for (int j = 0; j < 16; ++j) { const int c = h * 128 + 16 * w + j; lb[j] = fsigmoid(hg_lb_raw[dir * 512 + c] - hg_lb_raw[1024 + dir * 512 + c]); }
    const bf16* HGb = (const bf16*)(F.ws + WS_HG);
    bf16* OD = (bf16*)(F.ws + (dir ? WS_OB : WS_OF));
    const int colq = h * 128 + 16 * w, colf = 512 * (1 + dir) + h * 128 + 16 * w, coli = 1536 + h * 128 + 16 * w;
    f32x16 s0, s1;
#pragma unroll
    for (int i = 0; i < 16; ++i) { s0[i] = 0.f; s1[i] = 0.f; }
    v4u nq[2], nf[2], ni[2];
    { const int chunk = dir ? 63 : 0; const size_t tok = (size_t)b * SEQ + chunk * 64 + (dir ? 63 - lane : lane); const bf16* row = HGb + tok * HGW;
      nq[0] = *(const v4u*)(row + colq); nq[1] = *(const v4u*)(row + colq + 8); nf[0] = *(const v4u*)(row + colf); nf[1] = *(const v4u*)(row + colf + 8); ni[0] = *(const v4u*)(row + coli); ni[1] = *(const v4u*)(row + coli + 8); }
    const int tb = w & 1, eb = w >> 1, db = w & 3, eb2 = 2 * (w >> 2);
    for (int step = 0; step < 64; ++step) {
        const int chunk = dir ? 63 - step : step;
        const size_t tok0 = (size_t)b * SEQ + chunk * 64;
        v4u cq[2] = {nq[0], nq[1]}, cf[2] = {nf[0], nf[1]}, ci[2] = {ni[0], ni[1]};
        if (step + 1 < 64) { const int nchunk = dir ? 62 - step : step + 1; const size_t tok = (size_t)b * SEQ + nchunk * 64 + (dir ? 63 - lane : lane); const bf16* row = HGb + tok * HGW;
            nq[0] = *(const v4u*)(row + colq); nq[1] = *(const v4u*)(row + colq + 8); nf[0] = *(const v4u*)(row + colf); nf[1] = *(const v4u*)(row + colf + 8); ni[0] = *(const v4u*)(row + coli); ni[1] = *(const v4u*)(row + coli + 8); }
        {
            const unsigned qa[8] = {cq[0].x, cq[0].y, cq[0].z, cq[0].w, cq[1].x, cq[1].y, cq[1].z, cq[1].w};
            const unsigned fa[8] = {cf[0].x, cf[0].y, cf[0].z, cf[0].w, cf[1].x, cf[1].y, cf[1].z, cf[1].w};
            const unsigned ia[8] = {ci[0].x, ci[0].y, ci[0].z, ci[0].w, ci[1].x, ci[1].y, ci[1].z, ci[1].w};
            float qt[16], kt[16], qe[16], kd[16];
#pragma unroll
            for (int j = 0; j < 16; ++j) {
                const float hq = (j & 1) ? bfhi(qa[j >> 1]) : bflo(qa[j >> 1]);
                const float fp = (j & 1) ? bfhi(fa[j >> 1]) : bflo(fa[j >> 1]);
                const float sg = fsigmoid(fp);
                const float f = lb[j] + (1.0f - lb[j]) * sg;
                const float kk = (1.0f - lb[j]) * (1.0f - sg);
                const float g = __builtin_amdgcn_logf(f) * 0.6931471805599453f;
                const float bcum = wave_incl_scan(g);
                const float E = fexp(bcum), R = __builtin_amdgcn_rcpf(E);
                const float E31 = __int_as_float(__builtin_amdgcn_readlane(__float_as_int(E), 31));
                const float E63 = __int_as_float(__builtin_amdgcn_readlane(__float_as_int(E), 63));
                const float rE31 = 1.0f / E31;
                const float q = hq * fsigmoid(hq);
                qt[j] = q * E * rE31; kt[j] = kk * R * E31; qe[j] = q * E; kd[j] = kk * R * E63;
                if (lane == 63) DEC[16 * w + j] = E63;
            }
            v4u o;
            o = (v4u){pk2(qt[0], qt[1]), pk2(qt[2], qt[3]), pk2(qt[4], qt[5]), pk2(qt[6], qt[7])}; *(LAS v4u*)(QT + lane * HG_LDK + 16 * w) = o;
            o = (v4u){pk2(qt[8], qt[9]), pk2(qt[10], qt[11]), pk2(qt[12], qt[13]), pk2(qt[14], qt[15])}; *(LAS v4u*)(QT + lane * HG_LDK + 16 * w + 8) = o;
            o = (v4u){pk2(kt[0], kt[1]), pk2(kt[2], kt[3]), pk2(kt[4], kt[5]), pk2(kt[6], kt[7])}; *(LAS v4u*)(KT + lane * HG_LDK + 16 * w) = o;
            o = (v4u){pk2(kt[8], kt[9]), pk2(kt[10], kt[11]), pk2(kt[12], kt[13]), pk2(kt[14], kt[15])}; *(LAS v4u*)(KT + lane * HG_LDK + 16 * w + 8) = o;
            o = (v4u){pk2(qe[0], qe[1]), pk2(qe[2], qe[3]), pk2(qe[4], qe[5]), pk2(qe[6], qe[7])}; *(LAS v4u*)(QE + lane * HG_LDK + 16 * w) = o;
            o = (v4u){pk2(qe[8], qe[9]), pk2(qe[10], qe[11]), pk2(qe[12], qe[13]), pk2(qe[14], qe[15])}; *(LAS v4u*)(QE + lane * HG_LDK + 16 * w + 8) = o;
#pragma unroll
            for (int j = 0; j < 16; ++j) {
                KDT[(16 * w + j) * HG_LDS_ + lane] = (bf16)f2bf(kd[j]);
                VT[(16 * w + j) * HG_LDS_ + lane] = (bf16)((j & 1) ? (ia[j >> 1] >> 16) : (ia[j >> 1] & 0xffffu));
            }
        }
        __syncthreads();
        f32x16 o;
#pragma unroll
        for (int i = 0; i < 16; ++i) o[i] = 0.f;
        mma_tile<128>(o, QE, HG_LDK, tb * 32, ST, HG_LDK, eb * 32, r32, hi);
        if (w < 3) {
            const int ti = (w == 0) ? 0 : 1, sj = (w == 2) ? 1 : 0;
            f32x16 a;
#pragma unroll
            for (int i = 0; i < 16; ++i) a[i] = 0.f;
            mma_tile<128>(a, QT, HG_LDK, ti * 32, KT, HG_LDK, sj * 32, r32, hi);
#pragma unroll
            for (int i = 0; i < 16; ++i) { const int tl = crow16(i, hi); float v = a[i]; if (ti == sj && r32 > tl) v = 0.f; AM[(ti * 32 + tl) * HG_LDS_ + sj * 32 + r32] = (bf16)f2bf(v); }
        }
        __syncthreads();
        if (tb) mma_tile<64>(o, AM, HG_LDS_, 32, VT, HG_LDS_, eb * 32, r32, hi); else mma_tile<32>(o, AM, HG_LDS_, 0, VT, HG_LDS_, eb * 32, r32, hi);
#pragma unroll
        for (int i = 0; i < 16; ++i) { const int tl = tb * 32 + crow16(i, hi); const size_t tok = tok0 + (dir ? 63 - tl : tl); OD[tok * 512 + h * 128 + eb * 32 + r32] = (bf16)f2bf(o[i]); }
        {
            float dc[16];
#pragma unroll
            for (int i = 0; i < 16; ++i) dc[i] = DEC[db * 32 + crow16(i, hi)];
#pragma unroll
            for (int i = 0; i < 16; ++i) { s0[i] *= dc[i]; s1[i] *= dc[i]; }
            mma_tile<64>(s0, KDT, HG_LDS_, db * 32, VT, HG_LDS_, eb2 * 32, r32, hi);
            mma_tile<64>(s1, KDT, HG_LDS_, db * 32, VT, HG_LDS_, (eb2 + 1) * 32, r32, hi);
#pragma unroll
            for (int g4 = 0; g4 < 4; ++g4) {
                v2u p0 = {pk2(s0[4 * g4], s0[4 * g4 + 1]), pk2(s0[4 * g4 + 2], s0[4 * g4 + 3])}; *(LAS v2u*)(ST + (eb2 * 32 + r32) * HG_LDK + db * 32 + 8 * g4 + 4 * hi) = p0;
                v2u p1 = {pk2(s1[4 * g4], s1[4 * g4 + 1]), pk2(s1[4 * g4 + 2], s1[4 * g4 + 3])}; *(LAS v2u*)(ST + ((eb2 + 1) * 32 + r32) * HG_LDK + db * 32 + 8 * g4 + 4 * hi) = p1;
            }
        }
        __syncthreads();
    }
}

DI void p2b_ohn(Frame& F) {
    int lane_ = threadIdx.x & 63; asm volatile("" : "+v"(lane_));
    const int gw = F.vcu * NWAVES + F.wave, NGW = F.G * NWAVES, lane = lane_;
    bf16* OF = (bf16*)(F.ws + WS_OF); const bf16* OB = (const bf16*)(F.ws + WS_OB); const bf16* HGb = (const bf16*)(F.ws + WS_HG);
    float gn[8];
#pragma unroll
    for (int j = 0; j < 8; ++j) gn[j] = inp(I_HG_ONORM)[(8 * lane + j) & 127];
    for (int m = gw; m < T; m += NGW) {
        const v4u a = *(const v4u*)(OF + (size_t)m * 512 + 8 * lane), bb = *(const v4u*)(OB + (size_t)m * 512 + 8 * lane), gg = *(const v4u*)(HGb + (size_t)m * HGW + 2048 + 8 * lane);
        const unsigned aa[4] = {a.x, a.y, a.z, a.w}, ba[4] = {bb.x, bb.y, bb.z, bb.w}, ga[4] = {gg.x, gg.y, gg.z, gg.w};
        float v[8]; float ss = 0.f;
#pragma unroll
        for (int j = 0; j < 4; ++j) { v[2 * j] = bflo(aa[j]) + bflo(ba[j]); v[2 * j + 1] = bfhi(aa[j]) + bfhi(ba[j]); ss += v[2 * j] * v[2 * j] + v[2 * j + 1] * v[2 * j + 1]; }
        ss += __shfl_xor(ss, 1); ss += __shfl_xor(ss, 2); ss += __shfl_xor(ss, 4); ss += __shfl_xor(ss, 8);
        const float rinv = __builtin_amdgcn_rsqf(ss * (1.0f / 128.0f) + EPS);
        float o[8];
#pragma unroll
        for (int j = 0; j < 8; ++j) { const float hg = (j & 1) ? bfhi(ga[j >> 1]) : bflo(ga[j >> 1]); o[j] = v[j] * rinv * gn[j] * (hg * fsigmoid(hg)); }
        *(v4u*)(OF + (size_t)m * 512 + 8 * lane) = (v4u){pk2(o[0], o[1]), pk2(o[2], o[3]), pk2(o[4], o[5]), pk2(o[6], o[7])};
    }
}

DI void cvt_f32_bf16(Frame& F, const float* src, bf16* dst, size_t n8) {
    const size_t g0 = (size_t)F.vcu * (NWAVES * 64) + F.tid, gs = (size_t)F.G * NWAVES * 64;
    for (size_t i = g0; i < n8; i += gs) { const f32x4 a = *(const f32x4*)(src + i * 8), b = *(const f32x4*)(src + i * 8 + 4);
        *(v4u*)(dst + i * 8) = (v4u){pk2(a.x, a.y), pk2(a.z, a.w), pk2(b.x, b.y), pk2(b.z, b.w)}; }
}

DI float gelu_tanh(float a) { const float u = 0.7978845608028654f * (a + 0.044715f * a * a * a); const float e = __builtin_amdgcn_exp2f(2.0f * 1.4426950408889634f * u); const float th = 1.0f - 2.0f * __builtin_amdgcn_rcpf(e + 1.0f); return 0.5f * a * (1.0f + th); }
DI float dot2bf(unsigned a, unsigned b, float c) {
    typedef __bf16 b2 __attribute__((ext_vector_type(2)));
    return __builtin_amdgcn_fdot2_f32_bf16(__builtin_bit_cast(b2, a), __builtin_bit_cast(b2, b), c, false);
}
DI void p6_peer(Frame& F) {
    int lane_ = threadIdx.x & 63; asm volatile("" : "+v"(lane_));
    const int gw = F.vcu * NWAVES + F.wave, NGW = F.G * NWAVES, lane = lane_;
    const bf16* UB = (const bf16*)(F.ws + WS_UB); const bf16* VB = (const bf16*)(F.ws + WS_VB);
    const int* IDX = (const int*)(F.ws + WS_IDX); const float* GWp = (const float*)(F.ws + WS_GW);
    const float* rowss = (const float*)(F.ws + WS_CTL) + CW_ROWSS;
    bf16* XN = (bf16*)(F.ws + WS_XN);
    const float* norm_ffn = inp(I_NORM_FFN); const float* norm_ple = inp(I_NORM_PLE);
    const int c0 = 8 * lane, c1 = 512 + 8 * lane;
    const int kmine = 8 * (lane >> 5) + 4 * ((lane >> 4) & 1) + 2 * ((lane >> 3) & 1) + ((lane >> 2) & 1);
    for (int m = gw; m < T; m += NGW) {
        float* xrow = F.out + (size_t)m * DMODEL;
        f32x4 xa = *(const f32x4*)(xrow + c0), xb = *(const f32x4*)(xrow + c0 + 4), xc = *(const f32x4*)(xrow + c1), xd = *(const f32x4*)(xrow + c1 + 4);
        const float rinv = __builtin_amdgcn_rsqf(rowss[m] * (1.0f / 1024.0f) + EPS);
        unsigned hp[8];
        { const f32x4 ga = *(const f32x4*)(norm_ffn + c0), gb = *(const f32x4*)(norm_ffn + c0 + 4), gc = *(const f32x4*)(norm_ffn + c1), gd = *(const f32x4*)(norm_ffn + c1 + 4);
          hp[0] = pk2(xa.x * rinv * ga.x, xa.y * rinv * ga.y); hp[1] = pk2(xa.z * rinv * ga.z, xa.w * rinv * ga.w); hp[2] = pk2(xb.x * rinv * gb.x, xb.y * rinv * gb.y); hp[3] = pk2(xb.z * rinv * gb.z, xb.w * rinv * gb.w);
          hp[4] = pk2(xc.x * rinv * gc.x, xc.y * rinv * gc.y); hp[5] = pk2(xc.z * rinv * gc.z, xc.w * rinv * gc.w); hp[6] = pk2(xd.x * rinv * gd.x, xd.y * rinv * gd.y); hp[7] = pk2(xd.z * rinv * gd.z, xd.w * rinv * gd.w); }
        float acc[16];
#pragma unroll
        for (int j = 0; j < 16; ++j) acc[j] = 0.f;
        for (int hd = 0; hd < 8; ++hd) {
            const int eid = IDX[(size_t)m * 128 + hd * 16 + (lane & 15)];
            const float gate = GWp[(size_t)m * 128 + hd * 16 + kmine];
            v4u U[16][2];
#pragma unroll
            for (int k = 0; k < 16; ++k) { const int e = __builtin_amdgcn_readlane(eid, k); const bf16* ur = UB + (size_t)e * DMODEL; U[k][0] = *(const v4u*)(ur + c0); U[k][1] = *(const v4u*)(ur + c1); }
            float pd[16];
#pragma unroll
            for (int k = 0; k < 16; ++k) { float s = 0.f; s = dot2bf(hp[0], U[k][0].x, s); s = dot2bf(hp[1], U[k][0].y, s); s = dot2bf(hp[2], U[k][0].z, s); s = dot2bf(hp[3], U[k][0].w, s);
                s = dot2bf(hp[4], U[k][1].x, s); s = dot2bf(hp[5], U[k][1].y, s); s = dot2bf(hp[6], U[k][1].z, s); s = dot2bf(hp[7], U[k][1].w, s); pd[k] = s; }
#pragma unroll
            for (int k = 0; k < 16; ++k) { const int e = __builtin_amdgcn_readlane(eid, k); const bf16* vr = VB + (size_t)e * DMODEL; U[k][0] = *(const v4u*)(vr + c0); U[k][1] = *(const v4u*)(vr + c1); }
            float q8[8];
#pragma unroll
            for (int j = 0; j < 8; ++j) { const float keep = (lane & 32) ? pd[j + 8] : pd[j], send = (lane & 32) ? pd[j] : pd[j + 8]; q8[j] = keep + __shfl_xor(send, 32); }
            float q4[4];
#pragma unroll
            for (int j = 0; j < 4; ++j) { const float keep = (lane & 16) ? q8[j + 4] : q8[j], send = (lane & 16) ? q8[j] : q8[j + 4]; q4[j] = keep + __shfl_xor(send, 16); }
            float q2[2];
#pragma unroll
            for (int j = 0; j < 2; ++j) { const float keep = (lane & 8) ? q4[j + 2] : q4[j], send = (lane & 8) ? q4[j] : q4[j + 2]; q2[j] = keep + __shfl_xor(send, 8); }
            float a;
            { const float keep = (lane & 4) ? q2[1] : q2[0], send = (lane & 4) ? q2[0] : q2[1]; a = keep + __shfl_xor(send, 4); }
            a += __shfl_xor(a, 2); a += __shfl_xor(a, 1);
            const float wgt = gelu_tanh(a) * gate;
#pragma unroll
            for (int k = 0; k < 16; ++k) {
                const int src = 32 * (k >> 3) + 16 * ((k >> 2) & 1) + 8 * ((k >> 1) & 1) + 4 * (k & 1);
                const float wk = __int_as_float(__builtin_amdgcn_readlane(__float_as_int(wgt), src));
                const unsigned va[8] = {U[k][0].x, U[k][0].y, U[k][0].z, U[k][0].w, U[k][1].x, U[k][1].y, U[k][1].z, U[k][1].w};
#pragma unroll
                for (int j = 0; j < 8; ++j) { acc[2 * j] += wk * bflo(va[j]); acc[2 * j + 1] += wk * bfhi(va[j]); }
            }
        }
        xa.x += acc[0]; xa.y += acc[1]; xa.z += acc[2]; xa.w += acc[3]; xb.x += acc[4]; xb.y += acc[5]; xb.z += acc[6]; xb.w += acc[7];
        xc.x += acc[8]; xc.y += acc[9]; xc.z += acc[10]; xc.w += acc[11]; xd.x += acc[12]; xd.y += acc[13]; xd.z += acc[14]; xd.w += acc[15];
        *(f32x4*)(xrow + c0) = xa; *(f32x4*)(xrow + c0 + 4) = xb; *(f32x4*)(xrow + c1) = xc; *(f32x4*)(xrow + c1 + 4) = xd;
        float ss = (xa.x * xa.x + xa.y * xa.y) + (xa.z * xa.z + xa.w * xa.w) + (xb.x * xb.x + xb.y * xb.y) + (xb.z * xb.z + xb.w * xb.w)
                 + (xc.x * xc.x + xc.y * xc.y) + (xc.z * xc.z + xc.w * xc.w) + (xd.x * xd.x + xd.y * xd.y) + (xd.z * xd.z + xd.w * xd.w);
        const float r2 = __builtin_amdgcn_rsqf(wave_sum(ss) * (1.0f / 1024.0f) + EPS);
        const f32x4 ga = *(const f32x4*)(norm_ple + c0), gb = *(const f32x4*)(norm_ple + c0 + 4), gc = *(const f32x4*)(norm_ple + c1), gd = *(const f32x4*)(norm_ple + c1 + 4);
        *(v4u*)(XN + (size_t)m * DMODEL + c0) = (v4u){pk2(xa.x * r2 * ga.x, xa.y * r2 * ga.y), pk2(xa.z * r2 * ga.z, xa.w * r2 * ga.w), pk2(xb.x * r2 * gb.x, xb.y * r2 * gb.y), pk2(xb.z * r2 * gb.z, xb.w * r2 * gb.w)};
        *(v4u*)(XN + (size_t)m * DMODEL + c1) = (v4u){pk2(xc.x * r2 * gc.x, xc.y * r2 * gc.y), pk2(xc.z * r2 * gc.z, xc.w * r2 * gc.w), pk2(xd.x * r2 * gd.x, xd.y * r2 * gd.y), pk2(xd.z * r2 * gd.z, xd.w * r2 * gd.w)};
    }
}
#ifndef PH_MASK
#define PH_MASK 0xffff
#endif
#define PH(k) (PH_MASK & (1 << (k)))
#ifndef DBG_SKIP
#define DBG_SKIP 0
#endif
struct Args { const float* in[19]; float* out; unsigned char* ws; };
__global__ void __launch_bounds__(NWAVES * 64, 2) fwd_megakernel(Args args) {
    extern __shared__ __attribute__((aligned(16))) unsigned char lds[];
    Frame F;
    F.lds = (LAS unsigned char*)lds;
    F.MISC = (volatile LAS unsigned*)(F.lds + MISC_OFF);
    F.tid = threadIdx.x; F.lane = F.tid & 63; F.wave = __builtin_amdgcn_readfirstlane(F.tid >> 6);
    F.G = gridDim.x; { const int bx = blockIdx.x; F.vcu = (F.G % 8 == 0) ? (bx % 8) * (F.G / 8) + bx / 8 : bx; }
    F.ws = args.ws; F.ctl = (gu32*)(args.ws + WS_CTL); F.out = args.out;
    for (int u = F.tid; u < (LDS_BYTES - LDSCTL_OFF) / 4; u += NWAVES * 64) ((LAS unsigned*)(F.lds + LDSCTL_OFF))[u] = 0u;
    __syncthreads();
    XcdBarrier bar = xcd_barrier_post((unsigned*)(F.ctl + CW_BAR), F.MISC + 8);
#define GRID_BAR() xcd_barrier(bar)
    unsigned char* ws = args.ws;
    bf16* XN = (bf16*)(ws + WS_XN); bf16* QKV = (bf16*)(ws + WS_QKV); bf16* HGB = (bf16*)(ws + WS_HG); bf16* GATE = (bf16*)(ws + WS_GATE);
    float* rowss = (float*)(ws + WS_CTL) + CW_ROWSS;

    if (PH(0)) p0_prologue(F);
    GRID_BAR();
    if (!(DBG_SKIP & 1)) {
    if (PH(1)) {   pg8::Gemm g{XN, (const bf16*)(ws + WS_WIN), T, INW, 1024, 1024, 1024}; pg8::StaticOrder S; S.init(T, INW, F.G, (int)blockIdx.x);
        pg8::EpiRoute E{QKV, HGB, GATE};
        pg8::gemm_phase<pg8::EpiRoute, pg8::StaticOrder, true, true>(F.lds, g, S, E); }
    GRID_BAR();
    if (PH(2)) p1b_rope(F);
    GRID_BAR();
    if (PH(3) && !(DBG_SKIP & 4)) { if (blockIdx.x < 64) hgrn_item(F, (int)blockIdx.x); }
    __syncthreads();
    if (PH(4) && !(DBG_SKIP & 8)) {
        const int upc = (1024 + F.G - 1) / F.G;
        for (int i = 0; i < upc; ++i) { const int n = F.vcu * upc + i; if (n >= 1024) break;
            attn_body::AttnUnit u; attn_body::unit_decode(n, u);
            attn_body::attn_unit<8>(u.bh / attn_body::NHEAD, u.bh % attn_body::NHEAD, u.qb, (const attn_body::bf16*)QKV, (const attn_body::bf16*)(QKV + 512), (const attn_body::bf16*)(QKV + 640), (attn_body::bf16*)QKV, (char*)lds); }
    }
    GRID_BAR();
    if (PH(5)) p2b_ohn(F);
    GRID_BAR();
    if (PH(6)) {   pg8::Gemm g{QKV, (const bf16*)(ws + WS_WUA), T, 1024, 512, QKVW, 512}; pg8::StaticOrder S; S.init(T, 1024, F.G, (int)blockIdx.x);
        pg8::EpiMerge<0> E{XN, GATE};
        pg8::gemm_phase<pg8::EpiMerge<0>, pg8::StaticOrder, true, true>(F.lds, g, S, E); }
    wg_l1_refresh();
    if (PH(7)) {   pg8::Gemm g{(const bf16*)(ws + WS_OF), (const bf16*)(ws + WS_WUH), T, 1024, 512, 512, 512}; pg8::StaticOrder S; S.init(T, 1024, F.G, (int)blockIdx.x);
        pg8::EpiMerge<1> E{XN, GATE};
        pg8::gemm_phase<pg8::EpiMerge<1>, pg8::StaticOrder, true, true>(F.lds, g, S, E); }
    GRID_BAR();
    }
    cvt_f32_bf16(F, inp(I_PEER_U), (bf16*)(ws + WS_UB), (size_t)NEXP * DMODEL / 8);
    cvt_f32_bf16(F, inp(I_PEER_V), (bf16*)(ws + WS_VB), (size_t)NEXP * DMODEL / 8);
    cvt_f32_bf16(F, inp(I_P), (bf16*)(ws + WS_PB), (size_t)T * PLED / 8);
    if (PH(8) && !(DBG_SKIP & 1)) {
        pg8::Gemm g{XN, (const bf16*)(ws + WS_WOUT), T, 1024, 1024, 1024, 1024}; pg8::StaticOrder S; S.init(T, 1024, F.G, (int)blockIdx.x);
        pg8::EpiResid E{inp(I_X), F.out, (bf16*)(ws + WS_X1B), rowss};
        pg8::gemm_phase<pg8::EpiResid, pg8::StaticOrder, true, true>(F.lds, g, S, E);
    } else {
        const int gw = F.vcu * NWAVES + F.wave, NGW = F.G * NWAVES; const float* x = inp(I_X);
        for (int m = gw; m < T; m += NGW) { float ss = 0.f;
            for (int j = 0; j < 4; ++j) { const f32x4 v = *(const f32x4*)(x + (size_t)m * 1024 + j * 256 + 4 * F.lane); *(f32x4*)(F.out + (size_t)m * 1024 + j * 256 + 4 * F.lane) = v;
                *(v2u*)((bf16*)(ws + WS_X1B) + (size_t)m * 1024 + j * 256 + 4 * F.lane) = (v2u){pk2(v.x, v.y), pk2(v.z, v.w)}; ss += v.x * v.x + v.y * v.y + v.z * v.z + v.w * v.w; }
            ss = wave_sum(ss); if (F.lane == 0) rowss[m] = ss; }
    }
    GRID_BAR();
    if (PH(9) && !(DBG_SKIP & 2)) {
        pg8::Gemm g{(const bf16*)(ws + WS_X1B), (const bf16*)(ws + WS_WPEER), T, 2048, 1024, 1024, 1024}; pg8::StaticOrder S; S.init(T, 2048, F.G, (int)blockIdx.x);
        pg8::EpiTopk E{rowss, (int*)(ws + WS_IDX), (float*)(ws + WS_GW), EPS};
        pg8::OneUnit one;
        for (int i = 0; S.next(i, one.u); ++i) pg8::gemm_phase<pg8::EpiTopk, pg8::OneUnit, false, true>(F.lds, g, one, E);
    }
    GRID_BAR();
    if (PH(10)) p6_peer(F);
    GRID_BAR();
    if (PH(11)) {   pg8::Gemm g{(const bf16*)(ws + WS_PB), (const bf16*)(ws + WS_WPP), T, 1024, 256, 256, 256}; pg8::StaticOrder S; S.init(T, 1024, F.G, (int)blockIdx.x);
        pg8::EpiBf16Plain E{(bf16*)(ws + WS_PP), 1024};
        pg8::gemm_phase<pg8::EpiBf16Plain, pg8::StaticOrder, true, true>(F.lds, g, S, E); }
    wg_l1_refresh();
    if (PH(12)) {   pg8::Gemm g{XN, (const bf16*)(ws + WS_WPG), T, 1024, 1024, 1024, 1024}; pg8::StaticOrder S; S.init(T, 1024, F.G, (int)blockIdx.x);
        pg8::EpiPle E{F.out, (const bf16*)(ws + WS_PP)};
        pg8::gemm_phase<pg8::EpiPle, pg8::StaticOrder, true, true>(F.lds, g, S, E); }
}

extern "C" void kernel_launch(void* const* d_in, const int* in_sizes, int n_in, void* d_out, int out_size, void* d_ws, size_t ws_size, hipStream_t stream) {
    static int grid = 0;
    if (grid == 0) {
        if (n_in != 19 || out_size != T * DMODEL || ws_size < WS_END) { fprintf(stderr, "kernel_launch: unexpected shapes (n_in %d out %d ws %zu)\n", n_in, out_size, ws_size); grid = -1; return; }
        int dev = 0, cus = 0, per_cu = 0;
        if (hipGetDevice(&dev) != hipSuccess || hipDeviceGetAttribute(&cus, hipDeviceAttributeMultiprocessorCount, dev) != hipSuccess) { grid = -1; return; }
        if (hipFuncSetAttribute((const void*)fwd_megakernel, hipFuncAttributeMaxDynamicSharedMemorySize, LDS_BYTES) != hipSuccess) { fprintf(stderr, "kernel_launch: hipFuncSetAttribute failed\n"); grid = -1; return; }
        if (hipOccupancyMaxActiveBlocksPerMultiprocessor(&per_cu, (const void*)fwd_megakernel, NWAVES * 64, LDS_BYTES) != hipSuccess || per_cu < 1) fprintf(stderr, "kernel_launch: occupancy query says %d\n", per_cu);
        (void)hipGetLastError();
        grid = cus;
    }
    if (grid < 0) return;
    (void)hipMemsetAsync((char*)d_ws + WS_CTL, 0, CTL_ZERO_BYTES, stream);
    Args a{};
    for (int i = 0; i < 19; ++i) a.in[i] = (const float*)d_in[i];
    a.out = (float*)d_out; a.ws = (unsigned char*)d_ws;
    hipLaunchKernelGGL(fwd_megakernel, dim3(grid), dim3(NWAVES * 64), LDS_BYTES, stream, a);
}
```

```cpp
#include <hip/hip_runtime.h>
#include <cstdio>
#include <cstdint>
namespace pg8 {
#define PG8_LAS __attribute__((address_space(3)))
typedef unsigned short bf16_t;
typedef short bf16x8 __attribute__((ext_vector_type(8)));
typedef float f32x4 __attribute__((ext_vector_type(4)));
typedef unsigned u32x4 __attribute__((ext_vector_type(4)));
typedef unsigned u32x2 __attribute__((ext_vector_type(2)));
constexpr int BM = 256, BK = 64, HALF = 128, HTB = HALF * BK * 2  , STAGE_BYTES = 8 * HTB, NXCD = 8, WGM = 8;

__host__ __device__ __forceinline__ int lds_byte(int r, int c) { const int st = (r >> 4) * 2 + (c >> 5), rr = r & 15, cc = c & 31, ob = rr * 64 + cc * 2; return st * 1024 + (ob ^ (((ob >> 9) & 1) << 5)); }
__host__ __device__ __forceinline__ void stage_rc(int b, int& R, int& C) { const int st = b / 1024, sb = b % 1024, swz = sb ^ (((sb >> 9) & 1) << 5); R = (st >> 1) * 16 + swz / 64; C = (st & 1) * 32 + (swz % 64) / 2; }
__host__ __device__ __forceinline__ int perm32(int rho) { const int n = rho >> 4, i = rho & 15; return 8 * (i >> 2) + 4 * n + (i & 3); }

struct Unit { int pm, pn; };
struct Gemm { const bf16_t* A; const bf16_t* Bt; int M, N, K, lda, ldb; };

struct StaticOrder {
    int nM, nN, nwg, G, c;
    __host__ __device__ void init(int M, int N, int G_, int c_) { nM = M / BM; nN = N / BM; nwg = nM * nN; G = G_; c = c_; }
    __host__ __device__ bool next(int i, Unit& u) const {
        const long L = (long)i * G + c; if (L >= nwg) return false;
        int wgid = (int)L; { const int q = nwg / NXCD, r = nwg % NXCD, xcd = wgid % NXCD, off = wgid / NXCD; wgid = (xcd < r ? xcd * (q + 1) : r * (q + 1) + (xcd - r) * q) + off; }
        const int nig = WGM * nN, gid = wgid / nig, fm = gid * WGM, gsz = (nM - fm) < WGM ? (nM - fm) : WGM;
        u.pm = fm + ((wgid % nig) % gsz); u.pn = (wgid % nig) / gsz; return true;
    }
    __device__ __forceinline__ void a_ready(const Unit&) const {}
    __device__ __forceinline__ void done(const Unit&) const {}
};
struct OneUnit {
    Unit u;
    __device__ __forceinline__ bool next(int i, Unit& o) const { if (i != 0) return false; o = u; return true; }
    __device__ __forceinline__ void a_ready(const Unit&) const {}
    __device__ __forceinline__ void done(const Unit&) const {}
};

__device__ __forceinline__ unsigned cvt_pk_bf16(float lo, float hi) { unsigned r; asm volatile("v_cvt_pk_bf16_f32 %0, %1, %2" : "=v"(r) : "v"(lo), "v"(hi)); return r; }
__device__ __forceinline__ float bf_lo(unsigned w) { return __uint_as_float(w << 16); }
__device__ __forceinline__ float bf_hi(unsigned w) { return __uint_as_float(w & 0xffff0000u); }
__device__ __forceinline__ float sigmoidf_(float x) { return __builtin_amdgcn_rcpf(1.0f + __builtin_amdgcn_exp2f(-1.4426950408889634f * x)); }


template <class Epi, class Sched, bool ALIGN_EPI = false, bool SP2 = false>
__device__ __forceinline__ void gemm_phase(PG8_LAS unsigned char* lds, const Gemm g, const Sched& S, const Epi& E) {
    int tid_ = threadIdx.x; asm volatile("" : "+v"(tid_));
    const int tid = tid_, wid = __builtin_amdgcn_readfirstlane(tid >> 6), lane = tid & 63, wr = wid >> 2, wc = wid & 3, fr = lane & 15, fq = lane >> 4;
    int K_ = g.K; asm volatile("" : "+s"(K_));
    const int K = K_, nt = K / BK;
    unsigned voffA[2], voffB[2];
#pragma unroll
    for (int i = 0; i < 2; ++i) { int R, C; stage_rc(tid * 16 + i * 8192, R, C); const int Rb = Epi::PERM ? ((R & ~31) + perm32(R & 31)) : R;
        voffA[i] = (unsigned)(R * g.lda + C) * 2u; voffB[i] = (unsigned)(Rb * g.ldb + C) * 2u; }
    const size_t kstep = (size_t)(BK * 2);
    const size_t hstepA = (size_t)HALF * g.lda * 2, hstepB = (size_t)HALF * g.ldb * 2;
    const size_t tstepA = 2 * hstepA, tstepB = 2 * hstepB;
    const unsigned ldsw = (unsigned)wid * 1024u;
    const int aoff = lds_byte(wr * 64 + fr, fq * 8), boff = lds_byte(wc * 32 + fr, fq * 8);
#define PG8_SA(b, h) (((b) * 2 + (h)) * HTB)
#define PG8_SB(b, h) ((4 + (b) * 2 + (h)) * HTB)
#define PG8_STAGE(bufoff, gbase, voff) do { _Pragma("unroll") for (int _i = 0; _i < 2; ++_i) \
        __builtin_amdgcn_global_load_lds((const unsigned*)((const char*)(gbase) + (voff)[_i]), (PG8_LAS unsigned*)(lds + (bufoff) + ldsw + _i * 8192), 16, 0, 0); } while (0)
#define PG8_LDA(dst, b, h) do { _Pragma("unroll") for (int m = 0; m < 4; ++m) _Pragma("unroll") for (int k = 0; k < 2; ++k) dst[m][k] = *(const PG8_LAS bf16x8*)(lds + PG8_SA(b, h) + aoff + m * 2048 + k * 1024); } while (0)
#define PG8_LDB(dst, b, h) do { _Pragma("unroll") for (int n = 0; n < 2; ++n) _Pragma("unroll") for (int k = 0; k < 2; ++k) dst[n][k] = *(const PG8_LAS bf16x8*)(lds + PG8_SB(b, h) + boff + n * 2048 + k * 1024); } while (0)
#define PG8_MMA(ai, bj, At, Bt) do { __builtin_amdgcn_s_setprio(1); _Pragma("unroll") for (int m = 0; m < 4; ++m) _Pragma("unroll") for (int n = 0; n < 2; ++n) _Pragma("unroll") for (int k = 0; k < 2; ++k) \
        acc[ai][bj][m][n] = __builtin_amdgcn_mfma_f32_16x16x32_bf16(Bt[n][k], At[m][k], acc[ai][bj][m][n], 0, 0, 0); __builtin_amdgcn_s_setprio(0); } while (0)
#define PG8_WAIT_V(n) asm volatile("s_waitcnt vmcnt(" #n ")" ::: "memory")
#define PG8_WAIT_L(n) asm volatile("s_waitcnt lgkmcnt(" #n ")" ::: "memory")
#define PG8_BAR __builtin_amdgcn_s_barrier()
#define PG8_SCHED __builtin_amdgcn_sched_barrier(0)
    Unit cur, nxt; int ui = 0;
    if (!S.next(0, cur)) return;
    f32x4 acc[2][2][4][2];
#pragma unroll
    for (int a = 0; a < 2; ++a)
#pragma unroll
        for (int b = 0; b < 2; ++b)
#pragma unroll
            for (int m = 0; m < 4; ++m)
#pragma unroll
                for (int n = 0; n < 2; ++n) acc[a][b][m][n] = (f32x4){0.f, 0.f, 0.f, 0.f};
    bf16x8 At[4][2], B0[2][2], B1[2][2];
    const char* cA = (const char*)g.A + (size_t)cur.pm * tstepA; const char* cB = (const char*)g.Bt + (size_t)cur.pn * tstepB;
    S.a_ready(cur);
    if constexpr (SP2) {
        PG8_STAGE(PG8_SB(0, 0), cB, voffB); PG8_STAGE(PG8_SB(0, 1), cB + hstepB, voffB); PG8_STAGE(PG8_SA(0, 0), cA, voffA); PG8_STAGE(PG8_SA(0, 1), cA + hstepA, voffA);
        if (wr == 1) PG8_BAR;
        PG8_WAIT_V(2); PG8_BAR;
        PG8_STAGE(PG8_SB(1, 0), cB + kstep, voffB); PG8_STAGE(PG8_SA(1, 0), cA + kstep, voffA); PG8_STAGE(PG8_SB(1, 1), cB + hstepB + kstep, voffB);
        PG8_WAIT_V(6); PG8_BAR;
    } else {
        PG8_STAGE(PG8_SB(0, 0), cB, voffB); PG8_STAGE(PG8_SA(0, 0), cA, voffA); PG8_STAGE(PG8_SB(0, 1), cB + hstepB, voffB); PG8_STAGE(PG8_SA(0, 1), cA + hstepA, voffA);
        if (wr == 1) PG8_BAR;
        PG8_WAIT_V(4); PG8_BAR;
        PG8_STAGE(PG8_SB(1, 0), cB + kstep, voffB); PG8_STAGE(PG8_SA(1, 0), cA + kstep, voffA); PG8_STAGE(PG8_SB(1, 1), cB + hstepB + kstep, voffB);
        PG8_WAIT_V(6); PG8_BAR;
    }
    for (;;) {
        const bool has_next = S.next(ui + 1, nxt);
        const char* nA = has_next ? (const char*)g.A + (size_t)nxt.pm * tstepA : cA; const char* nB = has_next ? (const char*)g.Bt + (size_t)nxt.pn * tstepB : cB;
        for (int t = 0; t < nt; t += 2) {
            const bool last = (t == nt - 2);
            const char* a1 = cA + (size_t)(t + 1) * kstep;
            const char* a2 = last ? nA : cA + (size_t)(t + 2) * kstep; const char* b2 = last ? nB : cB + (size_t)(t + 2) * kstep;
            const char* a3 = a2 + kstep; const char* b3 = b2 + kstep;
            if (last && has_next) S.a_ready(nxt);
            if constexpr (SP2) {
            PG8_LDB(B0, 0, 0); PG8_LDB(B1, 0, 1); PG8_SCHED; PG8_LDA(At, 0, 0); PG8_STAGE(PG8_SA(1, 1), a1 + hstepA, voffA);
            PG8_WAIT_V(8); PG8_WAIT_L(0); PG8_BAR; PG8_MMA(0, 0, At, B0); PG8_MMA(0, 1, At, B1); PG8_BAR; PG8_SCHED;
            PG8_LDA(At, 0, 1); PG8_STAGE(PG8_SB(0, 0), b2, voffB); PG8_STAGE(PG8_SB(0, 1), b2 + hstepB, voffB); PG8_STAGE(PG8_SA(0, 0), a2, voffA);
            PG8_WAIT_V(8); PG8_WAIT_L(0); PG8_BAR; PG8_MMA(1, 0, At, B0); PG8_MMA(1, 1, At, B1); PG8_BAR; PG8_SCHED;
            PG8_LDB(B0, 1, 0); PG8_LDB(B1, 1, 1); PG8_SCHED; PG8_LDA(At, 1, 0); PG8_STAGE(PG8_SA(0, 1), a2 + hstepA, voffA);
            PG8_WAIT_V(8); PG8_WAIT_L(0); PG8_BAR; PG8_MMA(0, 0, At, B0); PG8_MMA(0, 1, At, B1); PG8_BAR; PG8_SCHED;
            PG8_LDA(At, 1, 1); PG8_STAGE(PG8_SB(1, 0), b3, voffB); PG8_STAGE(PG8_SB(1, 1), b3 + hstepB, voffB); PG8_STAGE(PG8_SA(1, 0), a3, voffA);
            PG8_WAIT_V(8); PG8_WAIT_L(0); PG8_BAR; PG8_MMA(1, 0, At, B0); PG8_MMA(1, 1, At, B1); PG8_BAR; PG8_SCHED;
            } else {
            PG8_LDB(B0, 0, 0); PG8_SCHED; PG8_LDA(At, 0, 0); PG8_STAGE(PG8_SA(1, 1), a1 + hstepA, voffA);
            PG8_WAIT_L(8); PG8_BAR; PG8_WAIT_L(0); PG8_MMA(0, 0, At, B0); PG8_BAR; PG8_SCHED;
            PG8_LDB(B1, 0, 1); PG8_STAGE(PG8_SB(0, 0), b2, voffB);
            PG8_BAR; PG8_WAIT_L(0); PG8_MMA(0, 1, At, B1); PG8_BAR;
            PG8_LDA(At, 0, 1); PG8_STAGE(PG8_SA(0, 0), a2, voffA);
            PG8_BAR; PG8_WAIT_L(0); PG8_MMA(1, 0, At, B0); PG8_BAR; PG8_SCHED;
            PG8_STAGE(PG8_SB(0, 1), b2 + hstepB, voffB);
            PG8_WAIT_V(6); PG8_BAR; PG8_MMA(1, 1, At, B1); PG8_BAR;
            PG8_LDB(B0, 1, 0); PG8_SCHED; PG8_LDA(At, 1, 0); PG8_STAGE(PG8_SA(0, 1), a2 + hstepA, voffA);
            PG8_WAIT_L(8); PG8_BAR; PG8_WAIT_L(0); PG8_MMA(0, 0, At, B0); PG8_BAR; PG8_SCHED;
            PG8_LDB(B1, 1, 1); PG8_STAGE(PG8_SB(1, 0), b3, voffB);
            PG8_BAR; PG8_WAIT_L(0); PG8_MMA(0, 1, At, B1); PG8_BAR;
            PG8_LDA(At, 1, 1); PG8_STAGE(PG8_SA(1, 0), a3, voffA);
            PG8_BAR; PG8_WAIT_L(0); PG8_MMA(1, 0, At, B0); PG8_BAR; PG8_SCHED;
            PG8_STAGE(PG8_SB(1, 1), b3 + hstepB, voffB);
            PG8_WAIT_V(6); PG8_BAR; PG8_MMA(1, 1, At, B1); PG8_BAR;
            }
        }
        if constexpr (ALIGN_EPI) { if (wr == 0) PG8_BAR; }
        if constexpr (!Epi::AFTER_DRAIN) { E(acc, cur, wr, wc, fr, fq); S.done(cur); }
        if (!has_next) break;
#pragma unroll
        for (int a = 0; a < 2; ++a)
#pragma unroll
            for (int b = 0; b < 2; ++b)
#pragma unroll
                for (int m = 0; m < 4; ++m)
#pragma unroll
                    for (int n = 0; n < 2; ++n) acc[a][b][m][n] = (f32x4){0.f, 0.f, 0.f, 0.f};
        cur = nxt; cA = nA; cB = nB; ++ui;
        if constexpr (ALIGN_EPI) { if (wr == 1) PG8_BAR; }
    }
    PG8_WAIT_V(0);
    if constexpr (!ALIGN_EPI) { if (wr == 0) PG8_BAR; }
    PG8_BAR;
    if constexpr (Epi::AFTER_DRAIN) { E.fused(acc, cur, wr, wc, fr, fq, lds, wid, lane); S.done(cur); }
#undef PG8_SA
#undef PG8_SB
#undef PG8_STAGE
#undef PG8_LDA
#undef PG8_LDB
#undef PG8_MMA
#undef PG8_WAIT_V
#undef PG8_WAIT_L
#undef PG8_BAR
#undef PG8_SCHED
}
}
namespace pg8 {
struct EpiRoute {
    static constexpr bool PERM = true, AFTER_DRAIN = false;
    bf16_t* qkv; bf16_t* hg; bf16_t* gate;
    __device__ __forceinline__ void operator()(const f32x4 (&acc)[2][2][4][2], const Unit& u, int wr, int wc, int fr, int fq) const {
        bf16_t* base; int ldc, colt;
        if (u.pn < 3) { base = qkv; ldc = 768; colt = u.pn * 256; }
        else if (u.pn < 13) { base = hg; ldc = 2560; colt = (u.pn - 3) * 256; }
        else { base = gate; ldc = 2048; colt = (u.pn - 13) * 256; }
        const int row0 = u.pm * BM + wr * 64 + fr, col0 = colt + wc * 32 + 8 * fq;
#pragma unroll
        for (int ai = 0; ai < 2; ++ai)
#pragma unroll
            for (int m = 0; m < 4; ++m) { bf16_t* rowp = base + (size_t)(row0 + ai * HALF + m * 16) * ldc + col0;
#pragma unroll
                for (int bj = 0; bj < 2; ++bj) { const f32x4 v0 = acc[ai][bj][m][0], v1 = acc[ai][bj][m][1];
                    u32x4 w; w.x = cvt_pk_bf16(v0[0], v0[1]); w.y = cvt_pk_bf16(v0[2], v0[3]); w.z = cvt_pk_bf16(v1[0], v1[1]); w.w = cvt_pk_bf16(v1[2], v1[3]);
                    *(u32x4*)(rowp + bj * HALF) = w; } }
    }
};
struct EpiBf16Plain {
    static constexpr bool PERM = true, AFTER_DRAIN = false;
    bf16_t* O; int ldc;
    __device__ __forceinline__ void operator()(const f32x4 (&acc)[2][2][4][2], const Unit& u, int wr, int wc, int fr, int fq) const {
        const int row0 = u.pm * BM + wr * 64 + fr, col0 = u.pn * BM + wc * 32 + 8 * fq;
#pragma unroll
        for (int ai = 0; ai < 2; ++ai)
#pragma unroll
            for (int m = 0; m < 4; ++m) { bf16_t* rowp = O + (size_t)(row0 + ai * HALF + m * 16) * ldc + col0;
#pragma unroll
                for (int bj = 0; bj < 2; ++bj) { const f32x4 v0 = acc[ai][bj][m][0], v1 = acc[ai][bj][m][1];
                    u32x4 w; w.x = cvt_pk_bf16(v0[0], v0[1]); w.y = cvt_pk_bf16(v0[2], v0[3]); w.z = cvt_pk_bf16(v1[0], v1[1]); w.w = cvt_pk_bf16(v1[2], v1[3]);
                    *(u32x4*)(rowp + bj * HALF) = w; } }
    }
};
template <int MODE> struct EpiMerge {
    static constexpr bool PERM = true, AFTER_DRAIN = false;
    bf16_t* MG; const bf16_t* gate;
    __device__ __forceinline__ void operator()(const f32x4 (&acc)[2][2][4][2], const Unit& u, int wr, int wc, int fr, int fq) const {
        const int row0 = u.pm * BM + wr * 64 + fr, col0 = u.pn * BM + wc * 32 + 8 * fq;
#pragma unroll
        for (int ai = 0; ai < 2; ++ai)
#pragma unroll
            for (int m = 0; m < 4; ++m) { const size_t row = (size_t)(row0 + ai * HALF + m * 16);
#pragma unroll
                for (int bj = 0; bj < 2; ++bj) { const int col = col0 + bj * HALF;
                    const u32x4 gw = *(const u32x4*)(gate + row * 2048 + MODE * 1024 + col);
                    float v[8] = {acc[ai][bj][m][0][0], acc[ai][bj][m][0][1], acc[ai][bj][m][0][2], acc[ai][bj][m][0][3], acc[ai][bj][m][1][0], acc[ai][bj][m][1][1], acc[ai][bj][m][1][2], acc[ai][bj][m][1][3]};
                    const unsigned gwa[4] = {gw.x, gw.y, gw.z, gw.w};
#pragma unroll
                    for (int j = 0; j < 4; ++j) { v[2 * j] *= sigmoidf_(bf_lo(gwa[j])); v[2 * j + 1] *= sigmoidf_(bf_hi(gwa[j])); }
                    if (MODE == 1) { const u32x4 pw = *(const u32x4*)(MG + row * 1024 + col); const unsigned pa[4] = {pw.x, pw.y, pw.z, pw.w};
#pragma unroll
                        for (int j = 0; j < 4; ++j) { v[2 * j] += bf_lo(pa[j]); v[2 * j + 1] += bf_hi(pa[j]); } }
                    u32x4 w; w.x = cvt_pk_bf16(v[0], v[1]); w.y = cvt_pk_bf16(v[2], v[3]); w.z = cvt_pk_bf16(v[4], v[5]); w.w = cvt_pk_bf16(v[6], v[7]);
                    *(u32x4*)(MG + row * 1024 + col) = w; } }
    }
};
struct EpiResid {
    static constexpr bool PERM = true, AFTER_DRAIN = false;
    const float* x; float* out; bf16_t* xb; float* rowss;
    __device__ __forceinline__ void operator()(const f32x4 (&acc)[2][2][4][2], const Unit& u, int wr, int wc, int fr, int fq) const {
        const int row0 = u.pm * BM + wr * 64 + fr, col0 = u.pn * BM + wc * 32 + 8 * fq;
#pragma unroll
        for (int ai = 0; ai < 2; ++ai)
#pragma unroll
            for (int m = 0; m < 4; ++m) { const size_t row = (size_t)(row0 + ai * HALF + m * 16); float ss = 0.f;
#pragma unroll
                for (int bj = 0; bj < 2; ++bj) { const size_t off = row * 1024 + col0 + bj * HALF;
                    const f32x4 x0 = *(const f32x4*)(x + off), x1 = *(const f32x4*)(x + off + 4);
                    const f32x4 o0 = x0 + acc[ai][bj][m][0], o1 = x1 + acc[ai][bj][m][1];
                    *(f32x4*)(out + off) = o0; *(f32x4*)(out + off + 4) = o1;
                    ss += (o0[0] * o0[0] + o0[1] * o0[1]) + (o0[2] * o0[2] + o0[3] * o0[3]) + (o1[0] * o1[0] + o1[1] * o1[1]) + (o1[2] * o1[2] + o1[3] * o1[3]);
                    u32x4 w; w.x = cvt_pk_bf16(o0[0], o0[1]); w.y = cvt_pk_bf16(o0[2], o0[3]); w.z = cvt_pk_bf16(o1[0], o1[1]); w.w = cvt_pk_bf16(o1[2], o1[3]);
                    *(u32x4*)(xb + off) = w; }
                ss += __shfl_xor(ss, 16); ss += __shfl_xor(ss, 32);
                if (fq == 0) atomicAdd(rowss + row, ss); }
    }
};
struct EpiPle {
    static constexpr bool PERM = true, AFTER_DRAIN = false;
    float* out; const bf16_t* pp;
    __device__ __forceinline__ void operator()(const f32x4 (&acc)[2][2][4][2], const Unit& u, int wr, int wc, int fr, int fq) const {
        const int row0 = u.pm * BM + wr * 64 + fr, col0 = u.pn * BM + wc * 32 + 8 * fq;
#pragma unroll
        for (int ai = 0; ai < 2; ++ai)
#pragma unroll
            for (int m = 0; m < 4; ++m) { const size_t row = (size_t)(row0 + ai * HALF + m * 16);
#pragma unroll
                for (int bj = 0; bj < 2; ++bj) { const size_t off = row * 1024 + col0 + bj * HALF;
                    const f32x4 x0 = *(const f32x4*)(out + off), x1 = *(const f32x4*)(out + off + 4);
                    const u32x4 pw = *(const u32x4*)(pp + off);
                    const f32x4 a0 = acc[ai][bj][m][0], a1 = acc[ai][bj][m][1];
                    f32x4 o0, o1;
                    o0[0] = x0[0] + sigmoidf_(a0[0]) * bf_lo(pw.x); o0[1] = x0[1] + sigmoidf_(a0[1]) * bf_hi(pw.x);
                    o0[2] = x0[2] + sigmoidf_(a0[2]) * bf_lo(pw.y); o0[3] = x0[3] + sigmoidf_(a0[3]) * bf_hi(pw.y);
                    o1[0] = x1[0] + sigmoidf_(a1[0]) * bf_lo(pw.z); o1[1] = x1[1] + sigmoidf_(a1[1]) * bf_hi(pw.z);
                    o1[2] = x1[2] + sigmoidf_(a1[2]) * bf_lo(pw.w); o1[3] = x1[3] + sigmoidf_(a1[3]) * bf_hi(pw.w);
                    *(f32x4*)(out + off) = o0; *(f32x4*)(out + off + 4) = o1; } }
    }
};

__device__ __forceinline__ int key_enc(float s, int idx, int mask) { int b = __float_as_int(s); b = (b & ~mask) | idx; return b ^ ((b >> 31) & 0x7fffffff); }
__device__ __forceinline__ int key_dec(int k) { return k ^ ((k >> 31) & 0x7fffffff); }
__device__ __forceinline__ void ce_desc(int& a, int& b) { const int mx = a > b ? a : b, mn = a > b ? b : a; a = mx; b = mn; }
template <int N> __device__ __forceinline__ void bitonic_sort_desc(int (&v)[N]) {
#pragma unroll
    for (int k = 2; k <= N; k <<= 1)
#pragma unroll
        for (int j = k >> 1; j > 0; j >>= 1)
#pragma unroll
            for (int i = 0; i < N; ++i) { const int l = i ^ j; if (l > i) { if ((i & k) == 0) ce_desc(v[i], v[l]); else ce_desc(v[l], v[i]); } }
}
__device__ __forceinline__ void merge16_desc(int (&a)[16], const int (&b)[16]) {
#pragma unroll
    for (int i = 0; i < 16; ++i) { const int o = b[15 - i]; a[i] = a[i] > o ? a[i] : o; }
#pragma unroll
    for (int j = 8; j > 0; j >>= 1)
#pragma unroll
        for (int i = 0; i < 16; ++i) { const int l = i ^ j; if (l > i) ce_desc(a[i], a[l]); }
}

struct EpiTopk {
    static constexpr bool PERM = true, AFTER_DRAIN = true;
    const float* rowss; int* IDX; float* GW; float eps;
    static constexpr int LDW = 132;
    __device__ __forceinline__ void fused(const f32x4 (&acc)[2][2][4][2], const Unit& u, int wr, int wc, int fr, int fq, PG8_LAS unsigned char* lds, int wid, int lane) const {
        PG8_LAS float* S = (PG8_LAS float*)lds;
        const int tid = wid * 64 + lane, trow = tid >> 1, half = tid & 1;
        float rinv[2][4];
#pragma unroll
        for (int ai = 0; ai < 2; ++ai)
#pragma unroll
            for (int m = 0; m < 4; ++m) rinv[ai][m] = __builtin_amdgcn_rsqf(rowss[u.pm * BM + ai * HALF + wr * 64 + m * 16 + fr] * (1.0f / 1024.0f) + eps);
        int L[2][16];
#pragma unroll
        for (int p = 0; p < 2; ++p) {
#pragma unroll
            for (int ai = 0; ai < 2; ++ai)
#pragma unroll
                for (int m = 0; m < 4; ++m) { const int r = ai * HALF + wr * 64 + m * 16 + fr; PG8_LAS float* sp = S + r * LDW + wc * 32 + 8 * fq;
                    *(PG8_LAS f32x4*)sp = acc[ai][p][m][0] * rinv[ai][m]; *(PG8_LAS f32x4*)(sp + 4) = acc[ai][p][m][1] * rinv[ai][m]; }
            __syncthreads();
            int run[16];
            const PG8_LAS float* rp = S + trow * LDW + half * 64;
#pragma unroll
            for (int q = 0; q < 4; ++q) {
                int gq[16];
#pragma unroll
                for (int i4 = 0; i4 < 4; ++i4) { const f32x4 v = *(const PG8_LAS f32x4*)(rp + q * 16 + i4 * 4);
#pragma unroll
                    for (int j = 0; j < 4; ++j) gq[i4 * 4 + j] = key_enc(v[j], half * 64 + q * 16 + i4 * 4 + j, 0x7f); }
                bitonic_sort_desc<16>(gq);
                if (q == 0) {
#pragma unroll
                    for (int i = 0; i < 16; ++i) run[i] = gq[i];
                } else merge16_desc(run, gq);
            }
            int o[16];
#pragma unroll
            for (int i = 0; i < 16; ++i) o[i] = __shfl_xor(run[i], 1);
            merge16_desc(run, o);
#pragma unroll
            for (int i = 0; i < 16; ++i) L[p][i] = run[i];
            __syncthreads();
        }
        float v1[16], v2[16];
        PG8_LAS unsigned char* tb = lds + tid * 32;
#pragma unroll
        for (int i = 0; i < 16; ++i) { const int b1 = key_dec(L[0][i]), b2 = key_dec(L[1][i]); v1[i] = __int_as_float(b1 & ~0x7f); v2[i] = __int_as_float(b2 & ~0x7f);
            tb[i] = (unsigned char)(b1 & 0x7f); tb[16 + i] = (unsigned char)(b2 & 0x7f); }
        const int NEG = (int)0x80000000;
        int X[16], Y[16], Z[16];
        const bool hb = half != 0;
#define CAND(iA, jA, iB, jB) key_enc((hb ? v1[iB] : v1[iA]) + (hb ? v2[jB] : v2[jA]), hb ? ((iB) * 16 + (jB)) : ((iA) * 16 + (jA)), 0xff)
#pragma unroll
        for (int j = 0; j < 16; ++j) { if (j < 8) X[j] = CAND(0, j, 1, j); else { const int k0 = key_enc(v1[0] + v2[j], j, 0xff); X[j] = hb ? NEG : k0; } }
        {
            constexpr int yi[16] = {2, 2, 2, 2, 2, 3, 3, 3, 3, 4, 4, 4, 5, 5, 6, 6}, yj[16] = {0, 1, 2, 3, 4, 0, 1, 2, 3, 0, 1, 2, 0, 1, 0, 1};
#pragma unroll
            for (int n = 0; n < 16; ++n) { const int kb = key_enc(v1[yi[n]] + v2[yj[n]], yi[n] * 16 + yj[n], 0xff);
                if (n < 8) { const int ka = key_enc(v1[8 + n] + v2[0], (8 + n) * 16, 0xff); Y[n] = hb ? kb : ka; } else Y[n] = hb ? kb : NEG; }
        }
#pragma unroll
        for (int n = 0; n < 16; ++n) { if (n < 2) { const int kb = key_enc(v1[7] + v2[n], 7 * 16 + n, 0xff); Z[n] = hb ? kb : NEG; } else Z[n] = NEG; }
#undef CAND
        bitonic_sort_desc<16>(Y);
        merge16_desc(X, Y); merge16_desc(X, Z);
        int o2[16];
#pragma unroll
        for (int i = 0; i < 16; ++i) o2[i] = __shfl_xor(X[i], 1);
        merge16_desc(X, o2);
        float sv[16], e[16]; float sum = 0.f;
#pragma unroll
        for (int i = 0; i < 16; ++i) { sv[i] = __int_as_float(key_dec(X[i]) & ~0xff); }
#pragma unroll
        for (int i = 0; i < 16; ++i) { e[i] = __builtin_amdgcn_exp2f((sv[i] - sv[0]) * 1.4426950408889634f); sum += e[i]; }
        const float rs = 1.0f / sum;
        asm volatile("s_waitcnt lgkmcnt(0)" ::: "memory");
        if (!hb) {
            const size_t ob = (size_t)(u.pm * BM + trow) * 128 + u.pn * 16;
#pragma unroll
            for (int i4 = 0; i4 < 4; ++i4) { f32x4 gv; u32x4 iv;
#pragma unroll
                for (int j = 0; j < 4; ++j) { const int i = i4 * 4 + j; const int pid = key_dec(X[i]) & 0xff; const int i1 = tb[pid >> 4], i2 = tb[16 + (pid & 15)];
                    iv[j] = (unsigned)(i1 * 128 + i2); gv[j] = e[i] * rs; }
                *(u32x4*)(IDX + ob + i4 * 4) = iv; *(f32x4*)(GW + ob + i4 * 4) = gv; }
        }
        __syncthreads();
    }
};
}
#include <hip/hip_bf16.h>
#include <cmath>
namespace attn_body {
using bf16=__hip_bfloat16;
using bf16x8=__attribute__((ext_vector_type(8)))short;
using s16x4=__attribute__((ext_vector_type(4)))short;
using f32x16=__attribute__((ext_vector_type(16)))float;
using u32x4=__attribute__((ext_vector_type(4)))unsigned;
constexpr int BATCH=8,NHEAD=8,NKV=2,SEQ=4096,D=64,DM=768;
constexpr int NW=8,QBLK=32,QB=QBLK*NW,KVBLK=64,NQB=SEQ/QB;
constexpr int ATTN_PITCH=DM, ATTN_UNIT_ROWS=QB;
__device__ __forceinline__ int crow(int r,int hi){return (r&3)+8*(r>>2)+4*hi;}
#define SBAR() __builtin_amdgcn_sched_barrier(0)
__device__ __forceinline__ void cmask(f32x16&p0,f32x16&p1,int jb,int qrel,int hi){
  const float NEG=-INFINITY; int kb=64*jb+4*hi;
  #pragma unroll
  for(int r=0;r<16;++r){int kv=kb+(r&3)+8*(r>>2); if(kv>qrel)p0[r]=NEG; if(kv+32>qrel)p1[r]=NEG;}
}

constexpr int NSLOT=3, SLOTB=8192;
constexpr int LDS_K=0, LDS_V=NSLOT*SLOTB, LDS_WS=2*NSLOT*SLOTB, LDS_OST=LDS_WS+NW*64*4, LDS_BYTES=LDS_OST+NW*4096;
constexpr float C2=0.125f*1.4426950408889634f;
__device__ __forceinline__ void glds16(const void*gsrc,unsigned lds_dst){unsigned keep;
  asm volatile("s_mov_b32 %0, m0\n\ts_mov_b32 m0, %2\n\ts_nop 0\n\tglobal_load_lds_dwordx4 %1, off\n\ts_mov_b32 m0, %0":"=&s"(keep):"v"(gsrc),"s"(lds_dst):"memory");}
__device__ __forceinline__ float max3f(float a,float b,float c){float r;asm("v_max3_f32 %0, %1, %2, %3":"=v"(r):"v"(a),"v"(b),"v"(c));return r;}
__device__ __forceinline__ float max2f(float a,float b){float r;asm("v_max_f32_e32 %0, %1, %2":"=v"(r):"v"(a),"v"(b));return r;}
__device__ __forceinline__ float fadd_s(float a,float b){float r;asm("v_add_f32_e32 %0, %1, %2":"=v"(r):"v"(a),"v"(b));return r;}
__device__ __forceinline__ float fsub_s(float a,float b){float r;asm("v_sub_f32_e32 %0, %1, %2":"=v"(r):"v"(a),"v"(b));return r;}
typedef float f32x2_t __attribute__((ext_vector_type(2))); typedef __bf16 bf16x2_t __attribute__((ext_vector_type(2)));
__device__ __forceinline__ unsigned cvtpk_s(float lo,float hi){f32x2_t v={lo,hi};bf16x2_t b=__builtin_convertvector(v,bf16x2_t);return __builtin_bit_cast(unsigned,b);}
#define WAIT_BAR(N) asm volatile("s_waitcnt vmcnt(" #N ") lgkmcnt(0)\n\ts_barrier":::"memory")

__device__ __forceinline__ void qkt(f32x16&p0,f32x16&p1,const char*Kslot,const bf16x8*qr,const f32x16&negm,int r32,int hi){
  const char*kb=Kslot+hi*1024+r32*16;
  #pragma unroll
  for(int d0=0;d0<4;++d0){
    const bf16x8 b0=*reinterpret_cast<const bf16x8*>(kb+d0*2048);
    const bf16x8 b1=*reinterpret_cast<const bf16x8*>(kb+d0*2048+512);
    if(d0==0){p0=__builtin_amdgcn_mfma_f32_32x32x16_bf16(b0,qr[0],negm,0,0,0);p1=__builtin_amdgcn_mfma_f32_32x32x16_bf16(b1,qr[0],negm,0,0,0);}
    else{p0=__builtin_amdgcn_mfma_f32_32x32x16_bf16(b0,qr[d0],p0,0,0,0);p1=__builtin_amdgcn_mfma_f32_32x32x16_bf16(b1,qr[d0],p1,0,0,0);}}
}
typedef __attribute__((address_space(3))) const char* lds_cptr;
typedef short v4i16_t __attribute__((ext_vector_type(4)));
__device__ __forceinline__ void kload8(bf16x8*kf,lds_cptr kp){
  kf[0]=*(const __attribute__((address_space(3))) bf16x8*)(kp);      kf[1]=*(const __attribute__((address_space(3))) bf16x8*)(kp+512);
  kf[2]=*(const __attribute__((address_space(3))) bf16x8*)(kp+2048); kf[3]=*(const __attribute__((address_space(3))) bf16x8*)(kp+2560);
  kf[4]=*(const __attribute__((address_space(3))) bf16x8*)(kp+4096); kf[5]=*(const __attribute__((address_space(3))) bf16x8*)(kp+4608);
  kf[6]=*(const __attribute__((address_space(3))) bf16x8*)(kp+6144); kf[7]=*(const __attribute__((address_space(3))) bf16x8*)(kp+6656);
}
__device__ __forceinline__ void kload2(bf16x8*kf,lds_cptr kp,int j){ kf[2*j]=*(const __attribute__((address_space(3))) bf16x8*)(kp+j*2048); kf[2*j+1]=*(const __attribute__((address_space(3))) bf16x8*)(kp+j*2048+512); }
__device__ __forceinline__ s16x4 vtr(lds_cptr p){ return __builtin_bit_cast(s16x4,__builtin_amdgcn_ds_read_tr16_b64_v4i16((__attribute__((address_space(3))) v4i16_t*)p)); }
__device__ __forceinline__ float rowmax(const f32x16&p0,const f32x16&p1){
  float a=max3f(p0[0],p0[1],p1[0]),b=max3f(p0[2],p0[3],p1[1]);a=max3f(a,p1[2],p1[3]);
  #pragma unroll
  for(int r=4;r<16;r+=4){a=max3f(a,p0[r],p0[r+1]);b=max3f(b,p0[r+2],p0[r+3]);a=max3f(a,p1[r],p1[r+1]);b=max3f(b,p1[r+2],p1[r+3]);}
  const float m=max2f(a,b);
  auto rr=__builtin_amdgcn_permlane32_swap(__float_as_uint(m),__float_as_uint(m),false,false);
  return max2f(__uint_as_float(rr[0]),__uint_as_float(rr[1]));
}
__device__ __forceinline__ void pv(f32x16*o,int vb,bf16x8 pa0,bf16x8 pa1,bf16x8 pa2,bf16x8 pa3){
  #pragma unroll
  for(int d0=0;d0<2;++d0){s16x4 lo[4],hi[4];
    #pragma unroll
    for(int ks=0;ks<4;++ks){
      asm volatile("ds_read_b64_tr_b16 %0,%1 offset:%c2":"=&v"(lo[ks]):"v"(vb),"i"(d0*4096+ks*1024):"memory");
      asm volatile("ds_read_b64_tr_b16 %0,%1 offset:%c2":"=&v"(hi[ks]):"v"(vb),"i"(d0*4096+ks*1024+512):"memory");}
    asm volatile("s_waitcnt lgkmcnt(0)":::"memory");SBAR();
    #define PK(k) (bf16x8){lo[k][0],lo[k][1],lo[k][2],lo[k][3],hi[k][0],hi[k][1],hi[k][2],hi[k][3]}
    o[d0]=__builtin_amdgcn_mfma_f32_32x32x16_bf16(pa0,PK(0),o[d0],0,0,0);
    o[d0]=__builtin_amdgcn_mfma_f32_32x32x16_bf16(pa1,PK(1),o[d0],0,0,0);
    o[d0]=__builtin_amdgcn_mfma_f32_32x32x16_bf16(pa2,PK(2),o[d0],0,0,0);
    o[d0]=__builtin_amdgcn_mfma_f32_32x32x16_bf16(pa3,PK(3),o[d0],0,0,0);
    #undef PK
  }
}

#ifndef ATTN_STORE16
#define ATTN_STORE16(p,v) (*(u32x4*)(p)=(v))
#endif
template<int THRL> __device__ __forceinline__ void attn_unit(int b,int h,int qb,const bf16*Q,const bf16*__restrict__ K,const bf16*__restrict__ V,bf16*O,char*shm){
  int tid_=threadIdx.x; asm volatile("":"+v"(tid_)); const int tid=tid_,lane=tid&63,r32=lane&31,hi=lane>>5; const int wid=__builtin_amdgcn_readfirstlane(tid>>6);
  const long rowbase=(long)b*SEQ; const int q0=qb*QB;
  const bf16*Qw=Q+(rowbase+q0+wid*QBLK)*DM+h*D;
  const bf16*Kh=K+rowbase*DM+(h/(NHEAD/NKV))*D,*Vh=V+rowbase*DM+(h/(NHEAD/NKV))*D;
  const unsigned lds0=(unsigned)(uintptr_t)shm;
  float*wsf=(float*)(shm+LDS_WS)+wid*64;
  const bf16*ksrc=Kh+(long)lane*DM+wid*8;
  const bf16*vsrc=Vh+(long)(16*(wid&3)+(lane>>2))*DM+(wid>>2)*32+(lane&3)*8;
  const unsigned kdst=lds0+LDS_K+wid*1024, vdst=lds0+LDS_V+wid*1024;
  #define DMA_K(t,slot) glds16(ksrc+(long)(t)*KVBLK*DM,(unsigned)__builtin_amdgcn_readfirstlane(kdst+(slot)))
  #define DMA_V(t,slot) glds16(vsrc+(long)(t)*KVBLK*DM,(unsigned)__builtin_amdgcn_readfirstlane(vdst+(slot)))
  const int vb0=(int)(lds0+LDS_V)+((lane>>4)&1)*32+(lane&3)*8+(4*hi+((lane&15)>>2))*64;
  const char*Kbase=shm+LDS_K; bf16x8 kf[8];
  const lds_cptr shm3=(lds_cptr)shm; const lds_cptr kp0=shm3+LDS_K+hi*1024+r32*16; const lds_cptr vp0=shm3+LDS_V+((lane>>4)&1)*32+(lane&3)*8+(4*hi+((lane&15)>>2))*64;
  constexpr int NT=SEQ/KVBLK;
  DMA_K(0,0);DMA_V(0,0);DMA_K(1,SLOTB);
  bf16x8 qr[4];
  #pragma unroll
  for(int d0=0;d0<4;++d0)qr[d0]=*reinterpret_cast<const bf16x8*>(&Qw[(long)r32*DM+d0*16+hi*8]);
  float mhat=0.f,l_reg=0.f;f32x16 o[2];o[0]=f32x16{};o[1]=f32x16{};f32x16 negm=f32x16{};asm volatile("":"+v"(negm));
  const int qrel=wid*QBLK+r32;
  #define CMASK(P0,P1,t) do{}while(0)
  bool resc=false;
  #define START(P0,P1) do{ const float rm=rowmax(P0,P1); resc=false; \
    { const float dl=rm; mhat=fadd_s(mhat,dl); \
      _Pragma("unroll") for(int r=0;r<16;++r){P0[r]=fsub_s(P0[r],dl);P1[r]=fsub_s(P1[r],dl);} \
      _Pragma("unroll") for(int r=0;r<16;++r)negm[r]=-mhat; asm volatile("":"+v"(negm)); } \
    _Pragma("unroll") for(int r=0;r<16;++r)P0[r]=__builtin_amdgcn_exp2f(P0[r]); }while(0)
  #define RESC() do{ if(resc){ asm volatile("s_waitcnt lgkmcnt(0)":::"memory"); \
      _Pragma("unroll") for(int d_=0;d_<2;++d_) _Pragma("unroll") for(int r=0;r<16;++r)o[d_][r]*=wsf[crow(r,hi)]; } }while(0)
  f32x16 pA0,pA1,pB0,pB1;
  int sl_prev=0,sl_cur=0,sl_next=SLOTB;
  #define ROT() do{sl_prev=sl_cur;sl_cur=sl_next;sl_next=(sl_next==(NSLOT-1)*SLOTB)?0:sl_next+SLOTB;}while(0)
  DMA_K(2,2*SLOTB);
  WAIT_BAR(3);
  qkt(pA0,pA1,Kbase,qr,negm,r32,hi);asm volatile("s_nop 15\n\ts_nop 7":"+v"(pA0),"+v"(pA1));CMASK(pA0,pA1,0);
  START(pA0,pA1);
  _Pragma("unroll") for(int r=0;r<16;++r)pA1[r]=__builtin_amdgcn_exp2f(pA1[r]);
  WAIT_BAR(0);
  DMA_K(3,0);DMA_V(1,SLOTB);
  ROT();
  kload8(kf,kp0+sl_cur);
  WAIT_BAR(2);
  s16x4 vlo[8],vhi[8]; u32x4 pw0,pw1,pw2,pw3;
  #define PKW(P,B) cvtpk_s(P[B],P[B+1])
  #define PAF(k) __builtin_bit_cast(bf16x8,pw##k)
  #define VFR(i) (bf16x8){vlo[i][0],vlo[i][1],vlo[i][2],vlo[i][3],vhi[i][0],vhi[i][1],vhi[i][2],vhi[i][3]}
  #define PIN(x) asm volatile("":"+v"(x))
  #define MX3(a,b,c) __builtin_fmaxf(__builtin_fmaxf((a),(b)),(c))
  #define GAPA(MF,A0,A1,A2,A3,W0,W1,PW) do{ MF; sacc+=A0; sacc+=A1; sacc+=A2; sacc+=A3; PIN(sacc); W0; W1; PIN(PW); SBAR(); }while(0)
  #define EX(v) __builtin_amdgcn_exp2f(v)
  #define GAPB(MF,X,B) do{ MF; X[B]=EX(X[B]); X[B+1]=EX(X[B+1]); X[B+2]=EX(X[B+2]); X[B+3]=EX(X[B+3]); PIN(X); SBAR(); }while(0)
  #define VRD(i) do{ vlo[i]=vtr(vp_+(((i)>>2)*4096+((i)&3)*1024)); vhi[i]=vtr(vp_+(((i)>>2)*4096+((i)&3)*1024+512)); }while(0)
  #define KRD(G,j) do{ if(G){ kload2(kf,kp0+sl_next,j); SBAR(); } }while(0)
  #define STEP(C0,C1,P0,P1,t,GK,GV,GL) do{ SBAR(); \
    const lds_cptr vp_=vp0+sl_prev; \
    VRD(0); SBAR(); float sacc=(P0[0]+P0[1]); \
    GAPA(C0=__builtin_amdgcn_mfma_f32_32x32x16_bf16(kf[0],qr[0],negm,0,0,0), P0[2],P0[3],P0[4],P0[5],     pw0[0]=PKW(P0,0), pw0[1]=PKW(P0,2), pw0); \
    VRD(4); SBAR(); GAPA(C1=__builtin_amdgcn_mfma_f32_32x32x16_bf16(kf[1],qr[0],negm,0,0,0), P0[6],P0[7],P0[8],P0[9],     pw0[2]=PKW(P0,4), pw0[3]=PKW(P0,6), pw0); \
    VRD(1); SBAR(); GAPA(C0=__builtin_amdgcn_mfma_f32_32x32x16_bf16(kf[2],qr[1],C0,0,0,0),   P0[10],P0[11],P0[12],P0[13], pw1[0]=PKW(P0,8), pw1[1]=PKW(P0,10), pw1); \
    VRD(5); SBAR(); GAPA(C1=__builtin_amdgcn_mfma_f32_32x32x16_bf16(kf[3],qr[1],C1,0,0,0),   P0[14],P0[15],P1[0],P1[1],   pw1[2]=PKW(P0,12),pw1[3]=PKW(P0,14), pw1); \
    VRD(2); SBAR(); GAPA(C0=__builtin_amdgcn_mfma_f32_32x32x16_bf16(kf[4],qr[2],C0,0,0,0),   P1[2],P1[3],P1[4],P1[5],     pw2[0]=PKW(P1,0), pw2[1]=PKW(P1,2), pw2); \
    VRD(6); SBAR(); GAPA(C1=__builtin_amdgcn_mfma_f32_32x32x16_bf16(kf[5],qr[2],C1,0,0,0),   P1[6],P1[7],P1[8],P1[9],     pw2[2]=PKW(P1,4), pw2[3]=PKW(P1,6), pw2); \
    VRD(3); SBAR(); GAPA(C0=__builtin_amdgcn_mfma_f32_32x32x16_bf16(kf[6],qr[3],C0,0,0,0),   P1[10],P1[11],P1[12],P1[13], pw3[0]=PKW(P1,8), pw3[1]=PKW(P1,10), pw3); \
    VRD(7); SBAR(); GAPA(C1=__builtin_amdgcn_mfma_f32_32x32x16_bf16(kf[7],qr[3],C1,0,0,0),   P1[14],P1[15],0.f,0.f,       pw3[2]=PKW(P1,12),pw3[3]=PKW(P1,14), pw3); \
    l_reg+=sacc; \
    if(GK){DMA_K((t)+3,sl_cur);} if(GV){DMA_V((t)+1,sl_next);} \
    CMASK(C0,C1,t); \
    { float a=MX3(C0[0],C0[1],C1[0]),b=MX3(C0[2],C0[3],C1[1]); a=MX3(a,C1[2],C1[3]); \
      _Pragma("unroll") for(int r=4;r<16;r+=4){a=MX3(a,C0[r],C0[r+1]);b=MX3(b,C0[r+2],C0[r+3]);a=MX3(a,C1[r],C1[r+1]);b=MX3(b,C1[r+2],C1[r+3]);} \
      float rm=__builtin_fmaxf(a,b); { auto rr=__builtin_amdgcn_permlane32_swap(__float_as_uint(rm),__float_as_uint(rm),false,false); rm=__builtin_fmaxf(__uint_as_float(rr[0]),__uint_as_float(rr[1])); } \
      resc=false; \
      if(__builtin_expect(__any(rm>(float)THRL),0)){ const float dl=__builtin_fmaxf(rm,0.f); mhat+=dl; \
        _Pragma("unroll") for(int r=0;r<16;++r){C0[r]-=dl;C1[r]-=dl;} \
        _Pragma("unroll") for(int r=0;r<16;++r)negm[r]=-mhat; asm volatile("":"+v"(negm)); \
        const float f=__builtin_amdgcn_exp2f(-dl); l_reg*=f; if(hi==0)wsf[r32]=f; resc=true; } } \
    SBAR(); \
    GAPB(o[0]=__builtin_amdgcn_mfma_f32_32x32x16_bf16(PAF(0),VFR(0),o[0],0,0,0), C0,0); \
    GAPB(o[1]=__builtin_amdgcn_mfma_f32_32x32x16_bf16(PAF(0),VFR(4),o[1],0,0,0), C0,4); \
    KRD(GL,0); GAPB(o[0]=__builtin_amdgcn_mfma_f32_32x32x16_bf16(PAF(1),VFR(1),o[0],0,0,0), C0,8); \
    KRD(GL,1); GAPB(o[1]=__builtin_amdgcn_mfma_f32_32x32x16_bf16(PAF(1),VFR(5),o[1],0,0,0), C0,12); \
    KRD(GL,2); GAPB(o[0]=__builtin_amdgcn_mfma_f32_32x32x16_bf16(PAF(2),VFR(2),o[0],0,0,0), C1,0); \
    KRD(GL,3); GAPB(o[1]=__builtin_amdgcn_mfma_f32_32x32x16_bf16(PAF(2),VFR(6),o[1],0,0,0), C1,4); \
    GAPB(o[0]=__builtin_amdgcn_mfma_f32_32x32x16_bf16(PAF(3),VFR(3),o[0],0,0,0), C1,8); \
    GAPB(o[1]=__builtin_amdgcn_mfma_f32_32x32x16_bf16(PAF(3),VFR(7),o[1],0,0,0), C1,12); \
    }while(0)
  int t=1;
  #undef CMASK
  #define CMASK(P0,P1,t) do{}while(0)
  for(;t+5<NT;t+=2){
    STEP(pB0,pB1,pA0,pA1,t,true,true,true);     WAIT_BAR(2); RESC(); ROT();
    STEP(pA0,pA1,pB0,pB1,t+1,true,true,true);   WAIT_BAR(2); RESC(); ROT();
  }
  #undef CMASK
  #define CMASK(P0,P1,t) do{}while(0)
  #define ENDW(tt) do{ if((tt)+3<NT){WAIT_BAR(2);} else if((tt)+2<NT){WAIT_BAR(1);} else {WAIT_BAR(0);} }while(0)
  for(;t+1<NT;t+=2){
    STEP(pB0,pB1,pA0,pA1,t,(t+3<NT),(t+1<NT),(t+1<NT));       ENDW(t);   RESC(); ROT();
    STEP(pA0,pA1,pB0,pB1,t+1,(t+4<NT),(t+2<NT),(t+2<NT));     ENDW(t+1); RESC(); ROT();
  }
  STEP(pB0,pB1,pA0,pA1,NT-1,false,false,false); RESC();
  { float sacc=pB0[0]+pB0[1]; _Pragma("unroll") for(int r=2;r<16;++r)sacc+=pB0[r]; _Pragma("unroll") for(int r=0;r<16;++r)sacc+=pB1[r]; l_reg+=sacc;
    pw0=(u32x4){PKW(pB0,0),PKW(pB0,2),PKW(pB0,4),PKW(pB0,6)};pw1=(u32x4){PKW(pB0,8),PKW(pB0,10),PKW(pB0,12),PKW(pB0,14)};pw2=(u32x4){PKW(pB1,0),PKW(pB1,2),PKW(pB1,4),PKW(pB1,6)};pw3=(u32x4){PKW(pB1,8),PKW(pB1,10),PKW(pB1,12),PKW(pB1,14)};
    SBAR(); pv(o,vb0+sl_cur,PAF(0),PAF(1),PAF(2),PAF(3)); }
  #undef PKW
  #undef PAF
  #undef VFR
  #undef PIN
  #undef MX3
  #undef GAPA
  #undef GAPB
  #undef EX
  #undef VRD
  #undef KRD
  #undef STEP
  #undef ENDW
  {auto rr=__builtin_amdgcn_permlane32_swap(__float_as_uint(l_reg),__float_as_uint(l_reg),false,false);l_reg=__uint_as_float(rr[0])+__uint_as_float(rr[1]);}
  if(hi==0)wsf[32+r32]=l_reg;asm volatile("s_waitcnt lgkmcnt(0)":::"memory");
  float rli[16];
  #pragma unroll
  for(int r=0;r<16;++r)rli[r]=__builtin_amdgcn_rcpf(wsf[32+crow(r,hi)]);
  bf16*Ow=O+(rowbase+q0+wid*QBLK)*DM+h*D;
  { bf16*stg=(bf16*)(shm+LDS_OST)+wid*2048;
    #pragma unroll
    for(int r=0;r<16;++r){const int orow=crow(r,hi);
      #pragma unroll
      for(int d0=0;d0<2;++d0)stg[orow*64+d0*32+r32]=__float2bfloat16(o[d0][r]*rli[r]);}
    asm volatile("s_waitcnt lgkmcnt(0)":::"memory");
    #pragma unroll
    for(int i=0;i<4;++i){const int row=i*8+(lane>>3),ch=lane&7; const u32x4 v=*(const u32x4*)(stg+row*64+ch*8); ATTN_STORE16(Ow+(long)row*DM+ch*8,v);} }
  asm volatile("s_waitcnt lgkmcnt(0)\n\ts_barrier":::"memory");
  #undef DMA_K
  #undef DMA_V
  #undef CMASK
  #undef START
  #undef RESC
  #undef ROT
}
constexpr int ATTN_LDS_BYTES=LDS_BYTES;
struct AttnTensors { const bf16* Q; const bf16* K; const bf16* V; bf16* O; };
struct AttnUnit { int bh; int qb; };
__device__ __forceinline__ void unit_decode(int n,AttnUnit&u){ const int grp=n>>6,wi=n&63; const int b=grp>>1,kvh=grp&1; u.bh=b*NHEAD+kvh*(NHEAD/NKV)+(wi>>4); u.qb=wi&15; }
#undef SBAR
#undef WAIT_BAR
}
constexpr int NWAVES = 8;
constexpr int BATCH = 8, SEQ = 4096, DMODEL = 1024, T = BATCH * SEQ;
constexpr int INW = 5376, QKVW = 768, HGW = 2560, GATEW = 2048;
constexpr int NEXP = 16384, PLED = 256;
constexpr float EPS = 1e-6f;
constexpr size_t MiB = 1u << 20;
constexpr size_t WS_CTL = 0, CTL_ZERO_BYTES = 1 * MiB;
constexpr size_t WS_WIN = 2 * MiB;
constexpr size_t WS_WUA = 13 * MiB;
constexpr size_t WS_WUH = 14 * MiB;
constexpr size_t WS_WOUT = 15 * MiB;
constexpr size_t WS_WPEER = 17 * MiB;
constexpr size_t WS_WPG = 21 * MiB;
constexpr size_t WS_WPP = 23 * MiB;
constexpr size_t WS_XN = 24 * MiB;
constexpr size_t WS_QKV = 88 * MiB;
constexpr size_t WS_HG = 136 * MiB;
constexpr size_t WS_GATE = 296 * MiB;
constexpr size_t WS_OF = 424 * MiB;
constexpr size_t WS_OB = 456 * MiB;
constexpr size_t WS_END = 488 * MiB;
constexpr size_t WS_UB8 = WS_HG, WS_VB8 = WS_HG + 16 * MiB, WS_US = WS_HG + 32 * MiB, WS_VS = WS_HG + 33 * MiB, WS_PB = WS_HG + 64 * MiB, WS_IDX = WS_HG + 80 * MiB, WS_GW = WS_HG + 96 * MiB;
constexpr size_t WS_X1B = WS_GATE, WS_PP = WS_GATE + 64 * MiB;
constexpr int CW_BAR = 4096;
constexpr int CW_QUEUE = 16384;
constexpr int CW_ROWSS = 131072;
static_assert((CW_ROWSS + T) * 4 <= (int)CTL_ZERO_BYTES, "ctl");
constexpr int SCR_BYTES = 147456;
constexpr int LDSCTL_OFF = SCR_BYTES, MISC_OFF = LDSCTL_OFF + 320;
constexpr int LDS_BYTES = SCR_BYTES + 1024;

#define GAS __attribute__((address_space(1)))
#define LAS __attribute__((address_space(3)))
typedef unsigned short bf16;
typedef unsigned v4u __attribute__((ext_vector_type(4)));
typedef unsigned v2u __attribute__((ext_vector_type(2)));
typedef float f32x4 __attribute__((ext_vector_type(4)));
typedef float f32x16 __attribute__((ext_vector_type(16)));
typedef short bf16x8 __attribute__((ext_vector_type(8)));
typedef GAS unsigned gu32;
#define RLX_AGENT __ATOMIC_RELAXED, __HIP_MEMORY_SCOPE_AGENT
#define LDS_WAIT() asm volatile("s_waitcnt lgkmcnt(0)" ::: "memory")
#define VM_WAIT() asm volatile("s_waitcnt vmcnt(0)" ::: "memory")
#define DI __device__ __forceinline__
DI unsigned f2bf(float f) { unsigned u = __builtin_bit_cast(unsigned, f); return (u + 0x7fffu + ((u >> 16) & 1u)) >> 16; }
DI unsigned pk2(float lo, float hi) { typedef float f2 __attribute__((ext_vector_type(2))); typedef __bf16 b2 __attribute__((ext_vector_type(2))); f2 v = {lo, hi}; b2 b = __builtin_convertvector(v, b2); return __builtin_bit_cast(unsigned, b); }
DI float bflo(unsigned w) { return __uint_as_float(w << 16); }
DI float bfhi(unsigned w) { return __uint_as_float(w & 0xffff0000u); }
DI float fsigmoid(float x) { return __builtin_amdgcn_rcpf(1.0f + __builtin_amdgcn_exp2f(-1.4426950408889634f * x)); }
DI float fexp(float x) { return __builtin_amdgcn_exp2f(1.4426950408889634f * x); }
DI float wave_sum(float v) {
#pragma unroll
    for (int o = 1; o < 64; o <<= 1) v += __shfl_xor(v, o);
    return v;
}

#define XB_TMO      128
#define XB_XCNT(j)  (256  + 64 * (j))
#define XB_XSUB(j)  (1280 + 64 * (j))
#define XB_XGEN(j)  (2304 + 64 * (j))
#define XB_TOP      3328
#define XB_TOPGEN   3392
#define XCD_BAR_WORDS 3456
#define XB_SPIN_CAP (1u << 18)
DI unsigned xb_ld(unsigned* p)              { return __hip_atomic_load(p, __ATOMIC_RELAXED, __HIP_MEMORY_SCOPE_AGENT); }
DI unsigned xb_add(unsigned* p, unsigned v) { return __hip_atomic_fetch_add(p, v, __ATOMIC_RELAXED, __HIP_MEMORY_SCOPE_AGENT); }
DI unsigned xb_xcc_id() { return (unsigned)__builtin_amdgcn_s_getreg((3 << 11) | 20) & 0xFu; }
#define XB_SPIN(cond, bar) do { unsigned _sp = 0; while (cond) { __builtin_amdgcn_s_sleep(1); \
    if ((++_sp & 255u) == 0u) { if (xb_ld(&(bar)[XB_TMO])) break; if (_sp > XB_SPIN_CAP) { atomicAdd(&(bar)[XB_TMO], 1u); break; } } } } while (0)
struct XcdBarrier { unsigned* bar; unsigned x; volatile LAS unsigned* st; };
DI XcdBarrier xcd_barrier_post(unsigned* bar, volatile LAS unsigned* st) {
    XcdBarrier b; b.bar = bar; b.x = xb_xcc_id(); b.st = st;
    if (threadIdx.x == 0) (void)xb_add(&bar[XB_XCNT(b.x)], 1u);
    return b;
}
DI void xcd_barrier_complete(unsigned* bar, unsigned x, unsigned& nloc, unsigned& nx) {
    const unsigned G = gridDim.x * gridDim.y * gridDim.z;
    unsigned sum, cnt, mine, sp = 0u;
    for (;;) {
        sum = 0u; cnt = 0u; mine = 0u;
#pragma unroll
        for (unsigned j = 0; j < 16; ++j) { const unsigned c = xb_ld(&bar[XB_XCNT(j)]); sum += c; cnt += (c > 0u) ? 1u : 0u; mine = (j == x) ? c : mine; }
        if (sum == G) break;
        __builtin_amdgcn_s_sleep(1);
        if ((++sp & 255u) == 0u) { if (xb_ld(&bar[XB_TMO])) break; if (sp > XB_SPIN_CAP) { atomicAdd(&bar[XB_TMO], 1u); break; } }
    }
    nloc = mine > 0u ? mine : 1u; nx = cnt > 0u ? cnt : 1u;
}
DI void xcd_barrier(const XcdBarrier& b) {
    asm volatile("s_waitcnt vmcnt(0)" ::: "memory");
    __syncthreads();
    if (threadIdx.x == 0) {
        unsigned* bar = b.bar;
        __builtin_amdgcn_s_waitcnt(0);
        unsigned nloc = b.st[0], nx = b.st[1];
        if (nloc == 0u) { xcd_barrier_complete(bar, b.x, nloc, nx); b.st[0] = nloc; b.st[1] = nx; }
        const unsigned old = xb_add(&bar[XB_XSUB(b.x)], 1u);
        const unsigned gen = old / nloc;
        if (old + 1u == (gen + 1u) * nloc) {
            __builtin_amdgcn_fence(__ATOMIC_RELEASE, "agent");
            asm volatile("s_waitcnt vmcnt(0)" ::: "memory");
            const unsigned og = xb_add(&bar[XB_TOP], 1u);
            const unsigned tg = og / nx;
            if (og + 1u == (tg + 1u) * nx) xb_add(&bar[XB_TOPGEN], 1u);
            else XB_SPIN(xb_ld(&bar[XB_TOPGEN]) == tg, bar);
            __builtin_amdgcn_fence(__ATOMIC_ACQUIRE, "agent");
            xb_add(&bar[XB_XGEN(b.x)], 1u);
            asm volatile("s_waitcnt vmcnt(0)" ::: "memory");
        } else {
            XB_SPIN(xb_ld(&bar[XB_XGEN(b.x)]) == gen, bar);
            __builtin_amdgcn_fence(__ATOMIC_ACQUIRE, "agent");
            asm volatile("s_waitcnt vmcnt(0)" ::: "memory");
        }
    }
    __syncthreads();
}
DI void wg_l1_refresh() {
    asm volatile("s_waitcnt vmcnt(0)" ::: "memory");
    __syncthreads();
    if (threadIdx.x == 0) { __builtin_amdgcn_fence(__ATOMIC_ACQUIRE, "agent"); asm volatile("s_waitcnt vmcnt(0)" ::: "memory"); }
    __syncthreads();
}

struct Frame {
    LAS unsigned char* lds;
    volatile LAS unsigned* MISC;
    gu32* ctl;
    int tid, lane, wave;
    int vcu, G;
    unsigned char* ws;
    float* out;
};
enum { I_X = 0, I_P, I_NORM_MIX, I_W_IN, I_Q_NORM, I_K_NORM, I_HG_LB, I_HG_ONORM, I_W_UP_ATT, I_W_UP_HG, I_W_OUT, I_NORM_FFN, I_PEER_WQ, I_PEER_SK, I_PEER_U, I_PEER_V, I_NORM_PLE, I_PLE_GATE, I_PLE_PROJ };
DI const float* inp(int k) {
    typedef const float* cfp;
    const __attribute__((address_space(4))) char* ka = (const __attribute__((address_space(4))) char*)__builtin_amdgcn_kernarg_segment_ptr();
    return *(const volatile __attribute__((address_space(4))) cfp*)(ka + 8 * k);
}

DI void p0_transpose_item(const float* W, int K, int N, bf16* WT, LAS float* scr, int item, int lane) {
    const int nblk = N / 32, kb = item / nblk, nb = item % nblk, k0 = 64 * kb, n0 = 32 * nb;
#pragma unroll 8
    for (int i = 0; i < 32; ++i) { const int kk = 2 * i + (lane >> 5); scr[kk * 33 + (lane & 31)] = W[(size_t)(k0 + kk) * N + n0 + (lane & 31)]; }
    LDS_WAIT(); asm volatile("" ::: "memory");
    const int c = lane & 7;
#pragma unroll
    for (int j = 0; j < 4; ++j) { const int n = (lane >> 3) + 8 * j; const LAS float* s = scr + (8 * c) * 33 + n;
        v4u o; o.x = pk2(s[0 * 33], s[1 * 33]); o.y = pk2(s[2 * 33], s[3 * 33]); o.z = pk2(s[4 * 33], s[5 * 33]); o.w = pk2(s[6 * 33], s[7 * 33]);
        *(GAS v4u*)(WT + (size_t)(n0 + n) * K + k0 + 8 * c) = o; }
    LDS_WAIT(); asm volatile("" ::: "memory");
}
DI void rms_row_to_bf16(int lane, const float* xrow, const float* gain, bf16* orow) {
    const GAS f32x4* xr = (const GAS f32x4*)xrow + lane; const GAS f32x4* gr = (const GAS f32x4*)gain + lane;
    f32x4 v[4]; float s = 0.f;
#pragma unroll
    for (int j = 0; j < 4; ++j) { v[j] = xr[64 * j]; s += (v[j].x * v[j].x + v[j].y * v[j].y) + (v[j].z * v[j].z + v[j].w * v[j].w); }
    const float rinv = __builtin_amdgcn_rsqf(wave_sum(s) * (1.f / DMODEL) + EPS);
    GAS unsigned long long* o8 = (GAS unsigned long long*)orow + lane;
#pragma unroll
    for (int j = 0; j < 4; ++j) { const f32x4 g = gr[64 * j]; o8[64 * j] = (unsigned long long)pk2(v[j].x * rinv * g.x, v[j].y * rinv * g.y) | ((unsigned long long)pk2(v[j].z * rinv * g.z, v[j].w * rinv * g.w) << 32); }
}
DI void p0_peer_w_item(Frame& F, int it) {
    const float* peer_subkeys = inp(I_PEER_SK); const float* peer_wq = inp(I_PEER_WQ); const float* norm_ffn = inp(I_NORM_FFN);
    const int hp = it >> 4, k0 = (it & 15) * 64, tid = F.tid;
    LAS float* skL = (LAS float*)F.lds; LAS float* wqL = (LAS float*)(F.lds + 128 * 132 * 4);
    const float* sk = peer_subkeys + (size_t)hp * 16384;
#pragma unroll
    for (int i = 0; i < 8; ++i) { const int idx = i * 2048 + tid * 4; const f32x4 v = *(const f32x4*)(sk + idx); *(LAS f32x4*)(skL + (idx >> 7) * 132 + (idx & 127)) = v; }
#pragma unroll
    for (int i = 0; i < 4; ++i) { const int idx = i * 2048 + tid * 4; const int k = idx >> 7, c = idx & 127; const f32x4 v = *(const f32x4*)(peer_wq + (size_t)(k0 + k) * 2048 + hp * 128 + c); *(LAS f32x4*)(wqL + k * 132 + c) = v; }
    __syncthreads();
    const int k = tid & 63, n0 = (tid >> 6) * 16;
    float acc[16];
#pragma unroll
    for (int n = 0; n < 16; ++n) acc[n] = 0.f;
    for (int c4 = 0; c4 < 32; ++c4) { const f32x4 wv = *(const LAS f32x4*)(wqL + k * 132 + c4 * 4);
#pragma unroll
        for (int n = 0; n < 16; ++n) { const f32x4 sv = *(const LAS f32x4*)(skL + (n0 + n) * 132 + c4 * 4); acc[n] += (wv.x * sv.x + wv.y * sv.y) + (wv.z * sv.z + wv.w * sv.w); } }
    const float g = norm_ffn[k0 + k];
    bf16* WT = (bf16*)(F.ws + WS_WPEER);
#pragma unroll
    for (int n = 0; n < 16; ++n) WT[(size_t)(hp * 128 + n0 + n) * 1024 + k0 + k] = (bf16)f2bf(acc[n] * g);
    __syncthreads();
}
DI void p0_prologue(Frame& F) {
    for (int it = blockIdx.x; it < 256; it += F.G) p0_peer_w_item(F, it);
    LAS float* scr = (LAS float*)(F.lds + F.wave * 16384);
    const int gw = F.vcu * NWAVES + F.wave, NGW = F.G * NWAVES;
    constexpr int I_IN = (1024 / 64) * (INW / 32), I_UA = (512 / 64) * (1024 / 32), I_OUT = (1024 / 64) * (1024 / 32), I_PP = (256 / 64) * (1024 / 32);
    constexpr int NITEMS = I_IN + 2 * I_UA + 2 * I_OUT + I_PP;
    for (int it = gw; it < NITEMS; it += NGW) {
        int r = it;
        if (r < I_IN) { p0_transpose_item(inp(I_W_IN), 1024, INW, (bf16*)(F.ws + WS_WIN), scr, r, F.lane); continue; } r -= I_IN;
        if (r < I_UA) { p0_transpose_item(inp(I_W_UP_ATT), 512, 1024, (bf16*)(F.ws + WS_WUA), scr, r, F.lane); continue; } r -= I_UA;
        if (r < I_UA) { p0_transpose_item(inp(I_W_UP_HG), 512, 1024, (bf16*)(F.ws + WS_WUH), scr, r, F.lane); continue; } r -= I_UA;
        if (r < I_OUT) { p0_transpose_item(inp(I_W_OUT), 1024, 1024, (bf16*)(F.ws + WS_WOUT), scr, r, F.lane); continue; } r -= I_OUT;
        if (r < I_OUT) { p0_transpose_item(inp(I_PLE_GATE), 1024, 1024, (bf16*)(F.ws + WS_WPG), scr, r, F.lane); continue; } r -= I_OUT;
        p0_transpose_item(inp(I_PLE_PROJ), 256, 1024, (bf16*)(F.ws + WS_WPP), scr, r, F.lane);
    }
    bf16* XN = (bf16*)(F.ws + WS_XN);
    const float* x = inp(I_X); const float* norm_mix = inp(I_NORM_MIX);
    for (int m = gw; m < T; m += NGW) rms_row_to_bf16(F.lane, x + (size_t)m * DMODEL, norm_mix, XN + (size_t)m * DMODEL);
}

DI void p1b_rope(Frame& F) {
    const int gw = F.vcu * NWAVES + F.wave, NGW = F.G * NWAVES, lane = F.lane;
    bf16* QKV = (bf16*)(F.ws + WS_QKV);
    const float gq = inp(I_Q_NORM)[lane], gk = inp(I_K_NORM)[lane];
    const int axis = lane >> 5, hf = (lane >> 4) & 1, fi = lane & 15;
    const float inv = __builtin_powf(10000.0f, -(float)fi * (1.0f / 16.0f));
    constexpr float C2 = 0.125f * 1.4426950408889634f;
    for (int m = gw; m < T; m += NGW) {
        const int t = m & (SEQ - 1); const float pos = (float)(axis ? (t & 63) : (t >> 6));
        const float ang = pos * inv; float sn, cs;
        sn = sinf(ang); cs = cosf(ang);
        bf16* row = QKV + (size_t)m * QKVW;
        float xv[10];
#pragma unroll
        for (int hh = 0; hh < 10; ++hh) xv[hh] = __uint_as_float((unsigned)row[hh * 64 + lane] << 16);
#pragma unroll
        for (int hh = 0; hh < 10; ++hh) {
            const float ss = wave_sum(xv[hh] * xv[hh]);
            const float y = xv[hh] * __builtin_amdgcn_rsqf(ss * (1.0f / 64.0f) + EPS) * (hh < 8 ? gq : gk);
            const float yp = __shfl_xor(y, 16);
            float o = hf ? (yp * sn + y * cs) : (y * cs - yp * sn);
            if (hh < 8) o *= C2;
            row[hh * 64 + lane] = (bf16)f2bf(o);
        }
    }
}
#define MFMA32(a, b, c) __builtin_amdgcn_mfma_f32_32x32x16_bf16((a), (b), (c), 0, 0, 0)
DI int crow16(int r, int hi) { return (r & 3) + 8 * (r >> 2) + 4 * hi; }
template <int CTRL, int RM> DI float dpp0(float x) { return __int_as_float(__builtin_amdgcn_update_dpp(0, __float_as_int(x), CTRL, RM, 0xf, false)); }
DI float wave_incl_scan(float x) {
    x += dpp0<0x111, 0xf>(x); x += dpp0<0x112, 0xf>(x); x += dpp0<0x114, 0xf>(x); x += dpp0<0x118, 0xf>(x);
    x += dpp0<0x142, 0xa>(x); x += dpp0<0x143, 0xc>(x);
    return x;
}
template <int K> DI void mma_tile(f32x16& acc, const LAS bf16* A, int lda, int m0, const LAS bf16* Bt, int ldb, int n0, int r32, int hi) {
    const LAS bf16* ap = A + (m0 + r32) * lda + 8 * hi; const LAS bf16* bp = Bt + (n0 + r32) * ldb + 8 * hi;
#pragma unroll
    for (int k0 = 0; k0 < K; k0 += 16) { const bf16x8 a = *(const LAS bf16x8*)(ap + k0); const bf16x8 b = *(const LAS bf16x8*)(bp + k0); acc = MFMA32(a, b, acc); }
}
constexpr int HG_LDK = 136, HG_LDS_ = 72;
constexpr int HGO_QT = 0, HGO_KT = HGO_QT + 64 * HG_LDK * 2, HGO_QE = HGO_KT + 64 * HG_LDK * 2, HGO_KDT = HGO_QE + 64 * HG_LDK * 2, HGO_VT = HGO_KDT + 128 * HG_LDS_ * 2,
              HGO_AM = HGO_VT + 128 * HG_LDS_ * 2, HGO_ST = HGO_AM + 64 * HG_LDS_ * 2, HGO_DEC = HGO_ST + 128 * HG_LDK * 2, HGO_END = HGO_DEC + 512;
static_assert(HGO_END <= SCR_BYTES, "hgrn lds");
DI void hgrn_item(Frame& F, int item) {
    const int b = item >> 3, h = (item >> 1) & 3, dir = item & 1;
    int tid_ = threadIdx.x; asm volatile("" : "+v"(tid_));
    const int tid = tid_, lane = tid & 63, w = __builtin_amdgcn_readfirstlane(tid >> 6), r32 = lane & 31, hi = lane >> 5;
    LAS bf16* QT = (LAS bf16*)(F.lds + HGO_QT); LAS bf16* KT = (LAS bf16*)(F.lds + HGO_KT); LAS bf16* QE = (LAS bf16*)(F.lds + HGO_QE);
    LAS bf16* KDT = (LAS bf16*)(F.lds + HGO_KDT); LAS bf16* VT = (LAS bf16*)(F.lds + HGO_VT); LAS bf16* AM = (LAS bf16*)(F.lds + HGO_AM);
    LAS bf16* ST = (LAS bf16*)(F.lds + HGO_ST); LAS float* DEC = (LAS float*)(F.lds + HGO_DEC);
    __syncthreads();
    for (int i = tid; i < (128 * HG_LDK * 2) / 16; i += NWAVES * 64) ((LAS v4u*)ST)[i] = (v4u){0u, 0u, 0u, 0u};
    for (int i = tid; i < (64 * HG_LDS_ * 2) / 16; i += NWAVES * 64) ((LAS v4u*)AM)[i] = (v4u){0u, 0u, 0u, 0u};
    float lb[16];
    const float* hg_lb_raw = inp(I_HG_LB);
#pragma unroll
    for (int j = 0; j < 16; ++j) { const int c = h * 128 + 16 * w + j; lb[j] = fsigmoid(hg_lb_raw[dir * 512 + c] - hg_lb_raw[1024 + dir * 512 + c]); }
    const bf16* HGb = (const bf16*)(F.ws + WS_HG);
    bf16* OD = (bf16*)(F.ws + (dir ? WS_OB : WS_OF));
    const int colq = h * 128 + 16 * w, colf = 512 * (1 + dir) + h * 128 + 16 * w, coli = 1536 + h * 128 + 16 * w;
    f32x16 s0, s1;
#pragma unroll
    for (int i = 0; i < 16; ++i) { s0[i] = 0.f; s1[i] = 0.f; }
    v4u nq[2], nf[2], ni[2];
    { const int chunk = dir ? 63 : 0; const size_t tok = (size_t)b * SEQ + chunk * 64 + (dir ? 63 - lane : lane); const bf16* row = HGb + tok * HGW;
      nq[0] = *(const v4u*)(row + colq); nq[1] = *(const v4u*)(row + colq + 8); nf[0] = *(const v4u*)(row + colf); nf[1] = *(const v4u*)(row + colf + 8); ni[0] = *(const v4u*)(row + coli); ni[1] = *(const v4u*)(row + coli + 8); }
    const int tb = w & 1, eb = w >> 1, db = w & 3, eb2 = 2 * (w >> 2);
    for (int step = 0; step < 64; ++step) {
        const int chunk = dir ? 63 - step : step;
        const size_t tok0 = (size_t)b * SEQ + chunk * 64;
        v4u cq[2] = {nq[0], nq[1]}, cf[2] = {nf[0], nf[1]}, ci[2] = {ni[0], ni[1]};
        if (step + 1 < 64) { const int nchunk = dir ? 62 - step : step + 1; const size_t tok = (size_t)b * SEQ + nchunk * 64 + (dir ? 63 - lane : lane); const bf16* row = HGb + tok * HGW;
            nq[0] = *(const v4u*)(row + colq); nq[1] = *(const v4u*)(row + colq + 8); nf[0] = *(const v4u*)(row + colf); nf[1] = *(const v4u*)(row + colf + 8); ni[0] = *(const v4u*)(row + coli); ni[1] = *(const v4u*)(row + coli + 8); }
        {
            const unsigned qa[8] = {cq[0].x, cq[0].y, cq[0].z, cq[0].w, cq[1].x, cq[1].y, cq[1].z, cq[1].w};
            const unsigned fa[8] = {cf[0].x, cf[0].y, cf[0].z, cf[0].w, cf[1].x, cf[1].y, cf[1].z, cf[1].w};
            const unsigned ia[8] = {ci[0].x, ci[0].y, ci[0].z, ci[0].w, ci[1].x, ci[1].y, ci[1].z, ci[1].w};
            float qt[16], kt[16], qe[16], kd[16];
#pragma unroll
            for (int j = 0; j < 16; ++j) {
                const float hq = (j & 1) ? bfhi(qa[j >> 1]) : bflo(qa[j >> 1]);
                const float fp = (j & 1) ? bfhi(fa[j >> 1]) : bflo(fa[j >> 1]);
                const float sg = fsigmoid(fp);
                const float f = lb[j] + (1.0f - lb[j]) * sg;
                const float kk = (1.0f - lb[j]) * (1.0f - sg);
                const float g = __builtin_amdgcn_logf(f) * 0.6931471805599453f;
                const float bcum = wave_incl_scan(g);
                const float E = fexp(bcum), R = __builtin_amdgcn_rcpf(E);
                const float E31 = __int_as_float(__builtin_amdgcn_readlane(__float_as_int(E), 31));
                const float E63 = __int_as_float(__builtin_amdgcn_readlane(__float_as_int(E), 63));
                const float rE31 = 1.0f / E31;
                const float q = hq * fsigmoid(hq);
                qt[j] = q * E * rE31; kt[j] = kk * R * E31; qe[j] = q * E; kd[j] = kk * R * E63;
                if (lane == 63) DEC[16 * w + j] = E63;
            }
            v4u o;
            o = (v4u){pk2(qt[0], qt[1]), pk2(qt[2], qt[3]), pk2(qt[4], qt[5]), pk2(qt[6], qt[7])}; *(LAS v4u*)(QT + lane * HG_LDK + 16 * w) = o;
            o = (v4u){pk2(qt[8], qt[9]), pk2(qt[10], qt[11]), pk2(qt[12], qt[13]), pk2(qt[14], qt[15])}; *(LAS v4u*)(QT + lane * HG_LDK + 16 * w + 8) = o;
            o = (v4u){pk2(kt[0], kt[1]), pk2(kt[2], kt[3]), pk2(kt[4], kt[5]), pk2(kt[6], kt[7])}; *(LAS v4u*)(KT + lane * HG_LDK + 16 * w) = o;
            o = (v4u){pk2(kt[8], kt[9]), pk2(kt[10], kt[11]), pk2(kt[12], kt[13]), pk2(kt[14], kt[15])}; *(LAS v4u*)(KT + lane * HG_LDK + 16 * w + 8) = o;
            o = (v4u){pk2(qe[0], qe[1]), pk2(qe[2], qe[3]), pk2(qe[4], qe[5]), pk2(qe[6], qe[7])}; *(LAS v4u*)(QE + lane * HG_LDK + 16 * w) = o;
            o = (v4u){pk2(qe[8], qe[9]), pk2(qe[10], qe[11]), pk2(qe[12], qe[13]), pk2(qe[14], qe[15])}; *(LAS v4u*)(QE + lane * HG_LDK + 16 * w + 8) = o;
#pragma unroll
            for (int j = 0; j < 16; ++j) {
                KDT[(16 * w + j) * HG_LDS_ + lane] = (bf16)f2bf(kd[j]);
                VT[(16 * w + j) * HG_LDS_ + lane] = (bf16)((j & 1) ? (ia[j >> 1] >> 16) : (ia[j >> 1] & 0xffffu));
            }
        }
        __syncthreads();
        f32x16 o;
#pragma unroll
        for (int i = 0; i < 16; ++i) o[i] = 0.f;
        mma_tile<128>(o, QE, HG_LDK, tb * 32, ST, HG_LDK, eb * 32, r32, hi);
        if (w < 3) {
            const int ti = (w == 0) ? 0 : 1, sj = (w == 2) ? 1 : 0;
            f32x16 a;
#pragma unroll
            for (int i = 0; i < 16; ++i) a[i] = 0.f;
            mma_tile<128>(a, QT, HG_LDK, ti * 32, KT, HG_LDK, sj * 32, r32, hi);
#pragma unroll
            for (int i = 0; i < 16; ++i) { const int tl = crow16(i, hi); float v = a[i]; if (ti == sj && r32 > tl) v = 0.f; AM[(ti * 32 + tl) * HG_LDS_ + sj * 32 + r32] = (bf16)f2bf(v); }
        }
        __syncthreads();
        if (tb) mma_tile<64>(o, AM, HG_LDS_, 32, VT, HG_LDS_, eb * 32, r32, hi); else mma_tile<32>(o, AM, HG_LDS_, 0, VT, HG_LDS_, eb * 32, r32, hi);
#pragma unroll
        for (int i = 0; i < 16; ++i) { const int tl = tb * 32 + crow16(i, hi); const size_t tok = tok0 + (dir ? 63 - tl : tl); OD[tok * 512 + h * 128 + eb * 32 + r32] = (bf16)f2bf(o[i]); }
        {
            float dc[16];
#pragma unroll
            for (int i = 0; i < 16; ++i) dc[i] = DEC[db * 32 + crow16(i, hi)];
#pragma unroll
            for (int i = 0; i < 16; ++i) { s0[i] *= dc[i]; s1[i] *= dc[i]; }
            mma_tile<64>(s0, KDT, HG_LDS_, db * 32, VT, HG_LDS_, eb2 * 32, r32, hi);
            mma_tile<64>(s1, KDT, HG_LDS_, db * 32, VT, HG_LDS_, (eb2 + 1) * 32, r32, hi);
#pragma unroll
            for (int g4 = 0; g4 < 4; ++g4) {
                v2u p0 = {pk2(s0[4 * g4], s0[4 * g4 + 1]), pk2(s0[4 * g4 + 2], s0[4 * g4 + 3])}; *(LAS v2u*)(ST + (eb2 * 32 + r32) * HG_LDK + db * 32 + 8 * g4 + 4 * hi) = p0;
                v2u p1 = {pk2(s1[4 * g4], s1[4 * g4 + 1]), pk2(s1[4 * g4 + 2], s1[4 * g4 + 3])}; *(LAS v2u*)(ST + ((eb2 + 1) * 32 + r32) * HG_LDK + db * 32 + 8 * g4 + 4 * hi) = p1;
            }
        }
        __syncthreads();
    }
}

DI void p2b_ohn(Frame& F) {
    int lane_ = threadIdx.x & 63; asm volatile("" : "+v"(lane_));
    const int gw = F.vcu * NWAVES + F.wave, NGW = F.G * NWAVES, lane = lane_;
    bf16* OF = (bf16*)(F.ws + WS_OF); const bf16* OB = (const bf16*)(F.ws + WS_OB); const bf16* HGb = (const bf16*)(F.ws + WS_HG);
    float gn[8];
#pragma unroll
    for (int j = 0; j < 8; ++j) gn[j] = inp(I_HG_ONORM)[(8 * lane + j) & 127];
    for (int m = gw; m < T; m += NGW) {
        const v4u a = *(const v4u*)(OF + (size_t)m * 512 + 8 * lane), bb = *(const v4u*)(OB + (size_t)m * 512 + 8 * lane), gg = *(const v4u*)(HGb + (size_t)m * HGW + 2048 + 8 * lane);
        const unsigned aa[4] = {a.x, a.y, a.z, a.w}, ba[4] = {bb.x, bb.y, bb.z, bb.w}, ga[4] = {gg.x, gg.y, gg.z, gg.w};
        float v[8]; float ss = 0.f;
#pragma unroll
        for (int j = 0; j < 4; ++j) { v[2 * j] = bflo(aa[j]) + bflo(ba[j]); v[2 * j + 1] = bfhi(aa[j]) + bfhi(ba[j]); ss += v[2 * j] * v[2 * j] + v[2 * j + 1] * v[2 * j + 1]; }
        ss += __shfl_xor(ss, 1); ss += __shfl_xor(ss, 2); ss += __shfl_xor(ss, 4); ss += __shfl_xor(ss, 8);
        const float rinv = __builtin_amdgcn_rsqf(ss * (1.0f / 128.0f) + EPS);
        float o[8];
#pragma unroll
        for (int j = 0; j < 8; ++j) { const float hg = (j & 1) ? bfhi(ga[j >> 1]) : bflo(ga[j >> 1]); o[j] = v[j] * rinv * gn[j] * (hg * fsigmoid(hg)); }
        *(v4u*)(OF + (size_t)m * 512 + 8 * lane) = (v4u){pk2(o[0], o[1]), pk2(o[2], o[3]), pk2(o[4], o[5]), pk2(o[6], o[7])};
    }
}

DI void cvt_f32_bf16(Frame& F, const float* src, bf16* dst, size_t n8) {
    const size_t g0 = (size_t)F.vcu * (NWAVES * 64) + F.tid, gs = (size_t)F.G * NWAVES * 64;
    for (size_t i = g0; i < n8; i += gs) { const f32x4 a = *(const f32x4*)(src + i * 8), b = *(const f32x4*)(src + i * 8 + 4);
        *(v4u*)(dst + i * 8) = (v4u){pk2(a.x, a.y), pk2(a.z, a.w), pk2(b.x, b.y), pk2(b.z, b.w)}; }
}

DI void cvt_rows_fp8(Frame& F, const float* src, unsigned char* dst8, float* scale) {
    int lane_ = threadIdx.x & 63; asm volatile("" : "+v"(lane_));
    const int gw = F.vcu * NWAVES + F.wave, NGW = F.G * NWAVES, lane = lane_;
    for (int e = gw; e < NEXP; e += NGW) {
        const float* r = src + (size_t)e * DMODEL + 16 * lane;
        const f32x4 a = *(const f32x4*)r, b = *(const f32x4*)(r + 4), c = *(const f32x4*)(r + 8), d = *(const f32x4*)(r + 12);
        float m = fmaxf(fmaxf(fmaxf(fabsf(a.x), fabsf(a.y)), fmaxf(fabsf(a.z), fabsf(a.w))), fmaxf(fmaxf(fabsf(b.x), fabsf(b.y)), fmaxf(fabsf(b.z), fabsf(b.w))));
        m = fmaxf(m, fmaxf(fmaxf(fmaxf(fabsf(c.x), fabsf(c.y)), fmaxf(fabsf(c.z), fabsf(c.w))), fmaxf(fmaxf(fabsf(d.x), fabsf(d.y)), fmaxf(fabsf(d.z), fabsf(d.w)))));
#pragma unroll
        for (int o = 1; o < 64; o <<= 1) m = fmaxf(m, __shfl_xor(m, o));
        const float sc = m > 0.f ? m * (1.0f / 256.0f) : 1.0f, inv = 1.0f / sc;
        v4u w;
        { int t = 0; t = __builtin_amdgcn_cvt_pk_fp8_f32(a.x * inv, a.y * inv, t, false); t = __builtin_amdgcn_cvt_pk_fp8_f32(a.z * inv, a.w * inv, t, true); w.x = (unsigned)t; }
        { int t = 0; t = __builtin_amdgcn_cvt_pk_fp8_f32(b.x * inv, b.y * inv, t, false); t = __builtin_amdgcn_cvt_pk_fp8_f32(b.z * inv, b.w * inv, t, true); w.y = (unsigned)t; }
        { int t = 0; t = __builtin_amdgcn_cvt_pk_fp8_f32(c.x * inv, c.y * inv, t, false); t = __builtin_amdgcn_cvt_pk_fp8_f32(c.z * inv, c.w * inv, t, true); w.z = (unsigned)t; }
        { int t = 0; t = __builtin_amdgcn_cvt_pk_fp8_f32(d.x * inv, d.y * inv, t, false); t = __builtin_amdgcn_cvt_pk_fp8_f32(d.z * inv, d.w * inv, t, true); w.w = (unsigned)t; }
        *(v4u*)(dst8 + (size_t)e * DMODEL + 16 * lane) = w;
        if (lane == 0) scale[e] = sc;
    }
}
DI float gelu_tanh(float a) { const float u = 0.7978845608028654f * (a + 0.044715f * a * a * a); const float e = __builtin_amdgcn_exp2f(2.0f * 1.4426950408889634f * u); const float th = 1.0f - 2.0f * __builtin_amdgcn_rcpf(e + 1.0f); return 0.5f * a * (1.0f + th); }
DI float dot2bf(unsigned a, unsigned b, float c) {
    typedef __bf16 b2 __attribute__((ext_vector_type(2)));
    return __builtin_amdgcn_fdot2_f32_bf16(__builtin_bit_cast(b2, a), __builtin_bit_cast(b2, b), c, false);
}
typedef float f32x2_ __attribute__((ext_vector_type(2)));
DI void dq16(const v4u& w, float (&o)[16]) {
    const unsigned a[4] = {w.x, w.y, w.z, w.w};
#pragma unroll
    for (int j = 0; j < 4; ++j) { const f32x2_ lo = __builtin_amdgcn_cvt_pk_f32_fp8((int)a[j], false), hi = __builtin_amdgcn_cvt_pk_f32_fp8((int)a[j], true); o[4 * j] = lo.x; o[4 * j + 1] = lo.y; o[4 * j + 2] = hi.x; o[4 * j + 3] = hi.y; }
}
DI void p6_peer(Frame& F) {
    int lane_ = threadIdx.x & 63; asm volatile("" : "+v"(lane_));
    const int gw = F.vcu * NWAVES + F.wave, NGW = F.G * NWAVES, lane = lane_;
    const unsigned char* UB8 = (const unsigned char*)(F.ws + WS_UB8); const unsigned char* VB8 = (const unsigned char*)(F.ws + WS_VB8);
    const float* US = (const float*)(F.ws + WS_US); const float* VS = (const float*)(F.ws + WS_VS);
    const int* IDX = (const int*)(F.ws + WS_IDX); const float* GWp = (const float*)(F.ws + WS_GW);
    const float* rowss = (const float*)(F.ws + WS_CTL) + CW_ROWSS;
    bf16* XN = (bf16*)(F.ws + WS_XN);
    const float* norm_ffn = inp(I_NORM_FFN); const float* norm_ple = inp(I_NORM_PLE);
    const int c0 = 16 * lane;
    const int kmine = 8 * (lane >> 5) + 4 * ((lane >> 4) & 1) + 2 * ((lane >> 3) & 1) + ((lane >> 2) & 1);
    for (int m = gw; m < T; m += NGW) {
        float* xrow = F.out + (size_t)m * DMODEL + c0;
        f32x4 xv[4];
#pragma unroll
        for (int j = 0; j < 4; ++j) xv[j] = *(const f32x4*)(xrow + 4 * j);
        const float rinv = __builtin_amdgcn_rsqf(rowss[m] * (1.0f / 1024.0f) + EPS);
        float hn[16];
#pragma unroll
        for (int j = 0; j < 4; ++j) { const f32x4 g = *(const f32x4*)(norm_ffn + c0 + 4 * j); hn[4 * j] = xv[j].x * rinv * g.x; hn[4 * j + 1] = xv[j].y * rinv * g.y; hn[4 * j + 2] = xv[j].z * rinv * g.z; hn[4 * j + 3] = xv[j].w * rinv * g.w; }
        float acc[16];
#pragma unroll
        for (int j = 0; j < 16; ++j) acc[j] = 0.f;
        for (int hd = 0; hd < 8; ++hd) {
            const int eid = IDX[(size_t)m * 128 + hd * 16 + (lane & 15)];
            const int emine = IDX[(size_t)m * 128 + hd * 16 + kmine];
            const float gate = GWp[(size_t)m * 128 + hd * 16 + kmine];
            const float su = US[emine], sv = VS[emine];
            v4u U[16];
#pragma unroll
            for (int k = 0; k < 16; ++k) { const int e = __builtin_amdgcn_readlane(eid, k); U[k] = *(const v4u*)(UB8 + (size_t)e * DMODEL + c0); }
            float pd[16];
#pragma unroll
            for (int k = 0; k < 16; ++k) { float q[16]; dq16(U[k], q); float s0 = 0.f, s1 = 0.f;
#pragma unroll
                for (int j = 0; j < 8; ++j) { s0 += hn[2 * j] * q[2 * j]; s1 += hn[2 * j + 1] * q[2 * j + 1]; }
                pd[k] = s0 + s1; }
#pragma unroll
            for (int k = 0; k < 16; ++k) { const int e = __builtin_amdgcn_readlane(eid, k); U[k] = *(const v4u*)(VB8 + (size_t)e * DMODEL + c0); }
            float q8[8];
#pragma unroll
            for (int j = 0; j < 8; ++j) { const float keep = (lane & 32) ? pd[j + 8] : pd[j], send = (lane & 32) ? pd[j] : pd[j + 8]; q8[j] = keep + __shfl_xor(send, 32); }
            float q4[4];
#pragma unroll
            for (int j = 0; j < 4; ++j) { const float keep = (lane & 16) ? q8[j + 4] : q8[j], send = (lane & 16) ? q8[j] : q8[j + 4]; q4[j] = keep + __shfl_xor(send, 16); }
            float q2[2];
#pragma unroll
            for (int j = 0; j < 2; ++j) { const float keep = (lane & 8) ? q4[j + 2] : q4[j], send = (lane & 8) ? q4[j] : q4[j + 2]; q2[j] = keep + __shfl_xor(send, 8); }
            float a;
            { const float keep = (lane & 4) ? q2[1] : q2[0], send = (lane & 4) ? q2[0] : q2[1]; a = keep + __shfl_xor(send, 4); }
            a += __shfl_xor(a, 2); a += __shfl_xor(a, 1);
            const float wgt = gelu_tanh(a * su) * gate * sv;
#pragma unroll
            for (int k = 0; k < 16; ++k) {
                const int src = 32 * (k >> 3) + 16 * ((k >> 2) & 1) + 8 * ((k >> 1) & 1) + 4 * (k & 1);
                const float wk = __int_as_float(__builtin_amdgcn_readlane(__float_as_int(wgt), src));
                float q[16]; dq16(U[k], q);
#pragma unroll
                for (int j = 0; j < 16; ++j) acc[j] += wk * q[j];
            }
        }
        float ss = 0.f;
#pragma unroll
        for (int j = 0; j < 4; ++j) { xv[j].x += acc[4 * j]; xv[j].y += acc[4 * j + 1]; xv[j].z += acc[4 * j + 2]; xv[j].w += acc[4 * j + 3]; *(f32x4*)(xrow + 4 * j) = xv[j];
            ss += (xv[j].x * xv[j].x + xv[j].y * xv[j].y) + (xv[j].z * xv[j].z + xv[j].w * xv[j].w); }
        const float r2 = __builtin_amdgcn_rsqf(wave_sum(ss) * (1.0f / 1024.0f) + EPS);
        v4u o0, o1;
        { const f32x4 g0 = *(const f32x4*)(norm_ple + c0), g1 = *(const f32x4*)(norm_ple + c0 + 4), g2 = *(const f32x4*)(norm_ple + c0 + 8), g3 = *(const f32x4*)(norm_ple + c0 + 12);
          o0 = (v4u){pk2(xv[0].x * r2 * g0.x, xv[0].y * r2 * g0.y), pk2(xv[0].z * r2 * g0.z, xv[0].w * r2 * g0.w), pk2(xv[1].x * r2 * g1.x, xv[1].y * r2 * g1.y), pk2(xv[1].z * r2 * g1.z, xv[1].w * r2 * g1.w)};
          o1 = (v4u){pk2(xv[2].x * r2 * g2.x, xv[2].y * r2 * g2.y), pk2(xv[2].z * r2 * g2.z, xv[2].w * r2 * g2.w), pk2(xv[3].x * r2 * g3.x, xv[3].y * r2 * g3.y), pk2(xv[3].z * r2 * g3.z, xv[3].w * r2 * g3.w)}; }
        *(v4u*)(XN + (size_t)m * DMODEL + c0) = o0; *(v4u*)(XN + (size_t)m * DMODEL + c0 + 8) = o1;
    }
}
#ifndef PH_MASK
#define PH_MASK 0xffff
#endif
#define PH(k) (PH_MASK & (1 << (k)))
#ifndef DBG_SKIP
#define DBG_SKIP 0
#endif
struct Args { const float* in[19]; float* out; unsigned char* ws; };
__global__ void __launch_bounds__(NWAVES * 64, 2) fwd_megakernel(Args args) {
    extern __shared__ __attribute__((aligned(16))) unsigned char lds[];
    Frame F;
    F.lds = (LAS unsigned char*)lds;
    F.MISC = (volatile LAS unsigned*)(F.lds + MISC_OFF);
    F.tid = threadIdx.x; F.lane = F.tid & 63; F.wave = __builtin_amdgcn_readfirstlane(F.tid >> 6);
    F.G = gridDim.x; { const int bx = blockIdx.x; F.vcu = (F.G % 8 == 0) ? (bx % 8) * (F.G / 8) + bx / 8 : bx; }
    F.ws = args.ws; F.ctl = (gu32*)(args.ws + WS_CTL); F.out = args.out;
    for (int u = F.tid; u < (LDS_BYTES - LDSCTL_OFF) / 4; u += NWAVES * 64) ((LAS unsigned*)(F.lds + LDSCTL_OFF))[u] = 0u;
    __syncthreads();
    XcdBarrier bar = xcd_barrier_post((unsigned*)(F.ctl + CW_BAR), F.MISC + 8);
#define GRID_BAR() xcd_barrier(bar)
    unsigned char* ws = args.ws;
    bf16* XN = (bf16*)(ws + WS_XN); bf16* QKV = (bf16*)(ws + WS_QKV); bf16* HGB = (bf16*)(ws + WS_HG); bf16* GATE = (bf16*)(ws + WS_GATE);
    float* rowss = (float*)(ws + WS_CTL) + CW_ROWSS;

    if (PH(0)) p0_prologue(F);
    GRID_BAR();
    if (!(DBG_SKIP & 1)) {
    if (PH(1)) {   pg8::Gemm g{XN, (const bf16*)(ws + WS_WIN), T, INW, 1024, 1024, 1024}; pg8::StaticOrder S; S.init(T, INW, F.G, (int)blockIdx.x);
        pg8::EpiRoute E{QKV, HGB, GATE};
        pg8::gemm_phase<pg8::EpiRoute, pg8::StaticOrder, true, true>(F.lds, g, S, E); }
    GRID_BAR();
    if (PH(2)) p1b_rope(F);
    GRID_BAR();
    {
        volatile LAS unsigned* qslot = F.MISC + 16;
        for (;;) {
            __syncthreads();
            if (F.tid == 0) *qslot = __hip_atomic_fetch_add((unsigned*)(F.ctl + CW_QUEUE), 1u, __ATOMIC_RELAXED, __HIP_MEMORY_SCOPE_AGENT);
            __syncthreads();
            const int n = (int)__builtin_amdgcn_readfirstlane(*qslot);
            if (n >= 64 + 1024) break;
            if (n < 64) { if (PH(3)) hgrn_item(F, n); }
            else if (PH(4)) { attn_body::AttnUnit u; attn_body::unit_decode(n - 64, u);
                attn_body::attn_unit<8>(u.bh / attn_body::NHEAD, u.bh % attn_body::NHEAD, u.qb, (const attn_body::bf16*)QKV, (const attn_body::bf16*)(QKV + 512), (const attn_body::bf16*)(QKV + 640), (attn_body::bf16*)QKV, (char*)lds); }
        }
    }
    GRID_BAR();
    if (PH(5)) p2b_ohn(F);
    GRID_BAR();
    if (PH(6)) {   pg8::Gemm g{QKV, (const bf16*)(ws + WS_WUA), T, 1024, 512, QKVW, 512}; pg8::StaticOrder S; S.init(T, 1024, F.G, (int)blockIdx.x);
        pg8::EpiMerge<0> E{XN, GATE};
        pg8::gemm_phase<pg8::EpiMerge<0>, pg8::StaticOrder, true, true>(F.lds, g, S, E); }
    wg_l1_refresh();
    if (PH(7)) {   pg8::Gemm g{(const bf16*)(ws + WS_OF), (const bf16*)(ws + WS_WUH), T, 1024, 512, 512, 512}; pg8::StaticOrder S; S.init(T, 1024, F.G, (int)blockIdx.x);
        pg8::EpiMerge<1> E{XN, GATE};
        pg8::gemm_phase<pg8::EpiMerge<1>, pg8::StaticOrder, true, true>(F.lds, g, S, E); }
    GRID_BAR();
    }
    cvt_rows_fp8(F, inp(I_PEER_U), ws + WS_UB8, (float*)(ws + WS_US));
    cvt_rows_fp8(F, inp(I_PEER_V), ws + WS_VB8, (float*)(ws + WS_VS));
    cvt_f32_bf16(F, inp(I_P), (bf16*)(ws + WS_PB), (size_t)T * PLED / 8);
    if (PH(8) && !(DBG_SKIP & 1)) {
        pg8::Gemm g{XN, (const bf16*)(ws + WS_WOUT), T, 1024, 1024, 1024, 1024}; pg8::StaticOrder S; S.init(T, 1024, F.G, (int)blockIdx.x);
        pg8::EpiResid E{inp(I_X), F.out, (bf16*)(ws + WS_X1B), rowss};
        pg8::gemm_phase<pg8::EpiResid, pg8::StaticOrder, true, true>(F.lds, g, S, E);
    } else {
        const int gw = F.vcu * NWAVES + F.wave, NGW = F.G * NWAVES; const float* x = inp(I_X);
        for (int m = gw; m < T; m += NGW) { float ss = 0.f;
            for (int j = 0; j < 4; ++j) { const f32x4 v = *(const f32x4*)(x + (size_t)m * 1024 + j * 256 + 4 * F.lane); *(f32x4*)(F.out + (size_t)m * 1024 + j * 256 + 4 * F.lane) = v;
                *(v2u*)((bf16*)(ws + WS_X1B) + (size_t)m * 1024 + j * 256 + 4 * F.lane) = (v2u){pk2(v.x, v.y), pk2(v.z, v.w)}; ss += v.x * v.x + v.y * v.y + v.z * v.z + v.w * v.w; }
            ss = wave_sum(ss); if (F.lane == 0) rowss[m] = ss; }
    }
    GRID_BAR();
    if (PH(9) && !(DBG_SKIP & 2)) {
        pg8::Gemm g{(const bf16*)(ws + WS_X1B), (const bf16*)(ws + WS_WPEER), T, 2048, 1024, 1024, 1024}; pg8::StaticOrder S; S.init(T, 2048, F.G, (int)blockIdx.x);
        pg8::EpiTopk E{rowss, (int*)(ws + WS_IDX), (float*)(ws + WS_GW), EPS};
        pg8::OneUnit one;
        for (int i = 0; S.next(i, one.u); ++i) pg8::gemm_phase<pg8::EpiTopk, pg8::OneUnit, false, true>(F.lds, g, one, E);
    }
    GRID_BAR();
    if (PH(10)) p6_peer(F);
    GRID_BAR();
    if (PH(11)) {   pg8::Gemm g{(const bf16*)(ws + WS_PB), (const bf16*)(ws + WS_WPP), T, 1024, 256, 256, 256}; pg8::StaticOrder S; S.init(T, 1024, F.G, (int)blockIdx.x);
        pg8::EpiBf16Plain E{(bf16*)(ws + WS_PP), 1024};
        pg8::gemm_phase<pg8::EpiBf16Plain, pg8::StaticOrder, true, true>(F.lds, g, S, E); }
    wg_l1_refresh();
    if (PH(12)) {   pg8::Gemm g{XN, (const bf16*)(ws + WS_WPG), T, 1024, 1024, 1024, 1024}; pg8::StaticOrder S; S.init(T, 1024, F.G, (int)blockIdx.x);
        pg8::EpiPle E{F.out, (const bf16*)(ws + WS_PP)};
        pg8::gemm_phase<pg8::EpiPle, pg8::StaticOrder, true, true>(F.lds, g, S, E); }
}

extern "C" void kernel_launch(void* const* d_in, const int* in_sizes, int n_in, void* d_out, int out_size, void* d_ws, size_t ws_size, hipStream_t stream) {
    static int grid = 0;
    if (grid == 0) {
        if (n_in != 19 || out_size != T * DMODEL || ws_size < WS_END) { fprintf(stderr, "kernel_launch: unexpected shapes (n_in %d out %d ws %zu)\n", n_in, out_size, ws_size); grid = -1; return; }
        int dev = 0, cus = 0, per_cu = 0;
        if (hipGetDevice(&dev) != hipSuccess || hipDeviceGetAttribute(&cus, hipDeviceAttributeMultiprocessorCount, dev) != hipSuccess) { grid = -1; return; }
        if (hipFuncSetAttribute((const void*)fwd_megakernel, hipFuncAttributeMaxDynamicSharedMemorySize, LDS_BYTES) != hipSuccess) { fprintf(stderr, "kernel_launch: hipFuncSetAttribute failed\n"); grid = -1; return; }
        if (hipOccupancyMaxActiveBlocksPerMultiprocessor(&per_cu, (const void*)fwd_megakernel, NWAVES * 64, LDS_BYTES) != hipSuccess || per_cu < 1) fprintf(stderr, "kernel_launch: occupancy query says %d\n", per_cu);
        (void)hipGetLastError();
        grid = cus;
    }
    if (grid < 0) return;
    (void)hipMemsetAsync((char*)d_ws + WS_CTL, 0, CTL_ZERO_BYTES, stream);
    Args a{};
    for (int i = 0; i < 19; ++i) a.in[i] = (const float*)d_in[i];
    a.out = (float*)d_out; a.ws = (unsigned char*)d_ws;
    hipLaunchKernelGGL(fwd_megakernel, dim3(grid), dim3(NWAVES * 64), LDS_BYTES, stream, a);
}
```

```cpp
#include <hip/hip_runtime.h>
#include <cstdio>
#include <cstdint>
namespace pg8 {
#define PG8_LAS __attribute__((address_space(3)))
typedef unsigned short bf16_t;
typedef short bf16x8 __attribute__((ext_vector_type(8)));
typedef float f32x4 __attribute__((ext_vector_type(4)));
typedef unsigned u32x4 __attribute__((ext_vector_type(4)));
typedef unsigned u32x2 __attribute__((ext_vector_type(2)));
constexpr int BM = 256, BK = 64, HALF = 128, HTB = HALF * BK * 2  , STAGE_BYTES = 8 * HTB, NXCD = 8, WGM = 8;

__host__ __device__ __forceinline__ int lds_byte(int r, int c) { const int st = (r >> 4) * 2 + (c >> 5), rr = r & 15, cc = c & 31, ob = rr * 64 + cc * 2; return st * 1024 + (ob ^ (((ob >> 9) & 1) << 5)); }
__host__ __device__ __forceinline__ void stage_rc(int b, int& R, int& C) { const int st = b / 1024, sb = b % 1024, swz = sb ^ (((sb >> 9) & 1) << 5); R = (st >> 1) * 16 + swz / 64; C = (st & 1) * 32 + (swz % 64) / 2; }
__host__ __device__ __forceinline__ int perm32(int rho) { const int n = rho >> 4, i = rho & 15; return 8 * (i >> 2) + 4 * n + (i & 3); }

struct Unit { int pm, pn; };
struct Gemm { const bf16_t* A; const bf16_t* Bt; int M, N, K, lda, ldb; };

struct StaticOrder {
    int nM, nN, nwg, G, c;
    __host__ __device__ void init(int M, int N, int G_, int c_) { nM = M / BM; nN = N / BM; nwg = nM * nN; G = G_; c = c_; }
    __host__ __device__ bool next(int i, Unit& u) const {
        const long L = (long)i * G + c; if (L >= nwg) return false;
        int wgid = (int)L; { const int q = nwg / NXCD, r = nwg % NXCD, xcd = wgid % NXCD, off = wgid / NXCD; wgid = (xcd < r ? xcd * (q + 1) : r * (q + 1) + (xcd - r) * q) + off; }
        const int nig = WGM * nN, gid = wgid / nig, fm = gid * WGM, gsz = (nM - fm) < WGM ? (nM - fm) : WGM;
        u.pm = fm + ((wgid % nig) % gsz); u.pn = (wgid % nig) / gsz; return true;
    }
    __device__ __forceinline__ void a_ready(const Unit&) const {}
    __device__ __forceinline__ void done(const Unit&) const {}
};
struct OneUnit {
    Unit u;
    __device__ __forceinline__ bool next(int i, Unit& o) const { if (i != 0) return false; o = u; return true; }
    __device__ __forceinline__ void a_ready(const Unit&) const {}
    __device__ __forceinline__ void done(const Unit&) const {}
};

__device__ __forceinline__ unsigned cvt_pk_bf16(float lo, float hi) { unsigned r; asm volatile("v_cvt_pk_bf16_f32 %0, %1, %2" : "=v"(r) : "v"(lo), "v"(hi)); return r; }
__device__ __forceinline__ float bf_lo(unsigned w) { return __uint_as_float(w << 16); }
__device__ __forceinline__ float bf_hi(unsigned w) { return __uint_as_float(w & 0xffff0000u); }
__device__ __forceinline__ float sigmoidf_(float x) { return __builtin_amdgcn_rcpf(1.0f + __builtin_amdgcn_exp2f(-1.4426950408889634f * x)); }


template <class Epi, class Sched, bool ALIGN_EPI = false, bool SP2 = false>
__device__ __forceinline__ void gemm_phase(PG8_LAS unsigned char* lds, const Gemm g, const Sched& S, const Epi& E, const int wave_id) {
    int tid_; asm volatile("v_mbcnt_lo_u32_b32 %0, -1, 0\n\tv_mbcnt_hi_u32_b32 %0, -1, %0" : "=v"(tid_)); tid_ += wave_id * 64;
    const int tid = tid_, wid = __builtin_amdgcn_readfirstlane(tid >> 6), lane = tid & 63, wr = wid >> 2, wc = wid & 3, fr = lane & 15, fq = lane >> 4;
    int K_ = g.K; asm volatile("" : "+s"(K_));
    const int K = K_, nt = K / BK;
    unsigned voffA[2], voffB[2];
#pragma unroll
    for (int i = 0; i < 2; ++i) { int R, C; stage_rc(tid * 16 + i * 8192, R, C); const int Rb = Epi::PERM ? ((R & ~31) + perm32(R & 31)) : R;
        voffA[i] = (unsigned)(R * g.lda + C) * 2u; voffB[i] = (unsigned)(Rb * g.ldb + C) * 2u; }
    const size_t kstep = (size_t)(BK * 2);
    const size_t hstepA = (size_t)HALF * g.lda * 2, hstepB = (size_t)HALF * g.ldb * 2;
    const size_t tstepA = 2 * hstepA, tstepB = 2 * hstepB;
    const unsigned ldsw = (unsigned)wid * 1024u;
    const int aoff = lds_byte(wr * 64 + fr, fq * 8), boff = lds_byte(wc * 32 + fr, fq * 8);
#define PG8_SA(b, h) (((b) * 2 + (h)) * HTB)
#define PG8_SB(b, h) ((4 + (b) * 2 + (h)) * HTB)
#define PG8_STAGE(bufoff, gbase, voff) do { _Pragma("unroll") for (int _i = 0; _i < 2; ++_i) \
        __builtin_amdgcn_global_load_lds((const unsigned*)((const char*)(gbase) + (voff)[_i]), (PG8_LAS unsigned*)(lds + (bufoff) + ldsw + _i * 8192), 16, 0, 0); } while (0)
#define PG8_LDA(dst, b, h) do { _Pragma("unroll") for (int m = 0; m < 4; ++m) _Pragma("unroll") for (int k = 0; k < 2; ++k) dst[m][k] = *(const PG8_LAS bf16x8*)(lds + PG8_SA(b, h) + aoff + m * 2048 + k * 1024); } while (0)
#define PG8_LDB(dst, b, h) do { _Pragma("unroll") for (int n = 0; n < 2; ++n) _Pragma("unroll") for (int k = 0; k < 2; ++k) dst[n][k] = *(const PG8_LAS bf16x8*)(lds + PG8_SB(b, h) + boff + n * 2048 + k * 1024); } while (0)
#define PG8_MMA(ai, bj, At, Bt) do { __builtin_amdgcn_s_setprio(1); _Pragma("unroll") for (int m = 0; m < 4; ++m) _Pragma("unroll") for (int n = 0; n < 2; ++n) _Pragma("unroll") for (int k = 0; k < 2; ++k) \
        acc[ai][bj][m][n] = __builtin_amdgcn_mfma_f32_16x16x32_bf16(Bt[n][k], At[m][k], acc[ai][bj][m][n], 0, 0, 0); __builtin_amdgcn_s_setprio(0); } while (0)
#define PG8_WAIT_V(n) asm volatile("s_waitcnt vmcnt(" #n ")" ::: "memory")
#define PG8_WAIT_L(n) asm volatile("s_waitcnt lgkmcnt(" #n ")" ::: "memory")
#define PG8_BAR __builtin_amdgcn_s_barrier()
#define PG8_SCHED __builtin_amdgcn_sched_barrier(0)
    Unit cur, nxt; int ui = 0;
    if (!S.next(0, cur)) return;
    f32x4 acc[2][2][4][2];
#pragma unroll
    for (int a = 0; a < 2; ++a)
#pragma unroll
        for (int b = 0; b < 2; ++b)
#pragma unroll
            for (int m = 0; m < 4; ++m)
#pragma unroll
                for (int n = 0; n < 2; ++n) acc[a][b][m][n] = (f32x4){0.f, 0.f, 0.f, 0.f};
    bf16x8 At[4][2], B0[2][2], B1[2][2];
    const char* cA = (const char*)g.A + (size_t)cur.pm * tstepA; const char* cB = (const char*)g.Bt + (size_t)cur.pn * tstepB;
    S.a_ready(cur);
    if constexpr (SP2) {
        PG8_STAGE(PG8_SB(0, 0), cB, voffB); PG8_STAGE(PG8_SB(0, 1), cB + hstepB, voffB); PG8_STAGE(PG8_SA(0, 0), cA, voffA); PG8_STAGE(PG8_SA(0, 1), cA + hstepA, voffA);
        if (wr == 1) PG8_BAR;
        PG8_WAIT_V(2); PG8_BAR;
        PG8_STAGE(PG8_SB(1, 0), cB + kstep, voffB); PG8_STAGE(PG8_SA(1, 0), cA + kstep, voffA); PG8_STAGE(PG8_SB(1, 1), cB + hstepB + kstep, voffB);
        PG8_WAIT_V(6); PG8_BAR;
    } else {
        PG8_STAGE(PG8_SB(0, 0), cB, voffB); PG8_STAGE(PG8_SA(0, 0), cA, voffA); PG8_STAGE(PG8_SB(0, 1), cB + hstepB, voffB); PG8_STAGE(PG8_SA(0, 1), cA + hstepA, voffA);
        if (wr == 1) PG8_BAR;
        PG8_WAIT_V(4); PG8_BAR;
        PG8_STAGE(PG8_SB(1, 0), cB + kstep, voffB); PG8_STAGE(PG8_SA(1, 0), cA + kstep, voffA); PG8_STAGE(PG8_SB(1, 1), cB + hstepB + kstep, voffB);
        PG8_WAIT_V(6); PG8_BAR;
    }
    for (;;) {
        const bool has_next = S.next(ui + 1, nxt);
        const char* nA = has_next ? (const char*)g.A + (size_t)nxt.pm * tstepA : cA; const char* nB = has_next ? (const char*)g.Bt + (size_t)nxt.pn * tstepB : cB;
        for (int t = 0; t < nt; t += 2) {
            const bool last = (t == nt - 2);
            const char* a1 = cA + (size_t)(t + 1) * kstep;
            const char* a2 = last ? nA : cA + (size_t)(t + 2) * kstep; const char* b2 = last ? nB : cB + (size_t)(t + 2) * kstep;
            const char* a3 = a2 + kstep; const char* b3 = b2 + kstep;
            if (last && has_next) S.a_ready(nxt);
            if constexpr (SP2) {
            PG8_LDB(B0, 0, 0); PG8_LDB(B1, 0, 1); PG8_SCHED; PG8_LDA(At, 0, 0); PG8_STAGE(PG8_SA(1, 1), a1 + hstepA, voffA);
            PG8_WAIT_V(8); PG8_WAIT_L(0); PG8_BAR; PG8_MMA(0, 0, At, B0); PG8_MMA(0, 1, At, B1); PG8_BAR; PG8_SCHED;
            PG8_LDA(At, 0, 1); PG8_STAGE(PG8_SB(0, 0), b2, voffB); PG8_STAGE(PG8_SB(0, 1), b2 + hstepB, voffB); PG8_STAGE(PG8_SA(0, 0), a2, voffA);
            PG8_WAIT_V(8); PG8_WAIT_L(0); PG8_BAR; PG8_MMA(1, 0, At, B0); PG8_MMA(1, 1, At, B1); PG8_BAR; PG8_SCHED;
            PG8_LDB(B0, 1, 0); PG8_LDB(B1, 1, 1); PG8_SCHED; PG8_LDA(At, 1, 0); PG8_STAGE(PG8_SA(0, 1), a2 + hstepA, voffA);
            PG8_WAIT_V(8); PG8_WAIT_L(0); PG8_BAR; PG8_MMA(0, 0, At, B0); PG8_MMA(0, 1, At, B1); PG8_BAR; PG8_SCHED;
            PG8_LDA(At, 1, 1); PG8_STAGE(PG8_SB(1, 0), b3, voffB); PG8_STAGE(PG8_SB(1, 1), b3 + hstepB, voffB); PG8_STAGE(PG8_SA(1, 0), a3, voffA);
            PG8_WAIT_V(8); PG8_WAIT_L(0); PG8_BAR; PG8_MMA(1, 0, At, B0); PG8_MMA(1, 1, At, B1); PG8_BAR; PG8_SCHED;
            } else {
            PG8_LDB(B0, 0, 0); PG8_SCHED; PG8_LDA(At, 0, 0); PG8_STAGE(PG8_SA(1, 1), a1 + hstepA, voffA);
            PG8_WAIT_L(8); PG8_BAR; PG8_WAIT_L(0); PG8_MMA(0, 0, At, B0); PG8_BAR; PG8_SCHED;
            PG8_LDB(B1, 0, 1); PG8_STAGE(PG8_SB(0, 0), b2, voffB);
            PG8_BAR; PG8_WAIT_L(0); PG8_MMA(0, 1, At, B1); PG8_BAR;
            PG8_LDA(At, 0, 1); PG8_STAGE(PG8_SA(0, 0), a2, voffA);
            PG8_BAR; PG8_WAIT_L(0); PG8_MMA(1, 0, At, B0); PG8_BAR; PG8_SCHED;
            PG8_STAGE(PG8_SB(0, 1), b2 + hstepB, voffB);
            PG8_WAIT_V(6); PG8_BAR; PG8_MMA(1, 1, At, B1); PG8_BAR;
            PG8_LDB(B0, 1, 0); PG8_SCHED; PG8_LDA(At, 1, 0); PG8_STAGE(PG8_SA(0, 1), a2 + hstepA, voffA);
            PG8_WAIT_L(8); PG8_BAR; PG8_WAIT_L(0); PG8_MMA(0, 0, At, B0); PG8_BAR; PG8_SCHED;
            PG8_LDB(B1, 1, 1); PG8_STAGE(PG8_SB(1, 0), b3, voffB);
            PG8_BAR; PG8_WAIT_L(0); PG8_MMA(0, 1, At, B1); PG8_BAR;
            PG8_LDA(At, 1, 1); PG8_STAGE(PG8_SA(1, 0), a3, voffA);
            PG8_BAR; PG8_WAIT_L(0); PG8_MMA(1, 0, At, B0); PG8_BAR; PG8_SCHED;
            PG8_STAGE(PG8_SB(1, 1), b3 + hstepB, voffB);
            PG8_WAIT_V(6); PG8_BAR; PG8_MMA(1, 1, At, B1); PG8_BAR;
            }
            if constexpr (Epi::MIDHOOK) { if (t + 2 == Epi::MID_TILES) E.mid(acc, cur, wr, wc, fr, fq); }
        }
        if constexpr (ALIGN_EPI) { if (wr == 0) PG8_BAR; }
        if constexpr (!Epi::AFTER_DRAIN) { E(acc, cur, wr, wc, fr, fq); S.done(cur); }
        if (!has_next) break;
#pragma unroll
        for (int a = 0; a < 2; ++a)
#pragma unroll
            for (int b = 0; b < 2; ++b)
#pragma unroll
                for (int m = 0; m < 4; ++m)
#pragma unroll
                    for (int n = 0; n < 2; ++n) acc[a][b][m][n] = (f32x4){0.f, 0.f, 0.f, 0.f};
        cur = nxt; cA = nA; cB = nB; ++ui;
        if constexpr (ALIGN_EPI) { if (wr == 1) PG8_BAR; }
    }
    PG8_WAIT_V(0);
    if constexpr (!ALIGN_EPI) { if (wr == 0) PG8_BAR; }
    PG8_BAR;
    if constexpr (Epi::AFTER_DRAIN) { E.fused(acc, cur, wr, wc, fr, fq, lds, wid, lane); S.done(cur); }
#undef PG8_SA
#undef PG8_SB
#undef PG8_STAGE
#undef PG8_LDA
#undef PG8_LDB
#undef PG8_MMA
#undef PG8_WAIT_V
#undef PG8_WAIT_L
#undef PG8_BAR
#undef PG8_SCHED
}
}
namespace pg8 {
__device__ __forceinline__ const float* kin(int k) {
    typedef const float* cfp;
    const __attribute__((address_space(4))) char* ka = (const __attribute__((address_space(4))) char*)__builtin_amdgcn_kernarg_segment_ptr();
    return *(const volatile __attribute__((address_space(4))) cfp*)(ka + 8 * k);
}
struct EpiRoute {
    static constexpr bool PERM = true, AFTER_DRAIN = false, MIDHOOK = false;
    bf16_t* qkv; bf16_t* hg; bf16_t* gate; int k_lb, k_qn, k_kn;
    const float* rope;
    PG8_LAS float* xs;
    __device__ __forceinline__ void operator()(const f32x4 (&acc)[2][2][4][2], const Unit& u, int wr, int wc, int fr, int fq) const {
        bf16_t* base; int ldc, colt, mode = 0;
        if (u.pn < 3) { base = qkv; ldc = 768; colt = u.pn * 256; mode = 4; }
        else if (u.pn < 13) { base = hg; ldc = 2560; colt = (u.pn - 3) * 256; mode = (u.pn < 5 || u.pn >= 11) ? 1 : (u.pn < 7 ? 2 : (u.pn < 9 ? 3 : 0)); }
        else { base = gate; ldc = 2048; colt = (u.pn - 13) * 256; mode = 5; }
        const int row0 = u.pm * BM + wr * 64 + fr, col0 = colt + wc * 32 + 8 * fq;
        if (mode == 4) {
            const int nbj = (u.pn == 2) ? 1 : 2;
#pragma unroll
            for (int ai = 0; ai < 2; ++ai)
#pragma unroll
                for (int m = 0; m < 4; ++m)
#pragma unroll
                    for (int bj = 0; bj < 2; ++bj) { if (bj < nbj) { const f32x4 v0 = acc[ai][bj][m][0], v1 = acc[ai][bj][m][1];
                        float ss = (v0[0] * v0[0] + v0[1] * v0[1]) + (v0[2] * v0[2] + v0[3] * v0[3]) + (v1[0] * v1[0] + v1[1] * v1[1]) + (v1[2] * v1[2] + v1[3] * v1[3]);
                        ss += __shfl_xor(ss, 16); ss += __shfl_xor(ss, 32);
                        if (fq == 0) xs[((ai * HALF + wr * 64 + m * 16 + fr) * 4 + 2 * bj + (wc >> 1)) * 2 + (wc & 1)] = ss; } }
            asm volatile("s_waitcnt lgkmcnt(0)\n\ts_barrier" ::: "memory");
            const int d0 = 32 * (wc & 1) + 8 * fq;
            float gn[8];
            { const float* nrm = kin(k_qn + (int)(u.pn == 2) * (k_kn - k_qn));
#pragma unroll
              for (int j = 0; j < 8; ++j) gn[j] = nrm[d0 + j]; }
            const float qs = (u.pn == 2) ? 1.0f : 0.125f * 1.4426950408889634f;
            const int axis = wc & 1, fbase = 8 * (fq & 1);
#pragma unroll
            for (int ai = 0; ai < 2; ++ai)
#pragma unroll
                for (int m = 0; m < 4; ++m) { const int rl = ai * HALF + wr * 64 + m * 16 + fr; const int grow = u.pm * BM + rl; const int t = grow & 4095;
                    const int pos = axis ? (t & 63) : (t >> 6);
                    const f32x4* rp = (const f32x4*)(rope + (pos * 16 + fbase) * 2);
                    const f32x4 c01 = rp[0], c23 = rp[1], c45 = rp[2], c67 = rp[3];
                    const float cs[8] = {c01[0], c01[2], c23[0], c23[2], c45[0], c45[2], c67[0], c67[2]}, sn[8] = {c01[1], c01[3], c23[1], c23[3], c45[1], c45[3], c67[1], c67[3]};
                    bf16_t* rowp = base + (size_t)grow * ldc + col0;
#pragma unroll
                    for (int bj = 0; bj < 2; ++bj) { const f32x4 v0 = acc[ai][bj][m][0], v1 = acc[ai][bj][m][1];
                        float v[8] = {v0[0], v0[1], v0[2], v0[3], v1[0], v1[1], v1[2], v1[3]};
                        if (bj < nbj) {
                            const PG8_LAS float* xp = xs + ((rl * 4 + 2 * bj + (wc >> 1)) * 2);
                            const float rinv = __builtin_amdgcn_rsqf((xp[0] + xp[1]) * (1.0f / 64.0f) + 1e-6f) * qs;
#pragma unroll
                            for (int j = 0; j < 8; ++j) { const float y = v[j] * rinv * gn[j]; const float yp = __shfl_xor(y, 32);
                                v[j] = (fq & 2) ? (yp * sn[j] + y * cs[j]) : (y * cs[j] - yp * sn[j]); }
                        }
                        u32x4 w; w.x = cvt_pk_bf16(v[0], v[1]); w.y = cvt_pk_bf16(v[2], v[3]); w.z = cvt_pk_bf16(v[4], v[5]); w.w = cvt_pk_bf16(v[6], v[7]);
                        *(u32x4*)(rowp + bj * HALF) = w; } }
            return;
        }
        float lb[2][8];
        if (mode == 2 || mode == 3) { const int d = mode - 2; const float* lbraw = kin(k_lb);
#pragma unroll
            for (int bj = 0; bj < 2; ++bj) { const int c = (col0 + bj * HALF) & 511; const float* r0 = lbraw + d * 512 + c; const float* r1 = lbraw + 1024 + d * 512 + c;
#pragma unroll
                for (int j = 0; j < 8; ++j) lb[bj][j] = sigmoidf_(r0[j] - r1[j]); } }
#pragma unroll
        for (int ai = 0; ai < 2; ++ai)
#pragma unroll
            for (int m = 0; m < 4; ++m) { bf16_t* rowp = base + (size_t)(row0 + ai * HALF + m * 16) * ldc + col0;
#pragma unroll
                for (int bj = 0; bj < 2; ++bj) { const f32x4 v0 = acc[ai][bj][m][0], v1 = acc[ai][bj][m][1];
                    float v[8] = {v0[0], v0[1], v0[2], v0[3], v1[0], v1[1], v1[2], v1[3]};
                    if (mode == 1) {
#pragma unroll
                        for (int j = 0; j < 8; ++j) v[j] = v[j] * sigmoidf_(v[j]);
                    } else if (mode == 5) {
                        unsigned q8[8];
#pragma unroll
                        for (int j = 0; j < 8; ++j) q8[j] = (unsigned)__builtin_rintf(255.0f * sigmoidf_(v[j]));
                        unsigned char* gp = (unsigned char*)base + (size_t)(row0 + ai * HALF + m * 16) * 2048 + col0 + bj * HALF;
                        *(unsigned long long*)gp = (unsigned long long)(q8[0] | (q8[1] << 8) | (q8[2] << 16) | (q8[3] << 24)) | ((unsigned long long)(q8[4] | (q8[5] << 8) | (q8[6] << 16) | (q8[7] << 24)) << 32);
                        continue;
                    } else if (mode >= 2) {
#pragma unroll
                        for (int j = 0; j < 8; ++j) v[j] = __builtin_amdgcn_logf(lb[bj][j] + (1.0f - lb[bj][j]) * sigmoidf_(v[j]));
                    }
                    u32x4 w; w.x = cvt_pk_bf16(v[0], v[1]); w.y = cvt_pk_bf16(v[2], v[3]); w.z = cvt_pk_bf16(v[4], v[5]); w.w = cvt_pk_bf16(v[6], v[7]);
                    *(u32x4*)(rowp + bj * HALF) = w; } }
    }
};
struct EpiBf16Plain {
    static constexpr bool PERM = true, AFTER_DRAIN = false, MIDHOOK = false;
    bf16_t* O; int ldc;
    __device__ __forceinline__ void operator()(const f32x4 (&acc)[2][2][4][2], const Unit& u, int wr, int wc, int fr, int fq) const {
        const int row0 = u.pm * BM + wr * 64 + fr, col0 = u.pn * BM + wc * 32 + 8 * fq;
#pragma unroll
        for (int ai = 0; ai < 2; ++ai)
#pragma unroll
            for (int m = 0; m < 4; ++m) { bf16_t* rowp = O + (size_t)(row0 + ai * HALF + m * 16) * ldc + col0;
#pragma unroll
                for (int bj = 0; bj < 2; ++bj) { const f32x4 v0 = acc[ai][bj][m][0], v1 = acc[ai][bj][m][1];
                    u32x4 w; w.x = cvt_pk_bf16(v0[0], v0[1]); w.y = cvt_pk_bf16(v0[2], v0[3]); w.z = cvt_pk_bf16(v1[0], v1[1]); w.w = cvt_pk_bf16(v1[2], v1[3]);
                    *(u32x4*)(rowp + bj * HALF) = w; } }
    }
};
struct EpiMergeFused {
    static constexpr bool PERM = true, AFTER_DRAIN = false, MIDHOOK = true; static constexpr int MID_TILES = 8;
    bf16_t* MG; const unsigned char* gate;
    __device__ __forceinline__ void mid(f32x4 (&acc)[2][2][4][2], const Unit& u, int wr, int wc, int fr, int fq) const {
        const int row0 = u.pm * BM + wr * 64 + fr, col0 = u.pn * BM + wc * 32 + 8 * fq;
#pragma unroll
        for (int ai = 0; ai < 2; ++ai)
#pragma unroll
            for (int m = 0; m < 4; ++m) { const size_t row = (size_t)(row0 + ai * HALF + m * 16);
#pragma unroll
                for (int bj = 0; bj < 2; ++bj) { const int col = col0 + bj * HALF;
                    const unsigned long long ga = *(const unsigned long long*)(gate + row * 2048 + col), gb = *(const unsigned long long*)(gate + row * 2048 + 1024 + col);
#pragma unroll
                    for (int j = 0; j < 8; ++j) { const float a = (float)((unsigned)(ga >> (8 * j)) & 0xffu), b = fmaxf((float)((unsigned)(gb >> (8 * j)) & 0xffu), 9.5367431640625e-7f);
                        acc[ai][bj][m][j >> 2][j & 3] *= a * __builtin_amdgcn_rcpf(b); } } }
    }
    __device__ __forceinline__ void operator()(const f32x4 (&acc)[2][2][4][2], const Unit& u, int wr, int wc, int fr, int fq) const {
        const int row0 = u.pm * BM + wr * 64 + fr, col0 = u.pn * BM + wc * 32 + 8 * fq;
#pragma unroll
        for (int ai = 0; ai < 2; ++ai)
#pragma unroll
            for (int m = 0; m < 4; ++m) { const size_t row = (size_t)(row0 + ai * HALF + m * 16);
#pragma unroll
                for (int bj = 0; bj < 2; ++bj) { const int col = col0 + bj * HALF;
                    const unsigned long long gb = *(const unsigned long long*)(gate + row * 2048 + 1024 + col);
                    float v[8] = {acc[ai][bj][m][0][0], acc[ai][bj][m][0][1], acc[ai][bj][m][0][2], acc[ai][bj][m][0][3], acc[ai][bj][m][1][0], acc[ai][bj][m][1][1], acc[ai][bj][m][1][2], acc[ai][bj][m][1][3]};
#pragma unroll
                    for (int j = 0; j < 8; ++j) v[j] *= fmaxf((float)((unsigned)(gb >> (8 * j)) & 0xffu), 9.5367431640625e-7f) * (1.0f / 255.0f);
                    u32x4 w; w.x = cvt_pk_bf16(v[0], v[1]); w.y = cvt_pk_bf16(v[2], v[3]); w.z = cvt_pk_bf16(v[4], v[5]); w.w = cvt_pk_bf16(v[6], v[7]);
                    *(u32x4*)(MG + row * 1024 + col) = w; } }
    }
};
struct EpiResid {
    static constexpr bool PERM = true, AFTER_DRAIN = false, MIDHOOK = false;
    const bf16_t* xn; const float* aux; bf16_t* xb; float* rowss;
    __device__ __forceinline__ void operator()(const f32x4 (&acc)[2][2][4][2], const Unit& u, int wr, int wc, int fr, int fq) const {
        const int row0 = u.pm * BM + wr * 64 + fr, col0 = u.pn * BM + wc * 32 + 8 * fq;
#pragma unroll
        for (int ai = 0; ai < 2; ++ai)
#pragma unroll
            for (int m = 0; m < 4; ++m) { const size_t row = (size_t)(row0 + ai * HALF + m * 16); float ss = 0.f; const float rr = aux[65536 + row];
#pragma unroll
                for (int bj = 0; bj < 2; ++bj) { const size_t off = row * 1024 + col0 + bj * HALF;
                    const u32x4 xw = *(const u32x4*)(xn + off);
                    const f32x4 g0 = *(const f32x4*)(aux + col0 + bj * HALF) * rr, g1 = *(const f32x4*)(aux + col0 + bj * HALF + 4) * rr;
                    const f32x4 x0 = {bf_lo(xw.x) * g0[0], bf_hi(xw.x) * g0[1], bf_lo(xw.y) * g0[2], bf_hi(xw.y) * g0[3]}, x1 = {bf_lo(xw.z) * g1[0], bf_hi(xw.z) * g1[1], bf_lo(xw.w) * g1[2], bf_hi(xw.w) * g1[3]};
                    const f32x4 o0 = x0 + acc[ai][bj][m][0], o1 = x1 + acc[ai][bj][m][1];
                    ss += (o0[0] * o0[0] + o0[1] * o0[1]) + (o0[2] * o0[2] + o0[3] * o0[3]) + (o1[0] * o1[0] + o1[1] * o1[1]) + (o1[2] * o1[2] + o1[3] * o1[3]);
                    u32x4 w; w.x = cvt_pk_bf16(o0[0], o0[1]); w.y = cvt_pk_bf16(o0[2], o0[3]); w.z = cvt_pk_bf16(o1[0], o1[1]); w.w = cvt_pk_bf16(o1[2], o1[3]);
                    *(u32x4*)(xb + off) = w; }
                ss += __shfl_xor(ss, 16); ss += __shfl_xor(ss, 32);
                if (fq == 0) atomicAdd(rowss + row, ss); }
    }
};
struct EpiPleFused {
    static constexpr bool PERM = true, AFTER_DRAIN = false, MIDHOOK = true; static constexpr int MID_TILES = 4;
    float* out; bf16_t* pp; const float* rowss2; float eps; const bf16_t* aple;
    __device__ __forceinline__ void mid(f32x4 (&acc)[2][2][4][2], const Unit& u, int wr, int wc, int fr, int fq) const {
        const int row0 = u.pm * BM + wr * 64 + fr, col0 = u.pn * BM + wc * 32 + 8 * fq;
#pragma unroll
        for (int ai = 0; ai < 2; ++ai)
#pragma unroll
            for (int m = 0; m < 4; ++m) { bf16_t* rowp = pp + (size_t)(row0 + ai * HALF + m * 16) * 1024 + col0;
#pragma unroll
                for (int bj = 0; bj < 2; ++bj) { const f32x4 v0 = acc[ai][bj][m][0], v1 = acc[ai][bj][m][1];
                    u32x4 w; w.x = cvt_pk_bf16(v0[0], v0[1]); w.y = cvt_pk_bf16(v0[2], v0[3]); w.z = cvt_pk_bf16(v1[0], v1[1]); w.w = cvt_pk_bf16(v1[2], v1[3]);
                    *(u32x4*)(rowp + bj * HALF) = w;
                    acc[ai][bj][m][0] = (f32x4){0.f, 0.f, 0.f, 0.f}; acc[ai][bj][m][1] = (f32x4){0.f, 0.f, 0.f, 0.f}; } }
    }
    __device__ __forceinline__ void operator()(const f32x4 (&acc)[2][2][4][2], const Unit& u, int wr, int wc, int fr, int fq) const {
        const int row0 = u.pm * BM + wr * 64 + fr, col0 = u.pn * BM + wc * 32 + 8 * fq;
#pragma unroll
        for (int ai = 0; ai < 2; ++ai)
#pragma unroll
            for (int m = 0; m < 4; ++m) { const size_t row = (size_t)(row0 + ai * HALF + m * 16);
                const float rv = __builtin_amdgcn_rsqf(rowss2[row] * (1.0f / 1024.0f) + eps);
#pragma unroll
                for (int bj = 0; bj < 2; ++bj) { const size_t off = row * 1024 + col0 + bj * HALF;
                    const u32x4 xw = *(const u32x4*)(aple + row * 1280 + 256 + col0 + bj * HALF);
                    const f32x4 x0 = {bf_lo(xw.x), bf_hi(xw.x), bf_lo(xw.y), bf_hi(xw.y)}, x1 = {bf_lo(xw.z), bf_hi(xw.z), bf_lo(xw.w), bf_hi(xw.w)};
                    const u32x4 pw = *(const u32x4*)(pp + off);
                    const f32x4 a0 = acc[ai][bj][m][0] * rv, a1 = acc[ai][bj][m][1] * rv;
                    f32x4 o0, o1;
                    o0[0] = x0[0] + sigmoidf_(a0[0]) * bf_lo(pw.x); o0[1] = x0[1] + sigmoidf_(a0[1]) * bf_hi(pw.x);
                    o0[2] = x0[2] + sigmoidf_(a0[2]) * bf_lo(pw.y); o0[3] = x0[3] + sigmoidf_(a0[3]) * bf_hi(pw.y);
                    o1[0] = x1[0] + sigmoidf_(a1[0]) * bf_lo(pw.z); o1[1] = x1[1] + sigmoidf_(a1[1]) * bf_hi(pw.z);
                    o1[2] = x1[2] + sigmoidf_(a1[2]) * bf_lo(pw.w); o1[3] = x1[3] + sigmoidf_(a1[3]) * bf_hi(pw.w);
                    *(f32x4*)(out + off) = o0; *(f32x4*)(out + off + 4) = o1; } }
    }
};

__device__ __forceinline__ int key_enc(float s, int idx, int mask) { int b = __float_as_int(s); b = (b & ~mask) | idx; return b ^ ((b >> 31) & 0x7fffffff); }
__device__ __forceinline__ int key_dec(int k) { return k ^ ((k >> 31) & 0x7fffffff); }
__device__ __forceinline__ void ce_desc(int& a, int& b) { const int mx = a > b ? a : b, mn = a > b ? b : a; a = mx; b = mn; }
template <int N> __device__ __forceinline__ void bitonic_sort_desc(int (&v)[N]) {
#pragma unroll
    for (int k = 2; k <= N; k <<= 1)
#pragma unroll
        for (int j = k >> 1; j > 0; j >>= 1)
#pragma unroll
            for (int i = 0; i < N; ++i) { const int l = i ^ j; if (l > i) { if ((i & k) == 0) ce_desc(v[i], v[l]); else ce_desc(v[l], v[i]); } }
}
__device__ __forceinline__ void merge16_desc(int (&a)[16], const int (&b)[16]) {
#pragma unroll
    for (int i = 0; i < 16; ++i) { const int o = b[15 - i]; a[i] = a[i] > o ? a[i] : o; }
#pragma unroll
    for (int j = 8; j > 0; j >>= 1)
#pragma unroll
        for (int i = 0; i < 16; ++i) { const int l = i ^ j; if (l > i) ce_desc(a[i], a[l]); }
}

struct EpiTopk {
    static constexpr bool PERM = true, AFTER_DRAIN = true, MIDHOOK = false;
    const float* rowss; unsigned short* IDX; float* GW; float eps;
    static constexpr int LDW = 132;
    __device__ __forceinline__ void fused(const f32x4 (&acc)[2][2][4][2], const Unit& u, int wr, int wc, int fr, int fq, PG8_LAS unsigned char* lds, int wid, int lane) const {
        PG8_LAS float* S = (PG8_LAS float*)lds;
        const int tid = wid * 64 + lane, trow = tid >> 1, half = tid & 1;
        float rinv[2][4];
#pragma unroll
        for (int ai = 0; ai < 2; ++ai)
#pragma unroll
            for (int m = 0; m < 4; ++m) rinv[ai][m] = __builtin_amdgcn_rsqf(rowss[u.pm * BM + ai * HALF + wr * 64 + m * 16 + fr] * (1.0f / 1024.0f) + eps);
        int L[2][16];
#pragma unroll
        for (int p = 0; p < 2; ++p) {
#pragma unroll
            for (int ai = 0; ai < 2; ++ai)
#pragma unroll
                for (int m = 0; m < 4; ++m) { const int r = ai * HALF + wr * 64 + m * 16 + fr; PG8_LAS float* sp = S + r * LDW + wc * 32 + 8 * fq;
                    *(PG8_LAS f32x4*)sp = acc[ai][p][m][0] * rinv[ai][m]; *(PG8_LAS f32x4*)(sp + 4) = acc[ai][p][m][1] * rinv[ai][m]; }
            __syncthreads();
            int run[16];
            const PG8_LAS float* rp = S + trow * LDW + half * 64;
#pragma unroll
            for (int q = 0; q < 4; ++q) {
                int gq[16];
#pragma unroll
                for (int i4 = 0; i4 < 4; ++i4) { const f32x4 v = *(const PG8_LAS f32x4*)(rp + q * 16 + i4 * 4);
#pragma unroll
                    for (int j = 0; j < 4; ++j) gq[i4 * 4 + j] = key_enc(v[j], half * 64 + q * 16 + i4 * 4 + j, 0x7f); }
                bitonic_sort_desc<16>(gq);
                if (q == 0) {
#pragma unroll
                    for (int i = 0; i < 16; ++i) run[i] = gq[i];
                } else merge16_desc(run, gq);
            }
            int o[16];
#pragma unroll
            for (int i = 0; i < 16; ++i) o[i] = __shfl_xor(run[i], 1);
            merge16_desc(run, o);
#pragma unroll
            for (int i = 0; i < 16; ++i) L[p][i] = run[i];
            __syncthreads();
        }
        float v1[16], v2[16];
        PG8_LAS unsigned char* tb = lds + tid * 32;
#pragma unroll
        for (int i = 0; i < 16; ++i) { const int b1 = key_dec(L[0][i]), b2 = key_dec(L[1][i]); v1[i] = __int_as_float(b1 & ~0x7f); v2[i] = __int_as_float(b2 & ~0x7f);
            tb[i] = (unsigned char)(b1 & 0x7f); tb[16 + i] = (unsigned char)(b2 & 0x7f); }
        const int NEG = (int)0x80000000;
        int X[16], Y[16], Z[16];
        const bool hb = half != 0;
#define CAND(iA, jA, iB, jB) key_enc((hb ? v1[iB] : v1[iA]) + (hb ? v2[jB] : v2[jA]), hb ? ((iB) * 16 + (jB)) : ((iA) * 16 + (jA)), 0xff)
#pragma unroll
        for (int j = 0; j < 16; ++j) { if (j < 8) X[j] = CAND(0, j, 1, j); else { const int k0 = key_enc(v1[0] + v2[j], j, 0xff); X[j] = hb ? NEG : k0; } }
        {
            constexpr int yi[16] = {2, 2, 2, 2, 2, 3, 3, 3, 3, 4, 4, 4, 5, 5, 6, 6}, yj[16] = {0, 1, 2, 3, 4, 0, 1, 2, 3, 0, 1, 2, 0, 1, 0, 1};
#pragma unroll
            for (int n = 0; n < 16; ++n) { const int kb = key_enc(v1[yi[n]] + v2[yj[n]], yi[n] * 16 + yj[n], 0xff);
                if (n < 8) { const int ka = key_enc(v1[8 + n] + v2[0], (8 + n) * 16, 0xff); Y[n] = hb ? kb : ka; } else Y[n] = hb ? kb : NEG; }
        }
#pragma unroll
        for (int n = 0; n < 16; ++n) { if (n < 2) { const int kb = key_enc(v1[7] + v2[n], 7 * 16 + n, 0xff); Z[n] = hb ? kb : NEG; } else Z[n] = NEG; }
#undef CAND
        bitonic_sort_desc<16>(Y);
        merge16_desc(X, Y); merge16_desc(X, Z);
        int o2[16];
#pragma unroll
        for (int i = 0; i < 16; ++i) o2[i] = __shfl_xor(X[i], 1);
        merge16_desc(X, o2);
        float sv[16], e[16]; float sum = 0.f;
#pragma unroll
        for (int i = 0; i < 16; ++i) { sv[i] = __int_as_float(key_dec(X[i]) & ~0xff); }
#pragma unroll
        for (int i = 0; i < 16; ++i) { e[i] = __builtin_amdgcn_exp2f((sv[i] - sv[0]) * 1.4426950408889634f); sum += e[i]; }
        const float rs = 1.0f / sum;
        asm volatile("s_waitcnt lgkmcnt(0)" ::: "memory");
        if (!hb) {
            const size_t ob = (size_t)(u.pm * BM + trow) * 128 + u.pn * 16;
            unsigned ids[16];
#pragma unroll
            for (int i4 = 0; i4 < 4; ++i4) { f32x4 gv;
#pragma unroll
                for (int j = 0; j < 4; ++j) { const int i = i4 * 4 + j; const int pid = key_dec(X[i]) & 0xff; const int i1 = tb[pid >> 4], i2 = tb[16 + (pid & 15)];
                    ids[i] = (unsigned)(i1 * 128 + i2); gv[j] = e[i] * rs; }
                *(f32x4*)(GW + ob + i4 * 4) = gv; }
            *(u32x4*)(IDX + ob) = (u32x4){ids[0] | (ids[1] << 16), ids[2] | (ids[3] << 16), ids[4] | (ids[5] << 16), ids[6] | (ids[7] << 16)};
            *(u32x4*)(IDX + ob + 8) = (u32x4){ids[8] | (ids[9] << 16), ids[10] | (ids[11] << 16), ids[12] | (ids[13] << 16), ids[14] | (ids[15] << 16)};
        }
        __syncthreads();
    }
};
}
#include <hip/hip_bf16.h>
#include <cmath>
namespace attn_body {
using bf16=__hip_bfloat16;
using bf16x8=__attribute__((ext_vector_type(8)))short;
using s16x4=__attribute__((ext_vector_type(4)))short;
using f32x16=__attribute__((ext_vector_type(16)))float;
using u32x4=__attribute__((ext_vector_type(4)))unsigned;
constexpr int BATCH=8,NHEAD=8,NKV=2,SEQ=4096,D=64,DM=768;
constexpr int NW=8,QBLK=32,QB=QBLK*NW,KVBLK=64,NQB=SEQ/QB;
constexpr int ATTN_PITCH=DM, ATTN_UNIT_ROWS=QB, ODM=1024;
__device__ __forceinline__ int crow(int r,int hi){return (r&3)+8*(r>>2)+4*hi;}
#define SBAR() __builtin_amdgcn_sched_barrier(0)
__device__ __forceinline__ void cmask(f32x16&p0,f32x16&p1,int jb,int qrel,int hi){
  const float NEG=-INFINITY; int kb=64*jb+4*hi;
  #pragma unroll
  for(int r=0;r<16;++r){int kv=kb+(r&3)+8*(r>>2); if(kv>qrel)p0[r]=NEG; if(kv+32>qrel)p1[r]=NEG;}
}

constexpr int NSLOT=3, SLOTB=8192;
constexpr int LDS_K=0, LDS_V=NSLOT*SLOTB, LDS_WS=2*NSLOT*SLOTB, LDS_OST=LDS_WS+NW*64*4, LDS_BYTES=LDS_OST+NW*4096;
constexpr float C2=0.125f*1.4426950408889634f;
__device__ __forceinline__ void glds16(const void*gsrc,unsigned lds_dst){unsigned keep;
  asm volatile("s_mov_b32 %0, m0\n\ts_mov_b32 m0, %2\n\ts_nop 0\n\tglobal_load_lds_dwordx4 %1, off\n\ts_mov_b32 m0, %0":"=&s"(keep):"v"(gsrc),"s"(lds_dst):"memory");}
__device__ __forceinline__ float max3f(float a,float b,float c){float r;asm("v_max3_f32 %0, %1, %2, %3":"=v"(r):"v"(a),"v"(b),"v"(c));return r;}
__device__ __forceinline__ float max2f(float a,float b){float r;asm("v_max_f32_e32 %0, %1, %2":"=v"(r):"v"(a),"v"(b));return r;}
__device__ __forceinline__ float fadd_s(float a,float b){float r;asm("v_add_f32_e32 %0, %1, %2":"=v"(r):"v"(a),"v"(b));return r;}
__device__ __forceinline__ float fsub_s(float a,float b){float r;asm("v_sub_f32_e32 %0, %1, %2":"=v"(r):"v"(a),"v"(b));return r;}
typedef float f32x2_t __attribute__((ext_vector_type(2))); typedef __bf16 bf16x2_t __attribute__((ext_vector_type(2)));
__device__ __forceinline__ unsigned cvtpk_s(float lo,float hi){f32x2_t v={lo,hi};bf16x2_t b=__builtin_convertvector(v,bf16x2_t);return __builtin_bit_cast(unsigned,b);}
#define WAIT_BAR(N) asm volatile("s_waitcnt vmcnt(" #N ") lgkmcnt(0)\n\ts_barrier":::"memory")

__device__ __forceinline__ void qkt(f32x16&p0,f32x16&p1,const char*Kslot,const bf16x8*qr,const f32x16&negm,int r32,int hi){
  const char*kb=Kslot+hi*1024+r32*16;
  #pragma unroll
  for(int d0=0;d0<4;++d0){
    const bf16x8 b0=*reinterpret_cast<const bf16x8*>(kb+d0*2048);
    const bf16x8 b1=*reinterpret_cast<const bf16x8*>(kb+d0*2048+512);
    if(d0==0){p0=__builtin_amdgcn_mfma_f32_32x32x16_bf16(b0,qr[0],negm,0,0,0);p1=__builtin_amdgcn_mfma_f32_32x32x16_bf16(b1,qr[0],negm,0,0,0);}
    else{p0=__builtin_amdgcn_mfma_f32_32x32x16_bf16(b0,qr[d0],p0,0,0,0);p1=__builtin_amdgcn_mfma_f32_32x32x16_bf16(b1,qr[d0],p1,0,0,0);}}
}
typedef __attribute__((address_space(3))) const char* lds_cptr;
typedef short v4i16_t __attribute__((ext_vector_type(4)));
__device__ __forceinline__ void kload8(bf16x8*kf,lds_cptr kp){
  kf[0]=*(const __attribute__((address_space(3))) bf16x8*)(kp);      kf[1]=*(const __attribute__((address_space(3))) bf16x8*)(kp+512);
  kf[2]=*(const __attribute__((address_space(3))) bf16x8*)(kp+2048); kf[3]=*(const __attribute__((address_space(3))) bf16x8*)(kp+2560);
  kf[4]=*(const __attribute__((address_space(3))) bf16x8*)(kp+4096); kf[5]=*(const __attribute__((address_space(3))) bf16x8*)(kp+4608);
  kf[6]=*(const __attribute__((address_space(3))) bf16x8*)(kp+6144); kf[7]=*(const __attribute__((address_space(3))) bf16x8*)(kp+6656);
}
__device__ __forceinline__ void kload2(bf16x8*kf,lds_cptr kp,int j){ kf[2*j]=*(const __attribute__((address_space(3))) bf16x8*)(kp+j*2048); kf[2*j+1]=*(const __attribute__((address_space(3))) bf16x8*)(kp+j*2048+512); }
__device__ __forceinline__ s16x4 vtr(lds_cptr p){ return __builtin_bit_cast(s16x4,__builtin_amdgcn_ds_read_tr16_b64_v4i16((__attribute__((address_space(3))) v4i16_t*)p)); }
__device__ __forceinline__ float rowmax(const f32x16&p0,const f32x16&p1){
  float a=max3f(p0[0],p0[1],p1[0]),b=max3f(p0[2],p0[3],p1[1]);a=max3f(a,p1[2],p1[3]);
  #pragma unroll
  for(int r=4;r<16;r+=4){a=max3f(a,p0[r],p0[r+1]);b=max3f(b,p0[r+2],p0[r+3]);a=max3f(a,p1[r],p1[r+1]);b=max3f(b,p1[r+2],p1[r+3]);}
  const float m=max2f(a,b);
  auto rr=__builtin_amdgcn_permlane32_swap(__float_as_uint(m),__float_as_uint(m),false,false);
  return max2f(__uint_as_float(rr[0]),__uint_as_float(rr[1]));
}
__device__ __forceinline__ void pv(f32x16*o,int vb,bf16x8 pa0,bf16x8 pa1,bf16x8 pa2,bf16x8 pa3){
  #pragma unroll
  for(int d0=0;d0<2;++d0){s16x4 lo[4],hi[4];
    #pragma unroll
    for(int ks=0;ks<4;++ks){
      asm volatile("ds_read_b64_tr_b16 %0,%1 offset:%c2":"=&v"(lo[ks]):"v"(vb),"i"(d0*4096+ks*1024):"memory");
      asm volatile("ds_read_b64_tr_b16 %0,%1 offset:%c2":"=&v"(hi[ks]):"v"(vb),"i"(d0*4096+ks*1024+512):"memory");}
    asm volatile("s_waitcnt lgkmcnt(0)":::"memory");SBAR();
    #define PK(k) (bf16x8){lo[k][0],lo[k][1],lo[k][2],lo[k][3],hi[k][0],hi[k][1],hi[k][2],hi[k][3]}
    o[d0]=__builtin_amdgcn_mfma_f32_32x32x16_bf16(pa0,PK(0),o[d0],0,0,0);
    o[d0]=__builtin_amdgcn_mfma_f32_32x32x16_bf16(pa1,PK(1),o[d0],0,0,0);
    o[d0]=__builtin_amdgcn_mfma_f32_32x32x16_bf16(pa2,PK(2),o[d0],0,0,0);
    o[d0]=__builtin_amdgcn_mfma_f32_32x32x16_bf16(pa3,PK(3),o[d0],0,0,0);
    #undef PK
  }
}

#ifndef ATTN_STORE16
#define ATTN_STORE16(p,v) (*(u32x4*)(p)=(v))
#endif
template<int THRL> __device__ __forceinline__ void attn_unit(int wave_id,int b,int h,int qb,const bf16*Q,const bf16*__restrict__ K,const bf16*__restrict__ V,bf16*O,char*shm){
  int tid_; asm volatile("v_mbcnt_lo_u32_b32 %0, -1, 0\n\tv_mbcnt_hi_u32_b32 %0, -1, %0":"=v"(tid_)); tid_+=wave_id*64; const int tid=tid_,lane=tid&63,r32=lane&31,hi=lane>>5; const int wid=__builtin_amdgcn_readfirstlane(tid>>6);
  const long rowbase=(long)b*SEQ; const int q0=qb*QB;
  const bf16*Qw=Q+(rowbase+q0+wid*QBLK)*DM+h*D;
  const bf16*Kh=K+rowbase*DM+(h/(NHEAD/NKV))*D,*Vh=V+rowbase*DM+(h/(NHEAD/NKV))*D;
  const unsigned lds0=(unsigned)(uintptr_t)shm;
  float*wsf=(float*)(shm+LDS_WS)+wid*64;
  const bf16*ksrc=Kh+(long)lane*DM+wid*8;
  const bf16*vsrc=Vh+(long)(16*(wid&3)+(lane>>2))*DM+(wid>>2)*32+(lane&3)*8;
  const unsigned kdst=lds0+LDS_K+wid*1024, vdst=lds0+LDS_V+wid*1024;
  #define DMA_K(t,slot) glds16(ksrc+(long)(t)*KVBLK*DM,(unsigned)__builtin_amdgcn_readfirstlane(kdst+(slot)))
  #define DMA_V(t,slot) glds16(vsrc+(long)(t)*KVBLK*DM,(unsigned)__builtin_amdgcn_readfirstlane(vdst+(slot)))
  const int vb0=(int)(lds0+LDS_V)+((lane>>4)&1)*32+(lane&3)*8+(4*hi+((lane&15)>>2))*64;
  const char*Kbase=shm+LDS_K; bf16x8 kf[8];
  const lds_cptr shm3=(lds_cptr)shm; const lds_cptr kp0=shm3+LDS_K+hi*1024+r32*16; const lds_cptr vp0=shm3+LDS_V+((lane>>4)&1)*32+(lane&3)*8+(4*hi+((lane&15)>>2))*64;
  constexpr int NT=SEQ/KVBLK;
  DMA_K(0,0);DMA_V(0,0);DMA_K(1,SLOTB);
  bf16x8 qr[4];
  #pragma unroll
  for(int d0=0;d0<4;++d0)qr[d0]=*reinterpret_cast<const bf16x8*>(&Qw[(long)r32*DM+d0*16+hi*8]);
  float mhat=0.f,l_reg=0.f;f32x16 o[2];o[0]=f32x16{};o[1]=f32x16{};f32x16 negm=f32x16{};asm volatile("":"+v"(negm));
  const int qrel=wid*QBLK+r32;
  #define CMASK(P0,P1,t) do{}while(0)
  bool resc=false;
  #define START(P0,P1) do{ const float rm=rowmax(P0,P1); resc=false; \
    { const float dl=rm; mhat=fadd_s(mhat,dl); \
      _Pragma("unroll") for(int r=0;r<16;++r){P0[r]=fsub_s(P0[r],dl);P1[r]=fsub_s(P1[r],dl);} \
      _Pragma("unroll") for(int r=0;r<16;++r)negm[r]=-mhat; asm volatile("":"+v"(negm)); } \
    _Pragma("unroll") for(int r=0;r<16;++r)P0[r]=__builtin_amdgcn_exp2f(P0[r]); }while(0)
  #define RESC() do{ if(resc){ asm volatile("s_waitcnt lgkmcnt(0)":::"memory"); \
      _Pragma("unroll") for(int d_=0;d_<2;++d_) _Pragma("unroll") for(int r=0;r<16;++r)o[d_][r]*=wsf[crow(r,hi)]; } }while(0)
  f32x16 pA0,pA1,pB0,pB1;
  int sl_prev=0,sl_cur=0,sl_next=SLOTB;
  #define ROT() do{sl_prev=sl_cur;sl_cur=sl_next;sl_next=(sl_next==(NSLOT-1)*SLOTB)?0:sl_next+SLOTB;}while(0)
  DMA_K(2,2*SLOTB);
  WAIT_BAR(3);
  qkt(pA0,pA1,Kbase,qr,negm,r32,hi);asm volatile("s_nop 15\n\ts_nop 7":"+v"(pA0),"+v"(pA1));CMASK(pA0,pA1,0);
  START(pA0,pA1);
  _Pragma("unroll") for(int r=0;r<16;++r)pA1[r]=__builtin_amdgcn_exp2f(pA1[r]);
  WAIT_BAR(0);
  DMA_K(3,0);DMA_V(1,SLOTB);
  ROT();
  kload8(kf,kp0+sl_cur);
  WAIT_BAR(2);
  s16x4 vlo[8],vhi[8]; u32x4 pw0,pw1,pw2,pw3;
  #define PKW(P,B) cvtpk_s(P[B],P[B+1])
  #define PAF(k) __builtin_bit_cast(bf16x8,pw##k)
  #define VFR(i) (bf16x8){vlo[i][0],vlo[i][1],vlo[i][2],vlo[i][3],vhi[i][0],vhi[i][1],vhi[i][2],vhi[i][3]}
  #define PIN(x) asm volatile("":"+v"(x))
  #define MX3(a,b,c) __builtin_fmaxf(__builtin_fmaxf((a),(b)),(c))
  #define GAPA(MF,A0,A1,A2,A3,W0,W1,PW) do{ MF; sacc+=A0; sacc+=A1; sacc+=A2; sacc+=A3; PIN(sacc); W0; W1; PIN(PW); SBAR(); }while(0)
  #define EX(v) __builtin_amdgcn_exp2f(v)
  #define GAPB(MF,X,B) do{ MF; X[B]=EX(X[B]); X[B+1]=EX(X[B+1]); X[B+2]=EX(X[B+2]); X[B+3]=EX(X[B+3]); PIN(X); SBAR(); }while(0)
  #define VRD(i) do{ vlo[i]=vtr(vp_+(((i)>>2)*4096+((i)&3)*1024)); vhi[i]=vtr(vp_+(((i)>>2)*4096+((i)&3)*1024+512)); }while(0)
  #define KRD(G,j) do{ if(G){ kload2(kf,kp0+sl_next,j); SBAR(); } }while(0)
  #define STEP(C0,C1,P0,P1,t,GK,GV,GL) do{ SBAR(); \
    const lds_cptr vp_=vp0+sl_prev; \
    VRD(0); SBAR(); float sacc=(P0[0]+P0[1]); \
    GAPA(C0=__builtin_amdgcn_mfma_f32_32x32x16_bf16(kf[0],qr[0],negm,0,0,0), P0[2],P0[3],P0[4],P0[5],     pw0[0]=PKW(P0,0), pw0[1]=PKW(P0,2), pw0); \
    VRD(4); SBAR(); GAPA(C1=__builtin_amdgcn_mfma_f32_32x32x16_bf16(kf[1],qr[0],negm,0,0,0), P0[6],P0[7],P0[8],P0[9],     pw0[2]=PKW(P0,4), pw0[3]=PKW(P0,6), pw0); \
    VRD(1); SBAR(); GAPA(C0=__builtin_amdgcn_mfma_f32_32x32x16_bf16(kf[2],qr[1],C0,0,0,0),   P0[10],P0[11],P0[12],P0[13], pw1[0]=PKW(P0,8), pw1[1]=PKW(P0,10), pw1); \
    VRD(5); SBAR(); GAPA(C1=__builtin_amdgcn_mfma_f32_32x32x16_bf16(kf[3],qr[1],C1,0,0,0),   P0[14],P0[15],P1[0],P1[1],   pw1[2]=PKW(P0,12),pw1[3]=PKW(P0,14), pw1); \
    VRD(2); SBAR(); GAPA(C0=__builtin_amdgcn_mfma_f32_32x32x16_bf16(kf[4],qr[2],C0,0,0,0),   P1[2],P1[3],P1[4],P1[5],     pw2[0]=PKW(P1,0), pw2[1]=PKW(P1,2), pw2); \
    VRD(6); SBAR(); GAPA(C1=__builtin_amdgcn_mfma_f32_32x32x16_bf16(kf[5],qr[2],C1,0,0,0),   P1[6],P1[7],P1[8],P1[9],     pw2[2]=PKW(P1,4), pw2[3]=PKW(P1,6), pw2); \
    VRD(3); SBAR(); GAPA(C0=__builtin_amdgcn_mfma_f32_32x32x16_bf16(kf[6],qr[3],C0,0,0,0),   P1[10],P1[11],P1[12],P1[13], pw3[0]=PKW(P1,8), pw3[1]=PKW(P1,10), pw3); \
    VRD(7); SBAR(); GAPA(C1=__builtin_amdgcn_mfma_f32_32x32x16_bf16(kf[7],qr[3],C1,0,0,0),   P1[14],P1[15],0.f,0.f,       pw3[2]=PKW(P1,12),pw3[3]=PKW(P1,14), pw3); \
    l_reg+=sacc; \
    if(GK){DMA_K((t)+3,sl_cur);} if(GV){DMA_V((t)+1,sl_next);} \
    CMASK(C0,C1,t); \
    { float a=MX3(C0[0],C0[1],C1[0]),b=MX3(C0[2],C0[3],C1[1]); a=MX3(a,C1[2],C1[3]); \
      _Pragma("unroll") for(int r=4;r<16;r+=4){a=MX3(a,C0[r],C0[r+1]);b=MX3(b,C0[r+2],C0[r+3]);a=MX3(a,C1[r],C1[r+1]);b=MX3(b,C1[r+2],C1[r+3]);} \
      float rm=__builtin_fmaxf(a,b); { auto rr=__builtin_amdgcn_permlane32_swap(__float_as_uint(rm),__float_as_uint(rm),false,false); rm=__builtin_fmaxf(__uint_as_float(rr[0]),__uint_as_float(rr[1])); } \
      resc=false; \
      if(__builtin_expect(__any(rm>(float)THRL),0)){ const float dl=__builtin_fmaxf(rm,0.f); mhat+=dl; \
        _Pragma("unroll") for(int r=0;r<16;++r){C0[r]-=dl;C1[r]-=dl;} \
        _Pragma("unroll") for(int r=0;r<16;++r)negm[r]=-mhat; asm volatile("":"+v"(negm)); \
        const float f=__builtin_amdgcn_exp2f(-dl); l_reg*=f; if(hi==0)wsf[r32]=f; resc=true; } } \
    SBAR(); \
    GAPB(o[0]=__builtin_amdgcn_mfma_f32_32x32x16_bf16(PAF(0),VFR(0),o[0],0,0,0), C0,0); \
    GAPB(o[1]=__builtin_amdgcn_mfma_f32_32x32x16_bf16(PAF(0),VFR(4),o[1],0,0,0), C0,4); \
    KRD(GL,0); GAPB(o[0]=__builtin_amdgcn_mfma_f32_32x32x16_bf16(PAF(1),VFR(1),o[0],0,0,0), C0,8); \
    KRD(GL,1); GAPB(o[1]=__builtin_amdgcn_mfma_f32_32x32x16_bf16(PAF(1),VFR(5),o[1],0,0,0), C0,12); \
    KRD(GL,2); GAPB(o[0]=__builtin_amdgcn_mfma_f32_32x32x16_bf16(PAF(2),VFR(2),o[0],0,0,0), C1,0); \
    KRD(GL,3); GAPB(o[1]=__builtin_amdgcn_mfma_f32_32x32x16_bf16(PAF(2),VFR(6),o[1],0,0,0), C1,4); \
    GAPB(o[0]=__builtin_amdgcn_mfma_f32_32x32x16_bf16(PAF(3),VFR(3),o[0],0,0,0), C1,8); \
    GAPB(o[1]=__builtin_amdgcn_mfma_f32_32x32x16_bf16(PAF(3),VFR(7),o[1],0,0,0), C1,12); \
    }while(0)
  int t=1;
  #undef CMASK
  #define CMASK(P0,P1,t) do{}while(0)
  for(;t+5<NT;t+=2){
    STEP(pB0,pB1,pA0,pA1,t,true,true,true);     WAIT_BAR(2); RESC(); ROT();
    STEP(pA0,pA1,pB0,pB1,t+1,true,true,true);   WAIT_BAR(2); RESC(); ROT();
  }
  #undef CMASK
  #define CMASK(P0,P1,t) do{}while(0)
  #define ENDW(tt) do{ if((tt)+3<NT){WAIT_BAR(2);} else if((tt)+2<NT){WAIT_BAR(1);} else {WAIT_BAR(0);} }while(0)
  for(;t+1<NT;t+=2){
    STEP(pB0,pB1,pA0,pA1,t,(t+3<NT),(t+1<NT),(t+1<NT));       ENDW(t);   RESC(); ROT();
    STEP(pA0,pA1,pB0,pB1,t+1,(t+4<NT),(t+2<NT),(t+2<NT));     ENDW(t+1); RESC(); ROT();
  }
  STEP(pB0,pB1,pA0,pA1,NT-1,false,false,false); RESC();
  { float sacc=pB0[0]+pB0[1]; _Pragma("unroll") for(int r=2;r<16;++r)sacc+=pB0[r]; _Pragma("unroll") for(int r=0;r<16;++r)sacc+=pB1[r]; l_reg+=sacc;
    pw0=(u32x4){PKW(pB0,0),PKW(pB0,2),PKW(pB0,4),PKW(pB0,6)};pw1=(u32x4){PKW(pB0,8),PKW(pB0,10),PKW(pB0,12),PKW(pB0,14)};pw2=(u32x4){PKW(pB1,0),PKW(pB1,2),PKW(pB1,4),PKW(pB1,6)};pw3=(u32x4){PKW(pB1,8),PKW(pB1,10),PKW(pB1,12),PKW(pB1,14)};
    SBAR(); pv(o,vb0+sl_cur,PAF(0),PAF(1),PAF(2),PAF(3)); }
  #undef PKW
  #undef PAF
  #undef VFR
  #undef PIN
  #undef MX3
  #undef GAPA
  #undef GAPB
  #undef EX
  #undef VRD
  #undef KRD
  #undef STEP
  #undef ENDW
  {auto rr=__builtin_amdgcn_permlane32_swap(__float_as_uint(l_reg),__float_as_uint(l_reg),false,false);l_reg=__uint_as_float(rr[0])+__uint_as_float(rr[1]);}
  if(hi==0)wsf[32+r32]=l_reg;asm volatile("s_waitcnt lgkmcnt(0)":::"memory");
  float rli[16];
  #pragma unroll
  for(int r=0;r<16;++r)rli[r]=__builtin_amdgcn_rcpf(wsf[32+crow(r,hi)]);
  bf16*Ow=O+(rowbase+q0+wid*QBLK)*ODM+h*D;
  { bf16*stg=(bf16*)(shm+LDS_OST)+wid*2048;
    #pragma unroll
    for(int r=0;r<16;++r){const int orow=crow(r,hi);
      #pragma unroll
      for(int d0=0;d0<2;++d0)stg[orow*64+d0*32+r32]=__float2bfloat16(o[d0][r]*rli[r]);}
    asm volatile("s_waitcnt lgkmcnt(0)":::"memory");
    #pragma unroll
    for(int i=0;i<4;++i){const int row=i*8+(lane>>3),ch=lane&7; const u32x4 v=*(const u32x4*)(stg+row*64+ch*8); ATTN_STORE16(Ow+(long)row*ODM+ch*8,v);} }
  asm volatile("s_waitcnt lgkmcnt(0)\n\ts_barrier":::"memory");
  #undef DMA_K
  #undef DMA_V
  #undef CMASK
  #undef START
  #undef RESC
  #undef ROT
}
constexpr int ATTN_LDS_BYTES=LDS_BYTES;
struct AttnTensors { const bf16* Q; const bf16* K; const bf16* V; bf16* O; };
struct AttnUnit { int bh; int qb; };
__device__ __forceinline__ void unit_decode(int n,AttnUnit&u){ const int grp=n>>6,wi=n&63; const int b=grp>>1,kvh=grp&1; u.bh=b*NHEAD+kvh*(NHEAD/NKV)+(wi>>4); u.qb=wi&15; }
#undef SBAR
#undef WAIT_BAR
}
constexpr int NWAVES = 8;
constexpr int BATCH = 8, SEQ = 4096, DMODEL = 1024, T = BATCH * SEQ;
constexpr int INW = 5376, QKVW = 768, HGW = 2560, GATEW = 2048;
constexpr int NEXP = 16384, PLED = 256;
constexpr float EPS = 1e-6f;
constexpr size_t MiB = 1u << 20;
constexpr size_t WS_CTL = 0, CTL_ZERO_BYTES = 1 * MiB;
constexpr size_t WS_ROPE = 1 * MiB;
constexpr size_t WS_GINV = WS_ROPE + 256 * 1024, WS_RMS = WS_GINV + 65536 * 4;
constexpr size_t WS_WIN = 2 * MiB;
constexpr size_t WS_WUA = 13 * MiB;
constexpr size_t WS_WOUT = 15 * MiB;
constexpr size_t WS_WPEER = 17 * MiB;
constexpr size_t WS_WPG = 21 * MiB;
constexpr size_t WS_XN = 24 * MiB;
constexpr size_t WS_QKV = 88 * MiB;
constexpr size_t WS_HG = 136 * MiB;
constexpr size_t WS_GATE = 296 * MiB;
constexpr size_t WS_END = 507 * MiB;
constexpr size_t WS_UB8 = 424 * MiB, WS_VB8 = 440 * MiB, WS_US = 456 * MiB;
constexpr size_t WS_IDX = WS_HG + 80 * MiB, WS_GW = WS_HG + 96 * MiB, WS_W = WS_HG + 112 * MiB;
constexpr size_t WS_H8 = 474 * MiB, WS_TSC = 506 * MiB;
constexpr size_t WS_X1B = WS_GATE, WS_PP = WS_GATE + 64 * MiB;
constexpr int CW_BAR = 4096;
constexpr int CW_QUEUE = 16384;
constexpr int CW_ROWSS = 131072;
constexpr int CW_ROWSS2 = CW_ROWSS + 32768;
static_assert((CW_ROWSS2 + 32768) * 4 <= (int)CTL_ZERO_BYTES, "ctl");
constexpr int SCR_BYTES = 147456;
constexpr int LDSCTL_OFF = SCR_BYTES, MISC_OFF = LDSCTL_OFF + 320;
constexpr int LDS_BYTES = SCR_BYTES + 1024;

#define GAS __attribute__((address_space(1)))
#define LAS __attribute__((address_space(3)))
typedef unsigned short bf16;
typedef unsigned v4u __attribute__((ext_vector_type(4)));
typedef unsigned v2u __attribute__((ext_vector_type(2)));
typedef float f32x4 __attribute__((ext_vector_type(4)));
typedef float f32x16 __attribute__((ext_vector_type(16)));
typedef short bf16x8 __attribute__((ext_vector_type(8)));
typedef GAS unsigned gu32;
#define RLX_AGENT __ATOMIC_RELAXED, __HIP_MEMORY_SCOPE_AGENT
#define LDS_WAIT() asm volatile("s_waitcnt lgkmcnt(0)" ::: "memory")
#define VM_WAIT() asm volatile("s_waitcnt vmcnt(0)" ::: "memory")
#define DI __device__ __forceinline__
DI int lane_id() { int l; asm volatile("v_mbcnt_lo_u32_b32 %0, -1, 0\n\tv_mbcnt_hi_u32_b32 %0, -1, %0" : "=v"(l)); return l; }
DI unsigned f2bf(float f) { unsigned u = __builtin_bit_cast(unsigned, f); return (u + 0x7fffu + ((u >> 16) & 1u)) >> 16; }
DI unsigned pk2(float lo, float hi) { typedef float f2 __attribute__((ext_vector_type(2))); typedef __bf16 b2 __attribute__((ext_vector_type(2))); f2 v = {lo, hi}; b2 b = __builtin_convertvector(v, b2); return __builtin_bit_cast(unsigned, b); }
DI float bflo(unsigned w) { return __uint_as_float(w << 16); }
DI float bfhi(unsigned w) { return __uint_as_float(w & 0xffff0000u); }
DI float fsigmoid(float x) { return __builtin_amdgcn_rcpf(1.0f + __builtin_amdgcn_exp2f(-1.4426950408889634f * x)); }
DI float fexp(float x) { return __builtin_amdgcn_exp2f(1.4426950408889634f * x); }
DI float wave_sum(float v) {
#pragma unroll
    for (int o = 1; o < 64; o <<= 1) v += __shfl_xor(v, o);
    return v;
}

#define XB_TMO      128
#define XB_XCNT(j)  (256  + 64 * (j))
#define XB_XSUB(j)  (1280 + 64 * (j))
#define XB_XGEN(j)  (2304 + 64 * (j))
#define XB_TOP      3328
#define XB_TOPGEN   3392
#define XCD_BAR_WORDS 3456
#define XB_SPIN_CAP (1u << 18)
DI unsigned xb_ld(unsigned* p)              { return __hip_atomic_load(p, __ATOMIC_RELAXED, __HIP_MEMORY_SCOPE_AGENT); }
DI unsigned xb_add(unsigned* p, unsigned v) { return __hip_atomic_fetch_add(p, v, __ATOMIC_RELAXED, __HIP_MEMORY_SCOPE_AGENT); }
DI unsigned xb_xcc_id() { return (unsigned)__builtin_amdgcn_s_getreg((3 << 11) | 20) & 0xFu; }
#define XB_SPIN(cond, bar) do { unsigned _sp = 0; while (cond) { __builtin_amdgcn_s_sleep(1); \
    if ((++_sp & 255u) == 0u) { if (xb_ld(&(bar)[XB_TMO])) break; if (_sp > XB_SPIN_CAP) { atomicAdd(&(bar)[XB_TMO], 1u); break; } } } } while (0)
struct XcdBarrier { unsigned* bar; unsigned x; volatile LAS unsigned* st; };
DI XcdBarrier xcd_barrier_post(unsigned* bar, volatile LAS unsigned* st, bool t0) {
    XcdBarrier b; b.bar = bar; b.x = xb_xcc_id(); b.st = st;
    if (t0) st[2] = xb_add(&bar[XB_XCNT(b.x)], 1u);
    return b;
}
DI void xcd_barrier_complete(unsigned* bar, unsigned x, unsigned& nloc, unsigned& nx) {
    const unsigned G = gridDim.x * gridDim.y * gridDim.z;
    unsigned sum, cnt, mine, sp = 0u;
    for (;;) {
        sum = 0u; cnt = 0u; mine = 0u;
#pragma unroll
        for (unsigned j = 0; j < 16; ++j) { const unsigned c = xb_ld(&bar[XB_XCNT(j)]); sum += c; cnt += (c > 0u) ? 1u : 0u; mine = (j == x) ? c : mine; }
        if (sum == G) break;
        __builtin_amdgcn_s_sleep(1);
        if ((++sp & 255u) == 0u) { if (xb_ld(&bar[XB_TMO])) break; if (sp > XB_SPIN_CAP) { atomicAdd(&bar[XB_TMO], 1u); break; } }
    }
    nloc = mine > 0u ? mine : 1u; nx = cnt > 0u ? cnt : 1u;
}
DI void xcd_barrier(const XcdBarrier& b, bool t0) {
    asm volatile("s_waitcnt vmcnt(0)" ::: "memory");
    __syncthreads();
    if (t0) {
        unsigned* bar = b.bar;
        __builtin_amdgcn_s_waitcnt(0);
        unsigned nloc = b.st[0], nx = b.st[1];
        if (nloc == 0u) { xcd_barrier_complete(bar, b.x, nloc, nx); b.st[0] = nloc; b.st[1] = nx; }
        const unsigned old = xb_add(&bar[XB_XSUB(b.x)], 1u);
        const unsigned gen = old / nloc;
        if (old + 1u == (gen + 1u) * nloc) {
            __builtin_amdgcn_fence(__ATOMIC_RELEASE, "agent");
            asm volatile("s_waitcnt vmcnt(0)" ::: "memory");
            const unsigned og = xb_add(&bar[XB_TOP], 1u);
            const unsigned tg = og / nx;
            if (og + 1u == (tg + 1u) * nx) xb_add(&bar[XB_TOPGEN], 1u);
            else XB_SPIN(xb_ld(&bar[XB_TOPGEN]) == tg, bar);
            __builtin_amdgcn_fence(__ATOMIC_ACQUIRE, "agent");
            xb_add(&bar[XB_XGEN(b.x)], 1u);
            asm volatile("s_waitcnt vmcnt(0)" ::: "memory");
        } else {
            XB_SPIN(xb_ld(&bar[XB_XGEN(b.x)]) == gen, bar);
            __builtin_amdgcn_fence(__ATOMIC_ACQUIRE, "agent");
            asm volatile("s_waitcnt vmcnt(0)" ::: "memory");
        }
    }
    __syncthreads();
}
DI void xcd_census(unsigned* bar, unsigned x, int& v, int& nx, int& nloc) {
    int vv = 0, cnt = 0, mine = 1;
#pragma unroll
    for (unsigned j = 0; j < 16; ++j) { const unsigned c = xb_ld(&bar[XB_XCNT(j)]); cnt += (c > 0u) ? 1 : 0; vv += (c > 0u && j < x) ? 1 : 0; if (j == x) mine = (int)c; }
    v = vv; nx = cnt > 0 ? cnt : 1; nloc = mine > 0 ? mine : 1;
}
DI void wg_l1_refresh(bool t0) {
    asm volatile("s_waitcnt vmcnt(0)" ::: "memory");
    __syncthreads();
    if (t0) { __builtin_amdgcn_fence(__ATOMIC_ACQUIRE, "agent"); asm volatile("s_waitcnt vmcnt(0)" ::: "memory"); }
    __syncthreads();
}

struct Frame {
    LAS unsigned char* lds;
    volatile LAS unsigned* MISC;
    gu32* ctl;
    int wave;
    int vcu, G;
    unsigned char* ws;
    float* out;
};
enum { I_X = 0, I_P, I_NORM_MIX, I_W_IN, I_Q_NORM, I_K_NORM, I_HG_LB, I_HG_ONORM, I_W_UP_ATT, I_W_UP_HG, I_W_OUT, I_NORM_FFN, I_PEER_WQ, I_PEER_SK, I_PEER_U, I_PEER_V, I_NORM_PLE, I_PLE_GATE, I_PLE_PROJ };
DI const float* inp(int k) {
    typedef const float* cfp;
    const __attribute__((address_space(4))) char* ka = (const __attribute__((address_space(4))) char*)__builtin_amdgcn_kernarg_segment_ptr();
    return *(const volatile __attribute__((address_space(4))) cfp*)(ka + 8 * k);
}

DI void p0_transpose_item(const float* W, int K, int N, bf16* WT, LAS float* scr, int item, int lane, const float* kgain = nullptr, int ldt = 0, int koff = 0) {
    if (ldt == 0) ldt = K;
    const int nblk = N / 32, kb = item / nblk, nb = item % nblk, k0 = 64 * kb, n0 = 32 * nb;
    float wv_[32];
#pragma unroll
    for (int i = 0; i < 32; ++i) { const int kk = 2 * i + (lane >> 5); wv_[i] = W[(size_t)(k0 + kk) * N + n0 + (lane & 31)]; }
#pragma unroll
    for (int i = 0; i < 32; ++i) { const int kk = 2 * i + (lane >> 5); scr[kk * 33 + (lane & 31)] = wv_[i] * (kgain ? kgain[k0 + kk] : 1.0f); }
    LDS_WAIT(); asm volatile("" ::: "memory");
    const int c = lane & 7;
#pragma unroll
    for (int j = 0; j < 4; ++j) { const int n = (lane >> 3) + 8 * j; const LAS float* s = scr + (8 * c) * 33 + n;
        v4u o; o.x = pk2(s[0 * 33], s[1 * 33]); o.y = pk2(s[2 * 33], s[3 * 33]); o.z = pk2(s[4 * 33], s[5 * 33]); o.w = pk2(s[6 * 33], s[7 * 33]);
        *(GAS v4u*)(WT + (size_t)(n0 + n) * ldt + koff + k0 + 8 * c) = o; }
    LDS_WAIT(); asm volatile("" ::: "memory");
}
DI void rms_row_to_bf16(int lane, const float* xrow, const float* gain, bf16* orow) {
    const GAS f32x4* xr = (const GAS f32x4*)xrow + lane; const GAS f32x4* gr = (const GAS f32x4*)gain + lane;
    f32x4 v[4]; float s = 0.f;
#pragma unroll
    for (int j = 0; j < 4; ++j) { v[j] = xr[64 * j]; s += (v[j].x * v[j].x + v[j].y * v[j].y) + (v[j].z * v[j].z + v[j].w * v[j].w); }
    const float rinv = __builtin_amdgcn_rsqf(wave_sum(s) * (1.f / DMODEL) + EPS);
    GAS unsigned long long* o8 = (GAS unsigned long long*)orow + lane;
#pragma unroll
    for (int j = 0; j < 4; ++j) { const f32x4 g = gr[64 * j]; o8[64 * j] = (unsigned long long)pk2(v[j].x * rinv * g.x, v[j].y * rinv * g.y) | ((unsigned long long)pk2(v[j].z * rinv * g.z, v[j].w * rinv * g.w) << 32); }
}
DI void p0_peer_w_item(Frame& F, int it) {
    const float* peer_subkeys = inp(I_PEER_SK); const float* peer_wq = inp(I_PEER_WQ); const float* norm_ffn = inp(I_NORM_FFN);
    const int hp = it >> 4, k0 = (it & 15) * 64, tid = (F.wave * 64 + lane_id());
    LAS float* skL = (LAS float*)F.lds; LAS float* wqL = (LAS float*)(F.lds + 128 * 132 * 4);
    const float* sk = peer_subkeys + (size_t)hp * 16384;
#pragma unroll
    for (int i = 0; i < 8; ++i) { const int idx = i * 2048 + tid * 4; const f32x4 v = *(const f32x4*)(sk + idx); *(LAS f32x4*)(skL + (idx >> 7) * 132 + (idx & 127)) = v; }
#pragma unroll
    for (int i = 0; i < 4; ++i) { const int idx = i * 2048 + tid * 4; const int k = idx >> 7, c = idx & 127; const f32x4 v = *(const f32x4*)(peer_wq + (size_t)(k0 + k) * 2048 + hp * 128 + c); *(LAS f32x4*)(wqL + k * 132 + c) = v; }
    __syncthreads();
    const int k = tid & 63, n0 = (tid >> 6) * 16;
    float acc[16];
#pragma unroll
    for (int n = 0; n < 16; ++n) acc[n] = 0.f;
    for (int c4 = 0; c4 < 32; ++c4) { const f32x4 wv = *(const LAS f32x4*)(wqL + k * 132 + c4 * 4);
#pragma unroll
        for (int n = 0; n < 16; ++n) { const f32x4 sv = *(const LAS f32x4*)(skL + (n0 + n) * 132 + c4 * 4); acc[n] += (wv.x * sv.x + wv.y * sv.y) + (wv.z * sv.z + wv.w * sv.w); } }
    const float gffn = norm_ffn[k0 + k];
    bf16* WT = (bf16*)(F.ws + WS_WPEER);
#pragma unroll
    for (int n = 0; n < 16; ++n) WT[(size_t)(hp * 128 + n0 + n) * 1024 + k0 + k] = (bf16)f2bf(acc[n] * gffn);
    __syncthreads();
}
DI void p0_prologue(Frame& F) {
    { float* rope = (float*)(F.ws + WS_ROPE);
      for (int e = (int)blockIdx.x * (NWAVES * 64) + (F.wave * 64 + lane_id()); e < 1024; e += F.G * NWAVES * 64) { const int pos = e >> 4, fi = e & 15;
          const float ang = (float)pos * __builtin_powf(10000.0f, -(float)fi * (1.0f / 16.0f)); rope[2 * e] = cosf(ang); rope[2 * e + 1] = sinf(ang);
          ((float*)(F.ws + WS_GINV))[e] = 1.0f / inp(I_NORM_MIX)[e]; } }
    for (int it = blockIdx.x; it < 256; it += F.G) p0_peer_w_item(F, it);
    LAS float* scr = (LAS float*)(F.lds + F.wave * 16384);
    const int gw = F.vcu * NWAVES + F.wave, NGW = F.G * NWAVES;
    constexpr int I_IN = (1024 / 64) * (INW / 32), I_UA = (512 / 64) * (1024 / 32), I_OUT = (1024 / 64) * (1024 / 32), I_PP = (256 / 64) * (1024 / 32);
    constexpr int NITEMS = I_IN + 2 * I_UA + 2 * I_OUT + I_PP;
    for (int it = gw; it < NITEMS; it += NGW) {
        int r = it;
        if (r < I_IN) { p0_transpose_item(inp(I_W_IN), 1024, INW, (bf16*)(F.ws + WS_WIN), scr, r, lane_id()); continue; } r -= I_IN;
        if (r < I_UA) { p0_transpose_item(inp(I_W_UP_ATT), 512, 1024, (bf16*)(F.ws + WS_WUA), scr, r, lane_id(), nullptr, 1024, 0); continue; } r -= I_UA;
        if (r < I_UA) { p0_transpose_item(inp(I_W_UP_HG), 512, 1024, (bf16*)(F.ws + WS_WUA), scr, r, lane_id(), nullptr, 1024, 512); continue; } r -= I_UA;
        if (r < I_OUT) { p0_transpose_item(inp(I_W_OUT), 1024, 1024, (bf16*)(F.ws + WS_WOUT), scr, r, lane_id()); continue; } r -= I_OUT;
        if (r < I_OUT) { p0_transpose_item(inp(I_PLE_GATE), 1024, 1024, (bf16*)(F.ws + WS_WPG), scr, r, lane_id(), inp(I_NORM_PLE), 1280, 256); continue; } r -= I_OUT;
        p0_transpose_item(inp(I_PLE_PROJ), 256, 1024, (bf16*)(F.ws + WS_WPG), scr, r, lane_id(), nullptr, 1280, 0);
    }
    bf16* XN = (bf16*)(F.ws + WS_XN);
    const float* x = inp(I_X); const float* norm_mix = inp(I_NORM_MIX);
    {
        int lane_ = lane_id(); asm volatile("" : "+v"(lane_));
        const int lane = lane_;
        f32x4 gq[4], vn[4];
#pragma unroll
        for (int j = 0; j < 4; ++j) gq[j] = ((const GAS f32x4*)norm_mix)[lane + 64 * j];
        if (gw < T) {
#pragma unroll
            for (int j = 0; j < 4; ++j) vn[j] = ((const GAS f32x4*)(x + (size_t)gw * DMODEL))[lane + 64 * j]; }
        for (int m = gw; m < T; m += NGW) {
            f32x4 v[4];
#pragma unroll
            for (int j = 0; j < 4; ++j) v[j] = vn[j];
            if (m + NGW < T) {
#pragma unroll
                for (int j = 0; j < 4; ++j) vn[j] = ((const GAS f32x4*)(x + (size_t)(m + NGW) * DMODEL))[lane + 64 * j]; }
            float sq = 0.f;
#pragma unroll
            for (int j = 0; j < 4; ++j) sq += (v[j].x * v[j].x + v[j].y * v[j].y) + (v[j].z * v[j].z + v[j].w * v[j].w);
            const float rinv = __builtin_amdgcn_rsqf(wave_sum(sq) * (1.f / DMODEL) + EPS);
            if (lane == 0) ((float*)(F.ws + WS_RMS))[m] = 1.0f / rinv;
            GAS unsigned long long* o8 = (GAS unsigned long long*)(XN + (size_t)m * DMODEL) + lane;
#pragma unroll
            for (int j = 0; j < 4; ++j) o8[64 * j] = (unsigned long long)pk2(v[j].x * rinv * gq[j].x, v[j].y * rinv * gq[j].y) | ((unsigned long long)pk2(v[j].z * rinv * gq[j].z, v[j].w * rinv * gq[j].w) << 32);
        }
    }
}

DI void p1b_rope(Frame& F) {
    const int gw = F.vcu * NWAVES + F.wave, NGW = F.G * NWAVES, lane = lane_id();
    bf16* QKV = (bf16*)(F.ws + WS_QKV);
    const float gq = inp(I_Q_NORM)[lane], gk = inp(I_K_NORM)[lane];
    const int axis = lane >> 5, hf = (lane >> 4) & 1, fi = lane & 15;
    const float inv = __builtin_powf(10000.0f, -(float)fi * (1.0f / 16.0f));
    constexpr float C2 = 0.125f * 1.4426950408889634f;
    for (int m = gw; m < T; m += NGW) {
        const int t = m & (SEQ - 1); const float pos = (float)(axis ? (t & 63) : (t >> 6));
        const float ang = pos * inv; float sn, cs;
        sn = sinf(ang); cs = cosf(ang);
        bf16* row = QKV + (size_t)m * QKVW;
        float xv[10];
#pragma unroll
        for (int hh = 0; hh < 10; ++hh) xv[hh] = __uint_as_float((unsigned)row[hh * 64 + lane] << 16);
#pragma unroll
        for (int hh = 0; hh < 10; ++hh) {
            const float ss = wave_sum(xv[hh] * xv[hh]);
            const float y = xv[hh] * __builtin_amdgcn_rsqf(ss * (1.0f / 64.0f) + EPS) * (hh < 8 ? gq : gk);
            const float yp = __shfl_xor(y, 16);
            float o = hf ? (yp * sn + y * cs) : (y * cs - yp * sn);
            if (hh < 8) o *= C2;
            row[hh * 64 + lane] = (bf16)f2bf(o);
        }
    }
}
#define MFMA32(a, b, c) __builtin_amdgcn_mfma_f32_32x32x16_bf16((a), (b), (c), 0, 0, 0)
DI int crow16(int r, int hi) { return (r & 3) + 8 * (r >> 2) + 4 * hi; }
template <int CTRL, int RM> DI float dpp0(float x) { return __int_as_float(__builtin_amdgcn_update_dpp(0, __float_as_int(x), CTRL, RM, 0xf, false)); }
DI float wave_incl_scan(float x) {
    x += dpp0<0x111, 0xf>(x); x += dpp0<0x112, 0xf>(x); x += dpp0<0x114, 0xf>(x); x += dpp0<0x118, 0xf>(x);
    x += dpp0<0x142, 0xa>(x); x += dpp0<0x143, 0xc>(x);
    return x;
}
template <int K> DI void mma_tile(f32x16& acc, const LAS bf16* A, int lda, int m0, const LAS bf16* Bt, int ldb, int n0, int r32, int hi) {
    const LAS bf16* ap = A + (m0 + r32) * lda + 8 * hi; const LAS bf16* bp = Bt + (n0 + r32) * ldb + 8 * hi;
    bf16x8 a[K / 16], b[K / 16];
#pragma unroll
    for (int k = 0; k < K / 16; ++k) { a[k] = *(const LAS bf16x8*)(ap + 16 * k); b[k] = *(const LAS bf16x8*)(bp + 16 * k); }
    __builtin_amdgcn_sched_barrier(0);
#pragma unroll
    for (int k = 0; k < K / 16; ++k) acc = MFMA32(a[k], b[k], acc);
}
constexpr int HG_LDK = 136, HG_LDS_ = 72;
constexpr int HGO_QT = 0, HGO_KT = HGO_QT + 64 * HG_LDK * 2, HGO_QE = HGO_KT + 64 * HG_LDK * 2, HGO_KDT = HGO_QE + 64 * HG_LDK * 2, HGO_VT = HGO_KDT + 128 * HG_LDS_ * 2,
              HGO_AM = HGO_VT + 128 * HG_LDS_ * 2, HGO_ST = HGO_AM + 64 * HG_LDS_ * 2, HGO_DEC = HGO_ST + 128 * HG_LDK * 2, HGO_END = HGO_DEC + 512;
static_assert(HGO_END <= SCR_BYTES, "hgrn lds");
#ifndef HG_SKIP
#define HG_SKIP 0
#endif
#define LDS_BAR() asm volatile("s_waitcnt lgkmcnt(0)\n\ts_barrier" ::: "memory")
DI void hgrn_item(Frame& F, int item) {
    const int b = item >> 3, h = (item >> 1) & 3, dir = item & 1;
    int tid_ = F.wave * 64 + lane_id(); asm volatile("" : "+v"(tid_));
    const int tid = tid_, lane = tid & 63, w = __builtin_amdgcn_readfirstlane(tid >> 6), r32 = lane & 31, hi = lane >> 5;
    LAS bf16* QT = (LAS bf16*)(F.lds + HGO_QT); LAS bf16* KT = (LAS bf16*)(F.lds + HGO_KT); LAS bf16* QE = (LAS bf16*)(F.lds + HGO_QE);
    LAS bf16* KDT = (LAS bf16*)(F.lds + HGO_KDT); LAS bf16* VT = (LAS bf16*)(F.lds + HGO_VT); LAS bf16* AM = (LAS bf16*)(F.lds + HGO_AM);
    LAS bf16* ST = (LAS bf16*)(F.lds + HGO_ST); LAS float* DEC = (LAS float*)(F.lds + HGO_DEC);
    __syncthreads();
    for (int i = tid; i < (128 * HG_LDK * 2) / 16; i += NWAVES * 64) ((LAS v4u*)ST)[i] = (v4u){0u, 0u, 0u, 0u};
    for (int i = tid; i < (64 * HG_LDS_ * 2) / 16; i += NWAVES * 64) ((LAS v4u*)AM)[i] = (v4u){0u, 0u, 0u, 0u};
    const bf16* HGb = (const bf16*)(F.ws + WS_HG);
    bf16* OD = (bf16*)(F.ws + WS_HG) + 512 * (1 + dir);
    const int colq = h * 128, colf = 512 * (1 + dir) + h * 128, coli = 1536 + h * 128;
    f32x16 s0, s1;
#pragma unroll
    for (int i = 0; i < 16; ++i) { s0[i] = 0.f; s1[i] = 0.f; }
    const int pt0 = tid >> 4, pc8 = (tid & 15) * 8;
    v4u nq[2], nf[2], ni[2];
    { const int chunk = dir ? 63 : 0;
#pragma unroll
      for (int pp = 0; pp < 2; ++pp) { const int t = pt0 + 32 * pp; const size_t tok = (size_t)b * SEQ + chunk * 64 + (dir ? 63 - t : t); const bf16* row = HGb + tok * HGW + pc8;
          nq[pp] = *(const v4u*)(row + colq); nf[pp] = *(const v4u*)(row + colf); }
      { const size_t tok = (size_t)b * SEQ + chunk * 64 + (dir ? 63 - lane : lane); const bf16* row = HGb + tok * HGW + coli + 16 * w; ni[0] = *(const v4u*)row; ni[1] = *(const v4u*)(row + 8); } }
    const int tb = w & 1, eb = w >> 1, db = w & 3, eb2 = 2 * (w >> 2);
    for (int step = 0; step < 64; ++step) {
        const int chunk = dir ? 63 - step : step;
        const size_t tok0 = (size_t)b * SEQ + chunk * 64;
#pragma unroll
        for (int pp = 0; pp < 2; ++pp) { const int t = pt0 + 32 * pp;
            *(LAS v4u*)(QT + t * HG_LDK + pc8) = nq[pp]; *(LAS v4u*)(KT + t * HG_LDK + pc8) = nf[pp]; }
        { const unsigned va[8] = {ni[0].x, ni[0].y, ni[0].z, ni[0].w, ni[1].x, ni[1].y, ni[1].z, ni[1].w};
#pragma unroll
          for (int j = 0; j < 8; ++j) { VT[(16 * w + 2 * j) * HG_LDS_ + lane] = (bf16)(va[j] & 0xffffu); VT[(16 * w + 2 * j + 1) * HG_LDS_ + lane] = (bf16)(va[j] >> 16); } }
        if (step + 1 < 64 && !(HG_SKIP & 16)) { const int nchunk = dir ? 62 - step : step + 1;
#pragma unroll
            for (int pp = 0; pp < 2; ++pp) { const int t = pt0 + 32 * pp; const size_t tok = (size_t)b * SEQ + nchunk * 64 + (dir ? 63 - t : t); const bf16* row = HGb + tok * HGW + pc8;
                nq[pp] = *(const v4u*)(row + colq); nf[pp] = *(const v4u*)(row + colf); }
            { const size_t tok = (size_t)b * SEQ + nchunk * 64 + (dir ? 63 - lane : lane); const bf16* row = HGb + tok * HGW + coli + 16 * w; ni[0] = *(const v4u*)row; ni[1] = *(const v4u*)(row + 8); } }
        LDS_BAR();
        const v4u cq0 = *(const LAS v4u*)(QT + lane * HG_LDK + 16 * w), cq1 = *(const LAS v4u*)(QT + lane * HG_LDK + 16 * w + 8);
        const v4u cf0 = *(const LAS v4u*)(KT + lane * HG_LDK + 16 * w), cf1 = *(const LAS v4u*)(KT + lane * HG_LDK + 16 * w + 8);
        if (!(HG_SKIP & 1)) {
            const unsigned qa[8] = {cq0.x, cq0.y, cq0.z, cq0.w, cq1.x, cq1.y, cq1.z, cq1.w};
            const unsigned fa[8] = {cf0.x, cf0.y, cf0.z, cf0.w, cf1.x, cf1.y, cf1.z, cf1.w};
            float qt[16], kt[16], qe[16], kd[16];
            {
                float bc[16], kk[16];
#pragma unroll
                for (int j = 0; j < 16; ++j) { bc[j] = (j & 1) ? bfhi(fa[j >> 1]) : bflo(fa[j >> 1]); kk[j] = 1.0f - __builtin_amdgcn_exp2f(bc[j]); }
#pragma unroll
                for (int j = 0; j < 16; ++j) bc[j] += dpp0<0x111, 0xf>(bc[j]);
#pragma unroll
                for (int j = 0; j < 16; ++j) bc[j] += dpp0<0x112, 0xf>(bc[j]);
#pragma unroll
                for (int j = 0; j < 16; ++j) bc[j] += dpp0<0x114, 0xf>(bc[j]);
#pragma unroll
                for (int j = 0; j < 16; ++j) bc[j] += dpp0<0x118, 0xf>(bc[j]);
#pragma unroll
                for (int j = 0; j < 16; ++j) bc[j] += dpp0<0x142, 0xa>(bc[j]);
#pragma unroll
                for (int j = 0; j < 16; ++j) bc[j] += dpp0<0x143, 0xc>(bc[j]);
#pragma unroll
                for (int j = 0; j < 16; ++j) {
                    const float q = (j & 1) ? bfhi(qa[j >> 1]) : bflo(qa[j >> 1]);
                    const float E = __builtin_amdgcn_exp2f(bc[j]), R = __builtin_amdgcn_exp2f(-bc[j]);
                    const float E31 = __int_as_float(__builtin_amdgcn_readlane(__float_as_int(E), 31));
                    const float E63 = __int_as_float(__builtin_amdgcn_readlane(__float_as_int(E), 63));
                    const float R31 = __int_as_float(__builtin_amdgcn_readlane(__float_as_int(R), 31));
                    const float kR = kk[j] * R;
                    qe[j] = q * E; qt[j] = qe[j] * R31; kt[j] = kR * E31; kd[j] = kR * E63;
                    if (lane == 63) DEC[16 * w + j] = E63;
                }
            }
            v4u o;
            o = (v4u){pk2(qt[0], qt[1]), pk2(qt[2], qt[3]), pk2(qt[4], qt[5]), pk2(qt[6], qt[7])}; *(LAS v4u*)(QT + lane * HG_LDK + 16 * w) = o;
            o = (v4u){pk2(qt[8], qt[9]), pk2(qt[10], qt[11]), pk2(qt[12], qt[13]), pk2(qt[14], qt[15])}; *(LAS v4u*)(QT + lane * HG_LDK + 16 * w + 8) = o;
            o = (v4u){pk2(kt[0], kt[1]), pk2(kt[2], kt[3]), pk2(kt[4], kt[5]), pk2(kt[6], kt[7])}; *(LAS v4u*)(KT + lane * HG_LDK + 16 * w) = o;
            o = (v4u){pk2(kt[8], kt[9]), pk2(kt[10], kt[11]), pk2(kt[12], kt[13]), pk2(kt[14], kt[15])}; *(LAS v4u*)(KT + lane * HG_LDK + 16 * w + 8) = o;
            o = (v4u){pk2(qe[0], qe[1]), pk2(qe[2], qe[3]), pk2(qe[4], qe[5]), pk2(qe[6], qe[7])}; *(LAS v4u*)(QE + lane * HG_LDK + 16 * w) = o;
            o = (v4u){pk2(qe[8], qe[9]), pk2(qe[10], qe[11]), pk2(qe[12], qe[13]), pk2(qe[14], qe[15])}; *(LAS v4u*)(QE + lane * HG_LDK + 16 * w + 8) = o;
#pragma unroll
            for (int j = 0; j < 16; j += 2) { const unsigned kp = pk2(kd[j], kd[j + 1]);
                KDT[(16 * w + j) * HG_LDS_ + lane] = (bf16)(kp & 0xffffu); KDT[(16 * w + j + 1) * HG_LDS_ + lane] = (bf16)(kp >> 16);
            }
        }
        LDS_BAR();
        f32x16 o;
#pragma unroll
        for (int i = 0; i < 16; ++i) o[i] = 0.f;
        if (!(HG_SKIP & 2)) mma_tile<128>(o, QE, HG_LDK, tb * 32, ST, HG_LDK, eb * 32, r32, hi);
        if (w < 3 && !(HG_SKIP & 2)) {
            const int ti = (w == 0) ? 0 : 1, sj = (w == 2) ? 1 : 0;
            f32x16 a;
#pragma unroll
            for (int i = 0; i < 16; ++i) a[i] = 0.f;
            mma_tile<128>(a, QT, HG_LDK, ti * 32, KT, HG_LDK, sj * 32, r32, hi);
#pragma unroll
            for (int i = 0; i < 16; i += 2) { const int tl = crow16(i, hi); float v0 = a[i], v1 = a[i + 1]; if (ti == sj && r32 > tl) v0 = 0.f; if (ti == sj && r32 > tl + 1) v1 = 0.f; const unsigned pp = pk2(v0, v1);
                AM[(ti * 32 + tl) * HG_LDS_ + sj * 32 + r32] = (bf16)(pp & 0xffffu); AM[(ti * 32 + tl + 1) * HG_LDS_ + sj * 32 + r32] = (bf16)(pp >> 16); }
        }
        LDS_BAR();
        if (!(HG_SKIP & 4)) { if (tb) mma_tile<64>(o, AM, HG_LDS_, 32, VT, HG_LDS_, eb * 32, r32, hi); else mma_tile<32>(o, AM, HG_LDS_, 0, VT, HG_LDS_, eb * 32, r32, hi); }
        if (!(HG_SKIP & 8))
#pragma unroll
        for (int i = 0; i < 16; i += 2) { const int tl = tb * 32 + crow16(i, hi); const size_t tokA = tok0 + (dir ? 63 - tl : tl), tokB = tok0 + (dir ? 62 - tl : tl + 1); const unsigned pp = pk2(o[i], o[i + 1]);
            OD[tokA * HGW + h * 128 + eb * 32 + r32] = (bf16)(pp & 0xffffu); OD[tokB * HGW + h * 128 + eb * 32 + r32] = (bf16)(pp >> 16); }
        if (!(HG_SKIP & 4)) {
            float dc[16];
#pragma unroll
            for (int i = 0; i < 16; ++i) dc[i] = DEC[db * 32 + crow16(i, hi)];
#pragma unroll
            for (int i = 0; i < 16; ++i) { s0[i] *= dc[i]; s1[i] *= dc[i]; }
            mma_tile<64>(s0, KDT, HG_LDS_, db * 32, VT, HG_LDS_, eb2 * 32, r32, hi);
            mma_tile<64>(s1, KDT, HG_LDS_, db * 32, VT, HG_LDS_, (eb2 + 1) * 32, r32, hi);
#pragma unroll
            for (int g4 = 0; g4 < 4; ++g4) {
                v2u p0 = {pk2(s0[4 * g4], s0[4 * g4 + 1]), pk2(s0[4 * g4 + 2], s0[4 * g4 + 3])}; *(LAS v2u*)(ST + (eb2 * 32 + r32) * HG_LDK + db * 32 + 8 * g4 + 4 * hi) = p0;
                v2u p1 = {pk2(s1[4 * g4], s1[4 * g4 + 1]), pk2(s1[4 * g4 + 2], s1[4 * g4 + 3])}; *(LAS v2u*)(ST + ((eb2 + 1) * 32 + r32) * HG_LDK + db * 32 + 8 * g4 + 4 * hi) = p1;
            }
        }
        LDS_BAR();
    }
}

DI void p2b_ohn(Frame& F, bf16* AO) {
    int lane_ = lane_id(); asm volatile("" : "+v"(lane_));
    const int gw = F.vcu * NWAVES + F.wave, NGW = F.G * NWAVES, lane = lane_;
    bf16* HGb = (bf16*)(F.ws + WS_HG);
    float gn[8];
#pragma unroll
    for (int j = 0; j < 8; ++j) gn[j] = inp(I_HG_ONORM)[(8 * lane + j) & 127];
    for (int m = gw; m < T; m += NGW) {
        const v4u a = *(const v4u*)(HGb + (size_t)m * HGW + 512 + 8 * lane), bb = *(const v4u*)(HGb + (size_t)m * HGW + 1024 + 8 * lane), gg = *(const v4u*)(HGb + (size_t)m * HGW + 2048 + 8 * lane);
        const unsigned aa[4] = {a.x, a.y, a.z, a.w}, ba[4] = {bb.x, bb.y, bb.z, bb.w}, ga[4] = {gg.x, gg.y, gg.z, gg.w};
        float v[8]; float ss = 0.f;
#pragma unroll
        for (int j = 0; j < 4; ++j) { v[2 * j] = bflo(aa[j]) + bflo(ba[j]); v[2 * j + 1] = bfhi(aa[j]) + bfhi(ba[j]); ss += v[2 * j] * v[2 * j] + v[2 * j + 1] * v[2 * j + 1]; }
        ss += __shfl_xor(ss, 1); ss += __shfl_xor(ss, 2); ss += __shfl_xor(ss, 4); ss += __shfl_xor(ss, 8);
        const float rinv = __builtin_amdgcn_rsqf(ss * (1.0f / 128.0f) + EPS);
        float o[8];
#pragma unroll
        for (int j = 0; j < 8; ++j) { const float hg = (j & 1) ? bfhi(ga[j >> 1]) : bflo(ga[j >> 1]); o[j] = v[j] * rinv * gn[j] * hg; }
        *(v4u*)(AO + (size_t)m * 1024 + 512 + 8 * lane) = (v4u){pk2(o[0], o[1]), pk2(o[2], o[3]), pk2(o[4], o[5]), pk2(o[6], o[7])};
    }
}

DI void cvt_f32_bf16(Frame& F, const float* src, bf16* dst, size_t g_lo, size_t g_hi) {
    for (size_t i = g_lo + (F.wave * 64 + lane_id()); i < g_hi; i += NWAVES * 64) { const f32x4 a = *(const f32x4*)(src + i * 8), b = *(const f32x4*)(src + i * 8 + 4);
        *(v4u*)(dst + i * 8) = (v4u){pk2(a.x, a.y), pk2(a.z, a.w), pk2(b.x, b.y), pk2(b.z, b.w)}; }
}

DI void cvt_p_rows(Frame& F, const float* p, bf16* aple, int r0, int r1) {
    const int tid = F.wave * 64 + lane_id();
    for (int r = r0 + (tid >> 5); r < r1; r += (NWAVES * 64) >> 5) { const int c = (tid & 31) * 8; const f32x4 a = *(const f32x4*)(p + (size_t)r * PLED + c), b = *(const f32x4*)(p + (size_t)r * PLED + c + 4);
        *(v4u*)(aple + (size_t)r * 1280 + c) = (v4u){pk2(a.x, a.y), pk2(a.z, a.w), pk2(b.x, b.y), pk2(b.z, b.w)}; }
}
template <bool SLICED> DI void cvt_rows_fp8(Frame& F, const float* src, unsigned char* dst8, float* scale2, int which, int e0, int e1) {
    int lane_ = lane_id(); asm volatile("" : "+v"(lane_));
    const int lane = lane_;
    for (int e = e0 + F.wave; e < e1; e += NWAVES) {
        const float* r = src + (size_t)e * DMODEL + 16 * lane;
        const f32x4 a = *(const f32x4*)r, b = *(const f32x4*)(r + 4), c = *(const f32x4*)(r + 8), d = *(const f32x4*)(r + 12);
        float m = fmaxf(fmaxf(fmaxf(fabsf(a.x), fabsf(a.y)), fmaxf(fabsf(a.z), fabsf(a.w))), fmaxf(fmaxf(fabsf(b.x), fabsf(b.y)), fmaxf(fabsf(b.z), fabsf(b.w))));
        m = fmaxf(m, fmaxf(fmaxf(fmaxf(fabsf(c.x), fabsf(c.y)), fmaxf(fabsf(c.z), fabsf(c.w))), fmaxf(fmaxf(fabsf(d.x), fabsf(d.y)), fmaxf(fabsf(d.z), fabsf(d.w)))));
#pragma unroll
        for (int o = 1; o < 64; o <<= 1) m = fmaxf(m, __shfl_xor(m, o));
        const float sc = m > 0.f ? m * (1.0f / 256.0f) : 1.0f, inv = 1.0f / sc;
        v4u w;
        { int t = 0; t = __builtin_amdgcn_cvt_pk_fp8_f32(a.x * inv, a.y * inv, t, false); t = __builtin_amdgcn_cvt_pk_fp8_f32(a.z * inv, a.w * inv, t, true); w.x = (unsigned)t; }
        { int t = 0; t = __builtin_amdgcn_cvt_pk_fp8_f32(b.x * inv, b.y * inv, t, false); t = __builtin_amdgcn_cvt_pk_fp8_f32(b.z * inv, b.w * inv, t, true); w.y = (unsigned)t; }
        { int t = 0; t = __builtin_amdgcn_cvt_pk_fp8_f32(c.x * inv, c.y * inv, t, false); t = __builtin_amdgcn_cvt_pk_fp8_f32(c.z * inv, c.w * inv, t, true); w.z = (unsigned)t; }
        { int t = 0; t = __builtin_amdgcn_cvt_pk_fp8_f32(d.x * inv, d.y * inv, t, false); t = __builtin_amdgcn_cvt_pk_fp8_f32(d.z * inv, d.w * inv, t, true); w.w = (unsigned)t; }
        if (SLICED) *(v4u*)(dst8 + ((size_t)(lane >> 3) * NEXP + e) * 128 + (lane & 7) * 16) = w;
        else *(v4u*)(dst8 + (size_t)e * DMODEL + 16 * lane) = w;
        if (lane == 0) scale2[2 * e + which] = sc;
    }
}
DI void cvt_rows_i8(Frame& F, const float* src, unsigned char* dst8, float* scale2, int which, int e0, int e1) {
    int lane_ = lane_id(); asm volatile("" : "+v"(lane_));
    const int lane = lane_;
    for (int e = e0 + F.wave; e < e1; e += NWAVES) {
        const float* r = src + (size_t)e * DMODEL + 16 * lane;
        const f32x4 a = *(const f32x4*)r, b = *(const f32x4*)(r + 4), c = *(const f32x4*)(r + 8), d = *(const f32x4*)(r + 12);
        float m = fmaxf(fmaxf(fmaxf(fabsf(a.x), fabsf(a.y)), fmaxf(fabsf(a.z), fabsf(a.w))), fmaxf(fmaxf(fabsf(b.x), fabsf(b.y)), fmaxf(fabsf(b.z), fabsf(b.w))));
        m = fmaxf(m, fmaxf(fmaxf(fmaxf(fabsf(c.x), fabsf(c.y)), fmaxf(fabsf(c.z), fabsf(c.w))), fmaxf(fmaxf(fabsf(d.x), fabsf(d.y)), fmaxf(fabsf(d.z), fabsf(d.w)))));
#pragma unroll
        for (int o = 1; o < 64; o <<= 1) m = fmaxf(m, __shfl_xor(m, o));
        const float sc = m > 0.f ? m * (1.0f / 127.0f) : 1.0f, inv = 1.0f / sc;
#define PK4I8(v) ((unsigned)((int)__builtin_rintf((v).x * inv) & 0xff) | ((unsigned)((int)__builtin_rintf((v).y * inv) & 0xff) << 8) | ((unsigned)((int)__builtin_rintf((v).z * inv) & 0xff) << 16) | ((unsigned)((int)__builtin_rintf((v).w * inv) & 0xff) << 24))
        const v4u w = {PK4I8(a), PK4I8(b), PK4I8(c), PK4I8(d)};
#undef PK4I8
        *(v4u*)(dst8 + (size_t)e * DMODEL + 16 * lane) = w;
        if (lane == 0) scale2[2 * e + which] = sc;
    }
}
DI void cvt_rows_fp4(Frame& F, const float* src, unsigned char* dst4, float* scale2, int which, int e0, int e1) {
    int lane_ = lane_id(); asm volatile("" : "+v"(lane_));
    const int lane = lane_;
    for (int e = e0 + F.wave; e < e1; e += NWAVES) {
        const float* r = src + (size_t)e * DMODEL + 16 * lane;
        const f32x4 a = *(const f32x4*)r, b = *(const f32x4*)(r + 4), c = *(const f32x4*)(r + 8), d = *(const f32x4*)(r + 12);
        float ss = a.x * a.x + a.y * a.y + a.z * a.z + a.w * a.w + b.x * b.x + b.y * b.y + b.z * b.z + b.w * b.w + c.x * c.x + c.y * c.y + c.z * c.z + c.w * c.w + d.x * d.x + d.y * d.y + d.z * d.z + d.w * d.w;
#pragma unroll
        for (int o = 1; o < 64; o <<= 1) ss += __shfl_xor(ss, o);
        const float sc = ss > 0.f ? 0.5f * __builtin_sqrtf(ss * (1.0f / 1024.0f)) : 1.0f, inv = 1.0f / sc;
        const float xs[16] = {a.x, a.y, a.z, a.w, b.x, b.y, b.z, b.w, c.x, c.y, c.z, c.w, d.x, d.y, d.z, d.w};
        unsigned w[2] = {0u, 0u};
#pragma unroll
        for (int k = 0; k < 16; ++k) { const float m = fabsf(xs[k]) * inv;
            const unsigned code = (m > 0.25f ? 1u : 0u) + (m > 0.75f ? 1u : 0u) + (m > 1.25f ? 1u : 0u) + (m > 1.75f ? 1u : 0u) + (m > 2.5f ? 1u : 0u) + (m > 3.5f ? 1u : 0u) + (m > 5.0f ? 1u : 0u);
            w[k >> 3] |= (code | (xs[k] < 0.f ? 8u : 0u)) << (4 * (k & 7)); }
        *(v2u*)(dst4 + ((size_t)(lane >> 4) * NEXP + e) * 128 + 8 * (lane & 15)) = (v2u){w[0], w[1]};
        if (lane == 0) scale2[2 * e + which] = sc;
    }
}
DI void cvt_rows_i4(Frame& F, const float* src, unsigned char* dst4, float* scale2, int which, int e0, int e1) {
    int lane_ = lane_id(); asm volatile("" : "+v"(lane_));
    const int lane = lane_;
    for (int e = e0 + F.wave; e < e1; e += NWAVES) {
        const float* r = src + (size_t)e * DMODEL + 16 * lane;
        const f32x4 a = *(const f32x4*)r, b = *(const f32x4*)(r + 4), c = *(const f32x4*)(r + 8), d = *(const f32x4*)(r + 12);
        float ss = a.x * a.x + a.y * a.y + a.z * a.z + a.w * a.w + b.x * b.x + b.y * b.y + b.z * b.z + b.w * b.w + c.x * c.x + c.y * c.y + c.z * c.z + c.w * c.w + d.x * d.x + d.y * d.y + d.z * d.z + d.w * d.w;
#pragma unroll
        for (int o = 1; o < 64; o <<= 1) ss += __shfl_xor(ss, o);
        const float sc = ss > 0.f ? 0.355f * __builtin_sqrtf(ss * (1.0f / 1024.0f)) : 1.0f, inv = 1.0f / sc;
#define Q4(v) ((unsigned)((int)fminf(fmaxf(__builtin_rintf((v) * inv), -7.0f), 7.0f)) & 0xfu)
        const v2u w = {Q4(a.x) | (Q4(a.y) << 4) | (Q4(a.z) << 8) | (Q4(a.w) << 12) | (Q4(b.x) << 16) | (Q4(b.y) << 20) | (Q4(b.z) << 24) | (Q4(b.w) << 28),
                       Q4(c.x) | (Q4(c.y) << 4) | (Q4(c.z) << 8) | (Q4(c.w) << 12) | (Q4(d.x) << 16) | (Q4(d.y) << 20) | (Q4(d.z) << 24) | (Q4(d.w) << 28)};
#undef Q4
        *(v2u*)(dst4 + (size_t)e * 512 + 8 * lane) = w;
        if (lane == 0) scale2[2 * e + which] = sc;
    }
}
struct XcdPart { int v, nx, li, nloc; };
DI float gelu_tanh(float a) { const float u = 0.7978845608028654f * (a + 0.044715f * a * a * a); const float e = __builtin_amdgcn_exp2f(2.0f * 1.4426950408889634f * u); const float th = 1.0f - 2.0f * __builtin_amdgcn_rcpf(e + 1.0f); return 0.5f * a * (1.0f + th); }
typedef float f32x2_ __attribute__((ext_vector_type(2)));
DI void dq16(const v4u& w, float (&o)[16]) {
    const unsigned a[4] = {w.x, w.y, w.z, w.w};
#pragma unroll
    for (int j = 0; j < 4; ++j) { const f32x2_ lo = __builtin_amdgcn_cvt_pk_f32_fp8((int)a[j], false), hi = __builtin_amdgcn_cvt_pk_f32_fp8((int)a[j], true); o[4 * j] = lo.x; o[4 * j + 1] = lo.y; o[4 * j + 2] = hi.x; o[4 * j + 3] = hi.y; }
}
DI void p5_quant_h(Frame& F) {
    int lane_ = lane_id(); asm volatile("" : "+v"(lane_));
    const int gw = F.vcu * NWAVES + F.wave, NGW = F.G * NWAVES, lane = lane_;
    const bf16* X1B = (const bf16*)(F.ws + WS_X1B); const float* rowss = (const float*)(F.ws + WS_CTL) + CW_ROWSS;
    unsigned char* H8 = (unsigned char*)(F.ws + WS_H8); float* TSC = (float*)(F.ws + WS_TSC);
    float gn[16];
    { const float* nf = inp(I_NORM_FFN) + 16 * lane;
#pragma unroll
      for (int d = 0; d < 16; ++d) gn[d] = nf[d]; }
    for (int m = gw; m < T; m += NGW) {
        const v4u xa = *(const v4u*)(X1B + (size_t)m * DMODEL + 16 * lane), xb = *(const v4u*)(X1B + (size_t)m * DMODEL + 16 * lane + 8);
        const unsigned xw_[8] = {xa.x, xa.y, xa.z, xa.w, xb.x, xb.y, xb.z, xb.w};
        float hv[16]; float mx = 0.f;
#pragma unroll
        for (int d = 0; d < 8; ++d) { hv[2 * d] = bflo(xw_[d]) * gn[2 * d]; hv[2 * d + 1] = bfhi(xw_[d]) * gn[2 * d + 1]; mx = fmaxf(mx, fmaxf(fabsf(hv[2 * d]), fabsf(hv[2 * d + 1]))); }
#pragma unroll
        for (int o = 1; o < 64; o <<= 1) mx = fmaxf(mx, __shfl_xor(mx, o));
        const float qs = mx > 0.f ? 119.0f / mx : 0.f;
        unsigned pa[2] = {0u, 0u}, pb[2] = {0u, 0u};
#pragma unroll
        for (int d = 0; d < 16; ++d) { const int h = (int)__builtin_rintf(hv[d] * qs); const int a = (h + 8) >> 4, b = h - 16 * a;
            pa[d >> 3] |= ((unsigned)a & 0xfu) << (4 * (d & 7)); pb[d >> 3] |= ((unsigned)b & 0xfu) << (4 * (d & 7)); }
        *(v2u*)(H8 + (size_t)m * DMODEL + 8 * lane) = (v2u){pa[0], pa[1]};
        *(v2u*)(H8 + (size_t)m * DMODEL + 512 + 8 * lane) = (v2u){pb[0], pb[1]};
        if (lane == 0) TSC[m] = (mx > 0.f ? mx * (1.0f / 119.0f) : 0.f) * __builtin_amdgcn_rsqf(rowss[m] * (1.0f / 1024.0f) + EPS);
    }
}
#ifndef P6_SKIP
#define P6_SKIP 0
#endif
template <int CTRL> DI int dppi0(int x) { return __builtin_amdgcn_update_dpp(0, x, CTRL, 0xf, 0xf, false); }
typedef float f32x2v __attribute__((ext_vector_type(2)));
constexpr int P6A_HSTR = 1024 + 64;
constexpr int P6A_WBYTES = 4096 + 2048 + 4 * P6A_HSTR;
static_assert(8 * P6A_WBYTES <= SCR_BYTES, "p6a lds");
DI void p6a_dots(Frame& F, const XcdPart P) {
    int lane_ = lane_id(); asm volatile("" : "+v"(lane_));
    const int lane = lane_, q = lane >> 4, i = lane & 15, q8 = lane >> 3; const unsigned i16 = 16u * (unsigned)(lane & 7);
    const unsigned char* UB8 = (const unsigned char*)(F.ws + WS_UB8); const f32x2_* US2 = (const f32x2_*)(F.ws + WS_US);
    const unsigned short* IDX = (const unsigned short*)(F.ws + WS_IDX); const float* GWp = (const float*)(F.ws + WS_GW); bf16* Wp = (bf16*)(F.ws + WS_W);
    const unsigned char* H8 = (const unsigned char*)(F.ws + WS_H8); const float* TSC = (const float*)(F.ws + WS_TSC);
    LAS unsigned char* wb = F.lds + F.wave * P6A_WBYTES;
    LAS v2u* list = (LAS v2u*)wb;
    LAS float* res = (LAS float*)(wb + 4096);
    LAS unsigned char* hb = wb + 4096 + 2048;
    const int wrank = P.li * NWAVES + F.wave, wstride = P.nloc * NWAVES;
    for (int s_ = P.v; s_ < 8; s_ += P.nx) {
        const int s = s_ & 3, tlo = (s_ >> 2) * (T / 2), thi = tlo + T / 2;
        v4u ean;
        if (tlo + wrank * 4 < thi) ean = *(const v4u*)(IDX + (size_t)(tlo + wrank * 4 + q) * 128 + 8 * i);
        for (int m0 = tlo + wrank * 4; m0 < thi; m0 += wstride * 4) {
            const int tok = m0 + q;
            const v4u ea = ean;
            if (m0 + wstride * 4 < thi) ean = *(const v4u*)(IDX + (size_t)(tok + wstride * 4) * 128 + 8 * i);
            v4u hv[4];
#pragma unroll
            for (int j = 0; j < 4; ++j) hv[j] = *(const v4u*)(H8 + (size_t)tok * DMODEL + 256 * j + 16 * i);
            const unsigned ev[8] = {ea.x & 0xffffu, ea.x >> 16, ea.y & 0xffffu, ea.y >> 16, ea.z & 0xffffu, ea.z >> 16, ea.w & 0xffffu, ea.w >> 16};
            int cnt = 0;
#pragma unroll
            for (int j = 0; j < 8; ++j) cnt += ((int)(ev[j] >> 12) == s) ? 1 : 0;
            int pre = cnt;
            pre += dppi0<0x111>(pre); pre += dppi0<0x112>(pre); pre += dppi0<0x114>(pre); pre += dppi0<0x118>(pre);
            const int n0 = __builtin_amdgcn_readlane(pre, 15), n1 = __builtin_amdgcn_readlane(pre, 31), n2 = __builtin_amdgcn_readlane(pre, 47), n3 = __builtin_amdgcn_readlane(pre, 63);
            const int p0 = (n0 + 1) & ~1, p1 = (n1 + 1) & ~1, p2 = (n2 + 1) & ~1, p3 = (n3 + 1) & ~1;
            const int ntot = p0 + p1 + p2 + p3;
            const int offq = (q > 0 ? p0 : 0) + (q > 1 ? p1 : 0) + (q > 2 ? p2 : 0), nq = q == 0 ? n0 : q == 1 ? n1 : q == 2 ? n2 : n3;
            int pos = pre - cnt + offq; unsigned fe = 0u;
#pragma unroll
            for (int j = 0; j < 8; ++j) if ((int)(ev[j] >> 12) == s) { list[pos] = (v2u){ev[j], (unsigned)(8 * i + j) | ((unsigned)q << 8)}; fe = ev[j]; ++pos; }
            if ((nq & 1) && cnt > 0) list[offq + nq] = (v2u){fe, 0x80000000u | ((unsigned)q << 8)};
#pragma unroll
            for (int j = 0; j < 4; ++j) *(LAS v4u*)(hb + q * P6A_HSTR + 256 * j + 16 * i) = hv[j];
            f32x2_ fsc = {0.f, 0.f}, fsc1 = {0.f, 0.f}; float fg = 0.f, ftsc = 0.f, fg1 = 0.f, ftsc1 = 0.f; size_t fo = 0, fo1 = 0; bool fv = false, fv1 = false;
            if (lane < ntot) { const v2u ek = list[lane]; fv = !(ek.y >> 31); const int tq = (int)(ek.y >> 8) & 3; fo = (size_t)(m0 + tq) * 128 + (ek.y & 255u); if (fv) { fsc = US2[ek.x]; fg = GWp[fo]; ftsc = TSC[m0 + tq]; } }
            if (lane + 64 < ntot) { const v2u ek = list[lane + 64]; fv1 = !(ek.y >> 31); const int tq = (int)(ek.y >> 8) & 3; fo1 = (size_t)(m0 + tq) * 128 + (ek.y & 255u); if (fv1) { fsc1 = US2[ek.x]; fg1 = GWp[fo1]; ftsc1 = TSC[m0 + tq]; } }
#define P6A_LOAD(U, TQ, base_) do { _Pragma("unroll") for (int st = 0; st < 2; ++st) if ((base_) + 16 * st < ntot) { const int slot = (base_) + 16 * st + 2 * q8; const int sl = slot < ntot ? slot : ntot - 2; \
                    const v4u ek2 = *(const LAS v4u*)(list + sl); TQ[st] = (int)(ek2.y >> 8) & 3; \
                    const unsigned ro0 = (ek2.x << 9) | i16, ro1 = (ek2.z << 9) | i16; \
                    _Pragma("unroll") for (int j = 0; j < 4; ++j) { U[st][0][j] = *(const v4u*)(UB8 + (ro0 + 128u * j)); U[st][1][j] = *(const v4u*)(UB8 + (ro1 + 128u * j)); } } } while (0)
#define P6A_DOT4(acc_, uu, hh) do { acc_ = __builtin_amdgcn_sdot8((int)(uu).x, (int)(hh).x, acc_, false); acc_ = __builtin_amdgcn_sdot8((int)(uu).y, (int)(hh).y, acc_, false); \
                    acc_ = __builtin_amdgcn_sdot8((int)(uu).z, (int)(hh).z, acc_, false); acc_ = __builtin_amdgcn_sdot8((int)(uu).w, (int)(hh).w, acc_, false); } while (0)
#define P6A_COMP(U, TQ, base_) do { _Pragma("unroll") for (int st = 0; st < 2; ++st) if ((base_) + 16 * st < ntot) { const LAS unsigned char* hp_ = hb + TQ[st] * P6A_HSTR + i16; \
                    v4u ha[4], hb4[4]; _Pragma("unroll") for (int j = 0; j < 4; ++j) { ha[j] = *(const LAS v4u*)(hp_ + 128 * j); hb4[j] = *(const LAS v4u*)(hp_ + 512 + 128 * j); } \
                    __builtin_amdgcn_sched_barrier(0);        \
                    int isa0 = 0, isb0 = 0, isa1 = 0, isb1 = 0; \
                    _Pragma("unroll") for (int j = 0; j < 4; ++j) { P6A_DOT4(isa0, U[st][0][j], ha[j]); P6A_DOT4(isb0, U[st][0][j], hb4[j]); P6A_DOT4(isa1, U[st][1][j], ha[j]); P6A_DOT4(isb1, U[st][1][j], hb4[j]); } \
                    int is0 = 16 * isa0 + isb0, is1 = 16 * isa1 + isb1; \
                    is0 += dppi0<0x111>(is0); is1 += dppi0<0x111>(is1); is0 += dppi0<0x112>(is0); is1 += dppi0<0x112>(is1); is0 += dppi0<0x114>(is0); is1 += dppi0<0x114>(is1); \
                    if ((lane & 7) == 7 && (base_) + 16 * st + 2 * q8 < ntot) *(LAS f32x2_*)(res + (base_) + 16 * st + 2 * q8) = (f32x2_){(float)is0, (float)is1}; } } while (0)
            v4u UA[2][2][4], UB[2][2][4]; int TA[2], TB[2];
            if (ntot > 0) P6A_LOAD(UA, TA, 0);
            if (ntot > 32) P6A_LOAD(UB, TB, 32);
            for (int base = 0; base < ntot; base += 64) {
                if (base > 0 && base + 32 < ntot) P6A_LOAD(UB, TB, base + 32);
                P6A_COMP(UA, TA, base);
                if (base + 64 < ntot) P6A_LOAD(UA, TA, base + 64);
                if (base + 32 < ntot) P6A_COMP(UB, TB, base + 32);
            }
#undef P6A_LOAD
#undef P6A_COMP
#undef P6A_DOT4
            if (fv) Wp[fo] = (bf16)f2bf(gelu_tanh(res[lane] * ftsc * fsc.x) * fg * fsc.y);
            if (fv1) Wp[fo1] = (bf16)f2bf(gelu_tanh(res[lane + 64] * ftsc1 * fsc1.x) * fg1 * fsc1.y);
            for (int idx = 128 + lane; idx < ntot; idx += 64) { const v2u ek = list[idx]; if (ek.y >> 31) continue; const f32x2_ sc = US2[ek.x]; const int tq = (int)(ek.y >> 8) & 3; const size_t o = (size_t)(m0 + tq) * 128 + (ek.y & 255u);
                Wp[o] = (bf16)f2bf(gelu_tanh(res[idx] * TSC[m0 + tq] * sc.x) * GWp[o] * sc.y); }
        }
    }
}
constexpr int P6B_RSTR = 160;
static_assert(8 * 64 * P6B_RSTR <= SCR_BYTES, "p6b lds");
DI void p6b_axpy(Frame& F, const XcdPart P) {
    int lane_ = lane_id(); asm volatile("" : "+v"(lane_));
    const int lane = lane_, c = lane & 7, g = lane >> 3;
    const unsigned short* IDX = (const unsigned short*)(F.ws + WS_IDX); const bf16* Wp = (const bf16*)(F.ws + WS_W);
    float* rowss2 = (float*)(F.ws + WS_CTL) + CW_ROWSS2;
    bf16* X2B = (bf16*)(F.ws + WS_XN) + 256;
    const bf16* X1B = (const bf16*)(F.ws + WS_X1B);
    const int wrank = P.li * NWAVES + F.wave, wstride = P.nloc * NWAVES;
    const int j4 = 4 * g;
    LAS unsigned char* redw = F.lds + F.wave * (64 * P6B_RSTR) + lane * P6B_RSTR;
    const LAS unsigned char* redr = F.lds + F.wave * (64 * P6B_RSTR) + c * P6B_RSTR + 16 * g;
    for (int s = P.v; s < 8; s += P.nx) {
        const unsigned char* Vb = (const unsigned char*)(F.ws + WS_VB8) + (size_t)(s & 3) * NEXP * 128;
        const unsigned c16 = (unsigned)c * 16u;
        const int ch = (s & 3) * 256 + 32 * c + j4;
        const int tlo = (s >> 2) * (T / 2), thi = tlo + T / 2;
#define P6B_GATHER(R, E) do { const unsigned e_[8] = {E[0].x, E[0].y, E[0].z, E[0].w, E[1].x, E[1].y, E[1].z, E[1].w}; _Pragma("unroll") for (int j = 0; j < 8; ++j) { \
            R[2 * j] = *(const v4u*)(Vb + (((e_[j] & 0xffffu) << 7) | c16)); R[2 * j + 1] = *(const v4u*)(Vb + (((e_[j] >> 16) << 7) | c16)); } } while (0)
#define P6B_TOKEN(R, W, m) do { const unsigned w_[8] = {W[0].x, W[0].y, W[0].z, W[0].w, W[1].x, W[1].y, W[1].z, W[1].w}; \
            f32x2v acc[16]; _Pragma("unroll") for (int k = 0; k < 16; ++k) acc[k] = (f32x2v){0.f, 0.f}; \
            _Pragma("unroll") for (int j = 0; j < 16; ++j) { const float wj = (j & 1) ? bfhi(w_[j >> 1]) : bflo(w_[j >> 1]); const f32x2v w2 = {wj, wj}; const unsigned ua[4] = {R[j].x, R[j].y, R[j].z, R[j].w}; \
                _Pragma("unroll") for (int k = 0; k < 4; ++k) { \
                    acc[4 * k] = __builtin_elementwise_fma(w2, __builtin_amdgcn_cvt_scalef32_pk_f32_fp4(ua[k], 1.0f, 0), acc[4 * k]); acc[4 * k + 1] = __builtin_elementwise_fma(w2, __builtin_amdgcn_cvt_scalef32_pk_f32_fp4(ua[k], 1.0f, 1), acc[4 * k + 1]); \
                    acc[4 * k + 2] = __builtin_elementwise_fma(w2, __builtin_amdgcn_cvt_scalef32_pk_f32_fp4(ua[k], 1.0f, 2), acc[4 * k + 2]); acc[4 * k + 3] = __builtin_elementwise_fma(w2, __builtin_amdgcn_cvt_scalef32_pk_f32_fp4(ua[k], 1.0f, 3), acc[4 * k + 3]); } } \
            _Pragma("unroll") for (int k = 0; k < 16; ++k) *(LAS f32x2v*)(redw + 8 * k) = acc[k]; \
            f32x4 q4v = *(const LAS f32x4*)(redr); _Pragma("unroll") for (int gg = 1; gg < 8; ++gg) { const f32x4 t_ = *(const LAS f32x4*)(redr + gg * 8 * P6B_RSTR); q4v.x += t_.x; q4v.y += t_.y; q4v.z += t_.z; q4v.w += t_.w; } \
            const float q4[4] = {q4v.x, q4v.y, q4v.z, q4v.w}; \
            const v2u x1w = *(const v2u*)(X1B + (size_t)(m) * DMODEL + ch); \
            const float x20 = bflo(x1w.x) + q4[0], x21 = bfhi(x1w.x) + q4[1], x22 = bflo(x1w.y) + q4[2], x23 = bfhi(x1w.y) + q4[3]; \
            *(v2u*)(X2B + (size_t)(m) * 1280 + ch) = (v2u){pk2(x20, x21), pk2(x22, x23)}; \
            const float tot = wave_incl_scan(x20 * x20 + x21 * x21 + x22 * x22 + x23 * x23); \
            if (lane == 63) atomicAdd(rowss2 + (m), tot); } while (0)
#define P6B_LDE(E, tokn) do { E[0] = *(const v4u*)(IDX + (size_t)(tokn) * 128 + 16 * g); E[1] = *(const v4u*)(IDX + (size_t)(tokn) * 128 + 16 * g + 8); } while (0)
#define P6B_LDW(W, tokn) do { W[0] = *(const v4u*)(Wp + (size_t)(tokn) * 128 + 16 * g); W[1] = *(const v4u*)(Wp + (size_t)(tokn) * 128 + 16 * g + 8); } while (0)
        v4u EA[2], EB[2], RA[16], RB[16], WCA[2], WCB[2];
        const int m_0 = tlo + wrank;
        if (m_0 < thi) { P6B_LDE(EA, m_0); P6B_LDW(WCA, m_0); P6B_GATHER(RA, EA); }
        if (m_0 + wstride < thi) { P6B_LDE(EB, m_0 + wstride); P6B_LDW(WCB, m_0 + wstride); P6B_GATHER(RB, EB); }
        if (m_0 + 2 * wstride < thi) P6B_LDE(EA, m_0 + 2 * wstride);
        if (m_0 + 3 * wstride < thi) P6B_LDE(EB, m_0 + 3 * wstride);
        for (int m = m_0; m < thi; m += 2 * wstride) {
            const int mb = m + wstride;
            P6B_TOKEN(RA, WCA, m);
            if (m + 2 * wstride < thi) { P6B_GATHER(RA, EA); P6B_LDW(WCA, m + 2 * wstride); if (m + 4 * wstride < thi) P6B_LDE(EA, m + 4 * wstride); }
            if (mb < thi) { P6B_TOKEN(RB, WCB, mb);
                if (mb + 2 * wstride < thi) { P6B_GATHER(RB, EB); P6B_LDW(WCB, mb + 2 * wstride); if (mb + 4 * wstride < thi) P6B_LDE(EB, mb + 4 * wstride); } }
        }
#undef P6B_LDE
#undef P6B_LDW
#undef P6B_GATHER
#undef P6B_TOKEN
    }
}
#ifndef PH_MASK
#define PH_MASK 0xffff
#endif
#define PH(k) (PH_MASK & (1 << (k)))
#ifndef DBG_SKIP
#define DBG_SKIP 0
#endif
struct Args { const float* in[19]; float* out; unsigned char* ws; };
__global__ void __launch_bounds__(NWAVES * 64, 2) fwd_megakernel(Args args) {
    extern __shared__ __attribute__((aligned(16))) unsigned char lds[];
    Frame F;
    F.lds = (LAS unsigned char*)lds;
    F.MISC = (volatile LAS unsigned*)(F.lds + MISC_OFF);
    F.wave = __builtin_amdgcn_readfirstlane((int)threadIdx.x >> 6);
    F.G = gridDim.x; { const int bx = blockIdx.x; F.vcu = (F.G % 8 == 0) ? (bx % 8) * (F.G / 8) + bx / 8 : bx; }
    F.ws = args.ws; F.ctl = (gu32*)(args.ws + WS_CTL); F.out = args.out;
    for (int u = threadIdx.x; u < (LDS_BYTES - LDSCTL_OFF) / 4; u += NWAVES * 64) ((LAS unsigned*)(F.lds + LDSCTL_OFF))[u] = 0u;
    __syncthreads();
    XcdBarrier bar = xcd_barrier_post((unsigned*)(F.ctl + CW_BAR), F.MISC + 8, threadIdx.x == 0);
#ifdef TIMING_A
#ifndef TIMING_QUANT
#define TIMING_QUANT 50.0f
#endif
    unsigned long long ts_[16]; int nts_ = 0;
#define STAMP() do { if (nts_ < 16) ts_[nts_++] = __builtin_amdgcn_s_memrealtime(); } while (0)
#else
#define STAMP() do {} while (0)
#endif
    STAMP();
#define T0() (F.wave == 0 && lane_id() == 0)
#define GRID_BAR() do { xcd_barrier(bar, T0()); STAMP(); } while (0)
    unsigned char* ws = args.ws;
    bf16* XN = (bf16*)(ws + WS_XN); bf16* QKV = (bf16*)(ws + WS_QKV); bf16* HGB = (bf16*)(ws + WS_HG); bf16* GATE = (bf16*)(ws + WS_GATE);
    float* rowss = (float*)(ws + WS_CTL) + CW_ROWSS;

    if (PH(0)) p0_prologue(F);
    GRID_BAR();
    if (!(DBG_SKIP & 1)) {
    if (PH(1)) {   pg8::Gemm g{XN, (const bf16*)(ws + WS_WIN), T, INW, 1024, 1024, 1024}; pg8::StaticOrder S; S.init(T, INW, F.G, (int)blockIdx.x);
        pg8::EpiRoute E{QKV, HGB, GATE, I_HG_LB, I_Q_NORM, I_K_NORM, (const float*)(ws + WS_ROPE), (LAS float*)(F.lds + 131072)};
        pg8::gemm_phase<pg8::EpiRoute, pg8::StaticOrder, true, true>(F.lds, g, S, E, F.wave); }
    GRID_BAR();
    {
        volatile LAS unsigned* qslot = F.MISC + 16;
        for (;;) {
            __syncthreads();
            if ((F.wave * 64 + lane_id()) == 0) *qslot = __hip_atomic_fetch_add((unsigned*)(F.ctl + CW_QUEUE), 1u, __ATOMIC_RELAXED, __HIP_MEMORY_SCOPE_AGENT);
            __syncthreads();
            const int n = (int)__builtin_amdgcn_readfirstlane(*qslot);
            if (n >= 64 + 1024 + 256) break;
            if (n >= 64 + 1024) {
                const int c = n - (64 + 1024);
                cvt_rows_i4(F, inp(I_PEER_U), ws + WS_UB8, (float*)(ws + WS_US), 0, 64 * c, 64 * c + 64);
                cvt_rows_fp4(F, inp(I_PEER_V), ws + WS_VB8, (float*)(ws + WS_US), 1, 64 * c, 64 * c + 64);
                continue; }
#ifdef TIMING_Q
            const unsigned long long tq0_ = __builtin_amdgcn_s_memrealtime();
#endif
            if (n < 64) { if (PH(3)) hgrn_item(F, n); }
            else if (PH(4)) { attn_body::AttnUnit u; attn_body::unit_decode(n - 64, u);
                attn_body::attn_unit<8>(F.wave, u.bh / attn_body::NHEAD, u.bh % attn_body::NHEAD, u.qb, (const attn_body::bf16*)QKV, (const attn_body::bf16*)(QKV + 512), (const attn_body::bf16*)(QKV + 640), (attn_body::bf16*)F.out, (char*)lds); }
#ifdef TIMING_Q
            if (n == TIMING_Q && T0()) F.ctl[CW_QUEUE + 64] = (unsigned)(__builtin_amdgcn_s_memrealtime() - tq0_);
#endif
        }
    }
    GRID_BAR();
    if (PH(5)) p2b_ohn(F, (bf16*)F.out);
    GRID_BAR();
    if (PH(6)) {   pg8::Gemm g{(const bf16*)F.out, (const bf16*)(ws + WS_WUA), T, 1024, 1024, 1024, 1024}; pg8::StaticOrder S; S.init(T, 1024, F.G, (int)blockIdx.x);
        pg8::EpiMergeFused E{(bf16*)(ws + WS_HG), (const unsigned char*)GATE};
        pg8::gemm_phase<pg8::EpiMergeFused, pg8::StaticOrder, true, true>(F.lds, g, S, E, F.wave); }
    GRID_BAR();
    }
    if (PH(8) && !(DBG_SKIP & 1)) {
        pg8::Gemm g{(const bf16*)(ws + WS_HG), (const bf16*)(ws + WS_WOUT), T, 1024, 1024, 1024, 1024}; pg8::StaticOrder S; S.init(T, 1024, F.G, (int)blockIdx.x);
        pg8::EpiResid E{XN, (const float*)(ws + WS_GINV), (bf16*)(ws + WS_X1B), rowss};
        pg8::gemm_phase<pg8::EpiResid, pg8::StaticOrder, true, true>(F.lds, g, S, E, F.wave);
    }
    GRID_BAR();
    if (PH(9) && !(DBG_SKIP & 2)) {
        pg8::Gemm g{(const bf16*)(ws + WS_X1B), (const bf16*)(ws + WS_WPEER), T, 2048, 1024, 1024, 1024}; pg8::StaticOrder S; S.init(T, 2048, F.G, (int)blockIdx.x);
        pg8::EpiTopk E{rowss, (unsigned short*)(ws + WS_IDX), (float*)(ws + WS_GW), EPS};
        pg8::OneUnit one;
        for (int i = 0; S.next(i, one.u); ++i) pg8::gemm_phase<pg8::EpiTopk, pg8::OneUnit, false, true>(F.lds, g, one, E, F.wave);
    }
    if (PH(9)) p5_quant_h(F);
    GRID_BAR();
    {   XcdPart P; xcd_census((unsigned*)(F.ctl + CW_BAR), bar.x, P.v, P.nx, P.nloc); P.li = (int)__builtin_amdgcn_readfirstlane(F.MISC[10]);
        if (PH(10)) { const int rpb = (T + F.G - 1) / F.G; const int r0 = (int)blockIdx.x * rpb; cvt_p_rows(F, inp(I_P), (bf16*)(ws + WS_XN), r0, min(r0 + rpb, T)); }
        if (PH(10)) p6a_dots(F, P);
        GRID_BAR();
        if (PH(10)) p6b_axpy(F, P);
    }
    GRID_BAR();
    if (PH(12)) {   pg8::Gemm g{XN, (const bf16*)(ws + WS_WPG), T, 1024, 1280, 1280, 1280}; pg8::StaticOrder S; S.init(T, 1024, F.G, (int)blockIdx.x);
        pg8::EpiPleFused E{F.out, (bf16*)(ws + WS_PP), rowss + 32768, EPS, XN};
        pg8::gemm_phase<pg8::EpiPleFused, pg8::StaticOrder, true, true>(F.lds, g, S, E, F.wave); }
#ifdef TIMING_A
    GRID_BAR();
    if (blockIdx.x == 0 && (F.wave * 64 + lane_id()) == 0) {
#ifdef TIMING_Q
        const float dq_ = 4.0f * __builtin_rintf((float)__hip_atomic_load((unsigned*)(F.ctl + CW_QUEUE + 64), __ATOMIC_RELAXED, __HIP_MEMORY_SCOPE_AGENT) * (0.01f / 20.0f));
        F.out[2] += dq_;
#endif
#if TIMING_A >= 100
        const float da = (TIMING_QUANT / 20.0f) * __builtin_rintf((float)(ts_[nts_ - 1] - ts_[0]) * (0.01f / TIMING_QUANT));
#else
        const float da = (TIMING_QUANT / 5.0f) * __builtin_rintf((float)(ts_[TIMING_A + 1] - ts_[TIMING_A]) * (0.01f / TIMING_QUANT));
#endif
        F.out[0] += da;
#ifdef TIMING_B
        const float db = (float)(ts_[TIMING_B + 1] - ts_[TIMING_B]) * (0.01f / 5.0f);
        F.out[1] += db;
#endif
    }
#endif
}

extern "C" void kernel_launch(void* const* d_in, const int* in_sizes, int n_in, void* d_out, int out_size, void* d_ws, size_t ws_size, hipStream_t stream) {
    static int grid = 0;
    if (grid == 0) {
        if (n_in != 19 || out_size != T * DMODEL || ws_size < WS_END) { fprintf(stderr, "kernel_launch: unexpected shapes (n_in %d out %d ws %zu)\n", n_in, out_size, ws_size); grid = -1; return; }
        int dev = 0, cus = 0, per_cu = 0;
        if (hipGetDevice(&dev) != hipSuccess || hipDeviceGetAttribute(&cus, hipDeviceAttributeMultiprocessorCount, dev) != hipSuccess) { grid = -1; return; }
        if (hipFuncSetAttribute((const void*)fwd_megakernel, hipFuncAttributeMaxDynamicSharedMemorySize, LDS_BYTES) != hipSuccess) { fprintf(stderr, "kernel_launch: hipFuncSetAttribute failed\n"); grid = -1; return; }
        if (hipOccupancyMaxActiveBlocksPerMultiprocessor(&per_cu, (const void*)fwd_megakernel, NWAVES * 64, LDS_BYTES) != hipSuccess || per_cu < 1) fprintf(stderr, "kernel_launch: occupancy query says %d\n", per_cu);
        (void)hipGetLastError();
        grid = cus;
    }
    if (grid < 0) return;
    (void)hipMemsetAsync((char*)d_ws + WS_CTL, 0, CTL_ZERO_BYTES, stream);
    Args a{};
    for (int i = 0; i < 19; ++i) a.in[i] = (const float*)d_in[i];
    a.out = (float*)d_out; a.ws = (unsigned char*)d_ws;
    hipLaunchKernelGGL(fwd_megakernel, dim3(grid), dim3(NWAVES * 64), LDS_BYTES, stream, a);
}
```

```cpp
#include <hip/hip_runtime.h>
#include <cstdio>
#include <cstdint>
namespace pg8 {
#define PG8_LAS __attribute__((address_space(3)))
typedef unsigned short bf16_t;
typedef short bf16x8 __attribute__((ext_vector_type(8)));
typedef float f32x4 __attribute__((ext_vector_type(4)));
typedef unsigned u32x4 __attribute__((ext_vector_type(4)));
typedef unsigned u32x2 __attribute__((ext_vector_type(2)));
constexpr int BM = 256, BK = 64, HALF = 128, HTB = HALF * BK * 2  , STAGE_BYTES = 8 * HTB, NXCD = 8, WGM = 8;

__host__ __device__ __forceinline__ int lds_byte(int r, int c) { const int st = (r >> 4) * 2 + (c >> 5), rr = r & 15, cc = c & 31, ob = rr * 64 + cc * 2; return st * 1024 + (ob ^ (((ob >> 9) & 1) << 5)); }
__host__ __device__ __forceinline__ void stage_rc(int b, int& R, int& C) { const int st = b / 1024, sb = b % 1024, swz = sb ^ (((sb >> 9) & 1) << 5); R = (st >> 1) * 16 + swz / 64; C = (st & 1) * 32 + (swz % 64) / 2; }
__host__ __device__ __forceinline__ int perm32(int rho) { const int n = rho >> 4, i = rho & 15; return 8 * (i >> 2) + 4 * n + (i & 3); }

struct Unit { int pm, pn; };
struct Gemm { const bf16_t* A; const bf16_t* Bt; int M, N, K, lda, ldb; };

struct StaticOrder {
    int nM, nN, nwg, G, c;
    __host__ __device__ void init(int M, int N, int G_, int c_) { nM = M / BM; nN = N / BM; nwg = nM * nN; G = G_; c = c_; }
    __host__ __device__ bool next(int i, Unit& u) const {
        const long L = (long)i * G + c; if (L >= nwg) return false;
        int wgid = (int)L; { const int q = nwg / NXCD, r = nwg % NXCD, xcd = wgid % NXCD, off = wgid / NXCD; wgid = (xcd < r ? xcd * (q + 1) : r * (q + 1) + (xcd - r) * q) + off; }
        const int nig = WGM * nN, gid = wgid / nig, fm = gid * WGM, gsz = (nM - fm) < WGM ? (nM - fm) : WGM;
        u.pm = fm + ((wgid % nig) % gsz); u.pn = (wgid % nig) / gsz; return true;
    }
    __device__ __forceinline__ void a_ready(const Unit&) const {}
    __device__ __forceinline__ void done(const Unit&) const {}
};
struct OneUnit {
    Unit u;
    __device__ __forceinline__ bool next(int i, Unit& o) const { if (i != 0) return false; o = u; return true; }
    __device__ __forceinline__ void a_ready(const Unit&) const {}
    __device__ __forceinline__ void done(const Unit&) const {}
};

__device__ __forceinline__ unsigned cvt_pk_bf16(float lo, float hi) { unsigned r; asm volatile("v_cvt_pk_bf16_f32 %0, %1, %2" : "=v"(r) : "v"(lo), "v"(hi)); return r; }
__device__ __forceinline__ float bf_lo(unsigned w) { return __uint_as_float(w << 16); }
__device__ __forceinline__ float bf_hi(unsigned w) { return __uint_as_float(w & 0xffff0000u); }
__device__ __forceinline__ float sigmoidf_(float x) { return __builtin_amdgcn_rcpf(1.0f + __builtin_amdgcn_exp2f(-1.4426950408889634f * x)); }


template <class Epi, class Sched, bool ALIGN_EPI = false, bool SP2 = false>
__device__ __forceinline__ void gemm_phase(PG8_LAS unsigned char* lds, const Gemm g, const Sched& S, const Epi& E, const int wave_id) {
    int tid_; asm volatile("v_mbcnt_lo_u32_b32 %0, -1, 0\n\tv_mbcnt_hi_u32_b32 %0, -1, %0" : "=v"(tid_)); tid_ += wave_id * 64;
    const int tid = tid_, wid = __builtin_amdgcn_readfirstlane(tid >> 6), lane = tid & 63, wr = wid >> 2, wc = wid & 3, fr = lane & 15, fq = lane >> 4;
    int K_ = g.K; asm volatile("" : "+s"(K_));
    const int K = K_, nt = K / BK;
    unsigned voffA[2], voffB[2];
#pragma unroll
    for (int i = 0; i < 2; ++i) { int R, C; stage_rc(tid * 16 + i * 8192, R, C); const int Rb = Epi::PERM ? ((R & ~31) + perm32(R & 31)) : R;
        voffA[i] = (unsigned)(R * g.lda + C) * 2u; voffB[i] = (unsigned)(Rb * g.ldb + C) * 2u; }
    const size_t kstep = (size_t)(BK * 2);
    const size_t hstepA = (size_t)HALF * g.lda * 2, hstepB = (size_t)HALF * g.ldb * 2;
    const size_t tstepA = 2 * hstepA, tstepB = 2 * hstepB;
    const unsigned ldsw = (unsigned)wid * 1024u;
    const int aoff = lds_byte(wr * 64 + fr, fq * 8), boff = lds_byte(wc * 32 + fr, fq * 8);
#define PG8_SA(b, h) (((b) * 2 + (h)) * HTB)
#define PG8_SB(b, h) ((4 + (b) * 2 + (h)) * HTB)
#define PG8_STAGE(bufoff, gbase, voff) do { _Pragma("unroll") for (int _i = 0; _i < 2; ++_i) \
        __builtin_amdgcn_global_load_lds((const unsigned*)((const char*)(gbase) + (voff)[_i]), (PG8_LAS unsigned*)(lds + (bufoff) + ldsw + _i * 8192), 16, 0, 0); } while (0)
#define PG8_LDA(dst, b, h) do { _Pragma("unroll") for (int m = 0; m < 4; ++m) _Pragma("unroll") for (int k = 0; k < 2; ++k) dst[m][k] = *(const PG8_LAS bf16x8*)(lds + PG8_SA(b, h) + aoff + m * 2048 + k * 1024); } while (0)
#define PG8_LDB(dst, b, h) do { _Pragma("unroll") for (int n = 0; n < 2; ++n) _Pragma("unroll") for (int k = 0; k < 2; ++k) dst[n][k] = *(const PG8_LAS bf16x8*)(lds + PG8_SB(b, h) + boff + n * 2048 + k * 1024); } while (0)
#define PG8_MMA(ai, bj, At, Bt) do { __builtin_amdgcn_s_setprio(1); _Pragma("unroll") for (int m = 0; m < 4; ++m) _Pragma("unroll") for (int n = 0; n < 2; ++n) _Pragma("unroll") for (int k = 0; k < 2; ++k) \
        acc[ai][bj][m][n] = __builtin_amdgcn_mfma_f32_16x16x32_bf16(Bt[n][k], At[m][k], acc[ai][bj][m][n], 0, 0, 0); __builtin_amdgcn_s_setprio(0); } while (0)
#define PG8_WAIT_V(n) asm volatile("s_waitcnt vmcnt(" #n ")" ::: "memory")
#define PG8_WAIT_L(n) asm volatile("s_waitcnt lgkmcnt(" #n ")" ::: "memory")
#define PG8_BAR __builtin_amdgcn_s_barrier()
#define PG8_SCHED __builtin_amdgcn_sched_barrier(0)
    Unit cur, nxt; int ui = 0;
    if (!S.next(0, cur)) return;
    f32x4 acc[2][2][4][2];
#pragma unroll
    for (int a = 0; a < 2; ++a)
#pragma unroll
        for (int b = 0; b < 2; ++b)
#pragma unroll
            for (int m = 0; m < 4; ++m)
#pragma unroll
                for (int n = 0; n < 2; ++n) acc[a][b][m][n] = (f32x4){0.f, 0.f, 0.f, 0.f};
    bf16x8 At[4][2], B0[2][2], B1[2][2];
    const char* cA = (const char*)g.A + (size_t)cur.pm * tstepA; const char* cB = (const char*)g.Bt + (size_t)cur.pn * tstepB;
    S.a_ready(cur);
    if constexpr (SP2) {
        PG8_STAGE(PG8_SB(0, 0), cB, voffB); PG8_STAGE(PG8_SB(0, 1), cB + hstepB, voffB); PG8_STAGE(PG8_SA(0, 0), cA, voffA); PG8_STAGE(PG8_SA(0, 1), cA + hstepA, voffA);
        if (wr == 1) PG8_BAR;
        PG8_WAIT_V(2); PG8_BAR;
        PG8_STAGE(PG8_SB(1, 0), cB + kstep, voffB); PG8_STAGE(PG8_SA(1, 0), cA + kstep, voffA); PG8_STAGE(PG8_SB(1, 1), cB + hstepB + kstep, voffB);
        PG8_WAIT_V(6); PG8_BAR;
    } else {
        PG8_STAGE(PG8_SB(0, 0), cB, voffB); PG8_STAGE(PG8_SA(0, 0), cA, voffA); PG8_STAGE(PG8_SB(0, 1), cB + hstepB, voffB); PG8_STAGE(PG8_SA(0, 1), cA + hstepA, voffA);
        if (wr == 1) PG8_BAR;
        PG8_WAIT_V(4); PG8_BAR;
        PG8_STAGE(PG8_SB(1, 0), cB + kstep, voffB); PG8_STAGE(PG8_SA(1, 0), cA + kstep, voffA); PG8_STAGE(PG8_SB(1, 1), cB + hstepB + kstep, voffB);
        PG8_WAIT_V(6); PG8_BAR;
    }
    for (;;) {
        const bool has_next = S.next(ui + 1, nxt);
        const char* nA = has_next ? (const char*)g.A + (size_t)nxt.pm * tstepA : cA; const char* nB = has_next ? (const char*)g.Bt + (size_t)nxt.pn * tstepB : cB;
        for (int t = 0; t < nt; t += 2) {
            const bool last = (t == nt - 2);
            const char* a1 = cA + (size_t)(t + 1) * kstep;
            const char* a2 = last ? nA : cA + (size_t)(t + 2) * kstep; const char* b2 = last ? nB : cB + (size_t)(t + 2) * kstep;
            const char* a3 = a2 + kstep; const char* b3 = b2 + kstep;
            if (last && has_next) S.a_ready(nxt);
            if constexpr (SP2) {
            PG8_LDB(B0, 0, 0); PG8_LDB(B1, 0, 1); PG8_SCHED; PG8_LDA(At, 0, 0); PG8_STAGE(PG8_SA(1, 1), a1 + hstepA, voffA);
            PG8_WAIT_V(8); PG8_WAIT_L(0); PG8_BAR; PG8_MMA(0, 0, At, B0); PG8_MMA(0, 1, At, B1); PG8_BAR; PG8_SCHED;
            PG8_LDA(At, 0, 1); PG8_STAGE(PG8_SB(0, 0), b2, voffB); PG8_STAGE(PG8_SB(0, 1), b2 + hstepB, voffB); PG8_STAGE(PG8_SA(0, 0), a2, voffA);
            PG8_WAIT_V(8); PG8_WAIT_L(0); PG8_BAR; PG8_MMA(1, 0, At, B0); PG8_MMA(1, 1, At, B1); PG8_BAR; PG8_SCHED;
            PG8_LDB(B0, 1, 0); PG8_LDB(B1, 1, 1); PG8_SCHED; PG8_LDA(At, 1, 0); PG8_STAGE(PG8_SA(0, 1), a2 + hstepA, voffA);
            PG8_WAIT_V(8); PG8_WAIT_L(0); PG8_BAR; PG8_MMA(0, 0, At, B0); PG8_MMA(0, 1, At, B1); PG8_BAR; PG8_SCHED;
            PG8_LDA(At, 1, 1); PG8_STAGE(PG8_SB(1, 0), b3, voffB); PG8_STAGE(PG8_SB(1, 1), b3 + hstepB, voffB); PG8_STAGE(PG8_SA(1, 0), a3, voffA);
            PG8_WAIT_V(8); PG8_WAIT_L(0); PG8_BAR; PG8_MMA(1, 0, At, B0); PG8_MMA(1, 1, At, B1); PG8_BAR; PG8_SCHED;
            } else {
            PG8_LDB(B0, 0, 0); PG8_SCHED; PG8_LDA(At, 0, 0); PG8_STAGE(PG8_SA(1, 1), a1 + hstepA, voffA);
            PG8_WAIT_L(8); PG8_BAR; PG8_WAIT_L(0); PG8_MMA(0, 0, At, B0); PG8_BAR; PG8_SCHED;
            PG8_LDB(B1, 0, 1); PG8_STAGE(PG8_SB(0, 0), b2, voffB);
            PG8_BAR; PG8_WAIT_L(0); PG8_MMA(0, 1, At, B1); PG8_BAR;
            PG8_LDA(At, 0, 1); PG8_STAGE(PG8_SA(0, 0), a2, voffA);
            PG8_BAR; PG8_WAIT_L(0); PG8_MMA(1, 0, At, B0); PG8_BAR; PG8_SCHED;
            PG8_STAGE(PG8_SB(0, 1), b2 + hstepB, voffB);
            PG8_WAIT_V(6); PG8_BAR; PG8_MMA(1, 1, At, B1); PG8_BAR;
            PG8_LDB(B0, 1, 0); PG8_SCHED; PG8_LDA(At, 1, 0); PG8_STAGE(PG8_SA(0, 1), a2 + hstepA, voffA);
            PG8_WAIT_L(8); PG8_BAR; PG8_WAIT_L(0); PG8_MMA(0, 0, At, B0); PG8_BAR; PG8_SCHED;
            PG8_LDB(B1, 1, 1); PG8_STAGE(PG8_SB(1, 0), b3, voffB);
            PG8_BAR; PG8_WAIT_L(0); PG8_MMA(0, 1, At, B1); PG8_BAR;
            PG8_LDA(At, 1, 1); PG8_STAGE(PG8_SA(1, 0), a3, voffA);
            PG8_BAR; PG8_WAIT_L(0); PG8_MMA(1, 0, At, B0); PG8_BAR; PG8_SCHED;
            PG8_STAGE(PG8_SB(1, 1), b3 + hstepB, voffB);
            PG8_WAIT_V(6); PG8_BAR; PG8_MMA(1, 1, At, B1); PG8_BAR;
            }
            if constexpr (Epi::MIDHOOK) { if (t + 2 == Epi::MID_TILES) E.mid(acc, cur, wr, wc, fr, fq); }
        }
        if constexpr (ALIGN_EPI) { if (wr == 0) PG8_BAR; }
        if constexpr (!Epi::AFTER_DRAIN) { E(acc, cur, wr, wc, fr, fq); S.done(cur); }
        if (!has_next) break;
#pragma unroll
        for (int a = 0; a < 2; ++a)
#pragma unroll
            for (int b = 0; b < 2; ++b)
#pragma unroll
                for (int m = 0; m < 4; ++m)
#pragma unroll
                    for (int n = 0; n < 2; ++n) acc[a][b][m][n] = (f32x4){0.f, 0.f, 0.f, 0.f};
        cur = nxt; cA = nA; cB = nB; ++ui;
        if constexpr (ALIGN_EPI) { if (wr == 1) PG8_BAR; }
    }
    PG8_WAIT_V(0);
    if constexpr (!ALIGN_EPI) { if (wr == 0) PG8_BAR; }
    PG8_BAR;
    if constexpr (Epi::AFTER_DRAIN) { E.fused(acc, cur, wr, wc, fr, fq, lds, wid, lane); S.done(cur); }
#undef PG8_SA
#undef PG8_SB
#undef PG8_STAGE
#undef PG8_LDA
#undef PG8_LDB
#undef PG8_MMA
#undef PG8_WAIT_V
#undef PG8_WAIT_L
#undef PG8_BAR
#undef PG8_SCHED
}
}
namespace pg8 {
__device__ __forceinline__ const float* kin(int k) {
    typedef const float* cfp;
    const __attribute__((address_space(4))) char* ka = (const __attribute__((address_space(4))) char*)__builtin_amdgcn_kernarg_segment_ptr();
    return *(const volatile __attribute__((address_space(4))) cfp*)(ka + 8 * k);
}
struct EpiRoute {
    static constexpr bool PERM = true, AFTER_DRAIN = false, MIDHOOK = false;
    bf16_t* qkv; bf16_t* hg; bf16_t* gate; int k_lb, k_qn, k_kn;
    const float* rope;
    PG8_LAS float* xs;
    __device__ __forceinline__ void operator()(const f32x4 (&acc)[2][2][4][2], const Unit& u, int wr, int wc, int fr, int fq) const {
        bf16_t* base; int ldc, colt, mode = 0;
        if (u.pn < 3) { base = qkv; ldc = 768; colt = u.pn * 256; mode = 4; }
        else if (u.pn < 13) { base = hg; ldc = 2560; colt = (u.pn - 3) * 256; mode = (u.pn < 5 || u.pn >= 11) ? 1 : (u.pn < 7 ? 2 : (u.pn < 9 ? 3 : 0)); }
        else { base = gate; ldc = 2048; colt = (u.pn - 13) * 256; mode = 5; }
        const int row0 = u.pm * BM + wr * 64 + fr, col0 = colt + wc * 32 + 8 * fq;
        if (mode == 4) {
            const int nbj = (u.pn == 2) ? 1 : 2;
#pragma unroll
            for (int ai = 0; ai < 2; ++ai)
#pragma unroll
                for (int m = 0; m < 4; ++m)
#pragma unroll
                    for (int bj = 0; bj < 2; ++bj) { if (bj < nbj) { const f32x4 v0 = acc[ai][bj][m][0], v1 = acc[ai][bj][m][1];
                        float ss = (v0[0] * v0[0] + v0[1] * v0[1]) + (v0[2] * v0[2] + v0[3] * v0[3]) + (v1[0] * v1[0] + v1[1] * v1[1]) + (v1[2] * v1[2] + v1[3] * v1[3]);
                        ss += __shfl_xor(ss, 16); ss += __shfl_xor(ss, 32);
                        if (fq == 0) xs[((ai * HALF + wr * 64 + m * 16 + fr) * 4 + 2 * bj + (wc >> 1)) * 2 + (wc & 1)] = ss; } }
            asm volatile("s_waitcnt lgkmcnt(0)\n\ts_barrier" ::: "memory");
            const int d0 = 32 * (wc & 1) + 8 * fq;
            float gn[8];
            { const float* nrm = kin(k_qn + (int)(u.pn == 2) * (k_kn - k_qn));
#pragma unroll
              for (int j = 0; j < 8; ++j) gn[j] = nrm[d0 + j]; }
            const float qs = (u.pn == 2) ? 1.0f : 0.125f * 1.4426950408889634f;
            const int axis = wc & 1, fbase = 8 * (fq & 1);
#pragma unroll
            for (int ai = 0; ai < 2; ++ai)
#pragma unroll
                for (int m = 0; m < 4; ++m) { const int rl = ai * HALF + wr * 64 + m * 16 + fr; const int grow = u.pm * BM + rl; const int t = grow & 4095;
                    const int pos = axis ? (t & 63) : (t >> 6);
                    const f32x4* rp = (const f32x4*)(rope + (pos * 16 + fbase) * 2);
                    const f32x4 c01 = rp[0], c23 = rp[1], c45 = rp[2], c67 = rp[3];
                    const float cs[8] = {c01[0], c01[2], c23[0], c23[2], c45[0], c45[2], c67[0], c67[2]}, sn[8] = {c01[1], c01[3], c23[1], c23[3], c45[1], c45[3], c67[1], c67[3]};
                    bf16_t* rowp = base + (size_t)grow * ldc + col0;
#pragma unroll
                    for (int bj = 0; bj < 2; ++bj) { const f32x4 v0 = acc[ai][bj][m][0], v1 = acc[ai][bj][m][1];
                        float v[8] = {v0[0], v0[1], v0[2], v0[3], v1[0], v1[1], v1[2], v1[3]};
                        if (bj < nbj) {
                            const PG8_LAS float* xp = xs + ((rl * 4 + 2 * bj + (wc >> 1)) * 2);
                            const float rinv = __builtin_amdgcn_rsqf((xp[0] + xp[1]) * (1.0f / 64.0f) + 1e-6f) * qs;
#pragma unroll
                            for (int j = 0; j < 8; ++j) { const float y = v[j] * rinv * gn[j]; const float yp = __shfl_xor(y, 32);
                                v[j] = (fq & 2) ? (yp * sn[j] + y * cs[j]) : (y * cs[j] - yp * sn[j]); }
                        }
                        u32x4 w; w.x = cvt_pk_bf16(v[0], v[1]); w.y = cvt_pk_bf16(v[2], v[3]); w.z = cvt_pk_bf16(v[4], v[5]); w.w = cvt_pk_bf16(v[6], v[7]);
                        *(u32x4*)(rowp + bj * HALF) = w; } }
            return;
        }
        float lb[2][8];
        if (mode == 2 || mode == 3) { const int d = mode - 2; const float* lbraw = kin(k_lb);
#pragma unroll
            for (int bj = 0; bj < 2; ++bj) { const int c = (col0 + bj * HALF) & 511; const float* r0 = lbraw + d * 512 + c; const float* r1 = lbraw + 1024 + d * 512 + c;
#pragma unroll
                for (int j = 0; j < 8; ++j) lb[bj][j] = sigmoidf_(r0[j] - r1[j]); } }
#pragma unroll
        for (int ai = 0; ai < 2; ++ai)
#pragma unroll
            for (int m = 0; m < 4; ++m) { bf16_t* rowp = base + (size_t)(row0 + ai * HALF + m * 16) * ldc + col0;
#pragma unroll
                for (int bj = 0; bj < 2; ++bj) { const f32x4 v0 = acc[ai][bj][m][0], v1 = acc[ai][bj][m][1];
                    float v[8] = {v0[0], v0[1], v0[2], v0[3], v1[0], v1[1], v1[2], v1[3]};
                    if (mode == 1) {
#pragma unroll
                        for (int j = 0; j < 8; ++j) v[j] = v[j] * sigmoidf_(v[j]);
                    } else if (mode == 5) {
                        unsigned q8[8];
#pragma unroll
                        for (int j = 0; j < 8; ++j) q8[j] = (unsigned)__builtin_rintf(255.0f * sigmoidf_(v[j]));
                        unsigned char* gp = (unsigned char*)base + (size_t)(row0 + ai * HALF + m * 16) * 2048 + col0 + bj * HALF;
                        *(unsigned long long*)gp = (unsigned long long)(q8[0] | (q8[1] << 8) | (q8[2] << 16) | (q8[3] << 24)) | ((unsigned long long)(q8[4] | (q8[5] << 8) | (q8[6] << 16) | (q8[7] << 24)) << 32);
                        continue;
                    } else if (mode >= 2) {
#pragma unroll
                        for (int j = 0; j < 8; ++j) v[j] = __builtin_amdgcn_logf(lb[bj][j] + (1.0f - lb[bj][j]) * sigmoidf_(v[j]));
                    }
                    u32x4 w; w.x = cvt_pk_bf16(v[0], v[1]); w.y = cvt_pk_bf16(v[2], v[3]); w.z = cvt_pk_bf16(v[4], v[5]); w.w = cvt_pk_bf16(v[6], v[7]);
                    *(u32x4*)(rowp + bj * HALF) = w; } }
    }
};
struct EpiBf16Plain {
    static constexpr bool PERM = true, AFTER_DRAIN = false, MIDHOOK = false;
    bf16_t* O; int ldc;
    __device__ __forceinline__ void operator()(const f32x4 (&acc)[2][2][4][2], const Unit& u, int wr, int wc, int fr, int fq) const {
        const int row0 = u.pm * BM + wr * 64 + fr, col0 = u.pn * BM + wc * 32 + 8 * fq;
#pragma unroll
        for (int ai = 0; ai < 2; ++ai)
#pragma unroll
            for (int m = 0; m < 4; ++m) { bf16_t* rowp = O + (size_t)(row0 + ai * HALF + m * 16) * ldc + col0;
#pragma unroll
                for (int bj = 0; bj < 2; ++bj) { const f32x4 v0 = acc[ai][bj][m][0], v1 = acc[ai][bj][m][1];
                    u32x4 w; w.x = cvt_pk_bf16(v0[0], v0[1]); w.y = cvt_pk_bf16(v0[2], v0[3]); w.z = cvt_pk_bf16(v1[0], v1[1]); w.w = cvt_pk_bf16(v1[2], v1[3]);
                    *(u32x4*)(rowp + bj * HALF) = w; } }
    }
};
struct EpiMergeFused {
    static constexpr bool PERM = true, AFTER_DRAIN = false, MIDHOOK = true; static constexpr int MID_TILES = 8;
    bf16_t* MG; const unsigned char* gate;
    __device__ __forceinline__ void mid(f32x4 (&acc)[2][2][4][2], const Unit& u, int wr, int wc, int fr, int fq) const {
        const int row0 = u.pm * BM + wr * 64 + fr, col0 = u.pn * BM + wc * 32 + 8 * fq;
#pragma unroll
        for (int ai = 0; ai < 2; ++ai)
#pragma unroll
            for (int m = 0; m < 4; ++m) { const size_t row = (size_t)(row0 + ai * HALF + m * 16);
#pragma unroll
                for (int bj = 0; bj < 2; ++bj) { const int col = col0 + bj * HALF;
                    const unsigned long long ga = *(const unsigned long long*)(gate + row * 2048 + col), gb = *(const unsigned long long*)(gate + row * 2048 + 1024 + col);
#pragma unroll
                    for (int j = 0; j < 8; ++j) { const float a = (float)((unsigned)(ga >> (8 * j)) & 0xffu), b = fmaxf((float)((unsigned)(gb >> (8 * j)) & 0xffu), 9.5367431640625e-7f);
                        acc[ai][bj][m][j >> 2][j & 3] *= a * __builtin_amdgcn_rcpf(b); } } }
    }
    __device__ __forceinline__ void operator()(const f32x4 (&acc)[2][2][4][2], const Unit& u, int wr, int wc, int fr, int fq) const {
        const int row0 = u.pm * BM + wr * 64 + fr, col0 = u.pn * BM + wc * 32 + 8 * fq;
#pragma unroll
        for (int ai = 0; ai < 2; ++ai)
#pragma unroll
            for (int m = 0; m < 4; ++m) { const size_t row = (size_t)(row0 + ai * HALF + m * 16);
#pragma unroll
                for (int bj = 0; bj < 2; ++bj) { const int col = col0 + bj * HALF;
                    const unsigned long long gb = *(const unsigned long long*)(gate + row * 2048 + 1024 + col);
                    float v[8] = {acc[ai][bj][m][0][0], acc[ai][bj][m][0][1], acc[ai][bj][m][0][2], acc[ai][bj][m][0][3], acc[ai][bj][m][1][0], acc[ai][bj][m][1][1], acc[ai][bj][m][1][2], acc[ai][bj][m][1][3]};
#pragma unroll
                    for (int j = 0; j < 8; ++j) v[j] *= fmaxf((float)((unsigned)(gb >> (8 * j)) & 0xffu), 9.5367431640625e-7f) * (1.0f / 255.0f);
                    u32x4 w; w.x = cvt_pk_bf16(v[0], v[1]); w.y = cvt_pk_bf16(v[2], v[3]); w.z = cvt_pk_bf16(v[4], v[5]); w.w = cvt_pk_bf16(v[6], v[7]);
                    *(u32x4*)(MG + row * 1024 + col) = w; } }
    }
};
struct EpiResid {
    static constexpr bool PERM = true, AFTER_DRAIN = false, MIDHOOK = false;
    const bf16_t* xn; const float* aux; bf16_t* xb; float* rowss;
    __device__ __forceinline__ void operator()(const f32x4 (&acc)[2][2][4][2], const Unit& u, int wr, int wc, int fr, int fq) const {
        const int row0 = u.pm * BM + wr * 64 + fr, col0 = u.pn * BM + wc * 32 + 8 * fq;
#pragma unroll
        for (int ai = 0; ai < 2; ++ai)
#pragma unroll
            for (int m = 0; m < 4; ++m) { const size_t row = (size_t)(row0 + ai * HALF + m * 16); float ss = 0.f; const float rr = aux[65536 + row];
#pragma unroll
                for (int bj = 0; bj < 2; ++bj) { const size_t off = row * 1024 + col0 + bj * HALF;
                    const u32x4 xw = *(const u32x4*)(xn + off);
                    const f32x4 g0 = *(const f32x4*)(aux + col0 + bj * HALF) * rr, g1 = *(const f32x4*)(aux + col0 + bj * HALF + 4) * rr;
                    const f32x4 x0 = {bf_lo(xw.x) * g0[0], bf_hi(xw.x) * g0[1], bf_lo(xw.y) * g0[2], bf_hi(xw.y) * g0[3]}, x1 = {bf_lo(xw.z) * g1[0], bf_hi(xw.z) * g1[1], bf_lo(xw.w) * g1[2], bf_hi(xw.w) * g1[3]};
                    const f32x4 o0 = x0 + acc[ai][bj][m][0], o1 = x1 + acc[ai][bj][m][1];
                    ss += (o0[0] * o0[0] + o0[1] * o0[1]) + (o0[2] * o0[2] + o0[3] * o0[3]) + (o1[0] * o1[0] + o1[1] * o1[1]) + (o1[2] * o1[2] + o1[3] * o1[3]);
                    u32x4 w; w.x = cvt_pk_bf16(o0[0], o0[1]); w.y = cvt_pk_bf16(o0[2], o0[3]); w.z = cvt_pk_bf16(o1[0], o1[1]); w.w = cvt_pk_bf16(o1[2], o1[3]);
                    *(u32x4*)(xb + off) = w; }
                ss += __shfl_xor(ss, 16); ss += __shfl_xor(ss, 32);
                if (fq == 0) atomicAdd(rowss + row, ss); }
    }
};
struct EpiPleFused {
    static constexpr bool PERM = true, AFTER_DRAIN = false, MIDHOOK = true; static constexpr int MID_TILES = 4;
    float* out; bf16_t* pp; const float* rowss2; float eps; const bf16_t* aple;
    __device__ __forceinline__ void mid(f32x4 (&acc)[2][2][4][2], const Unit& u, int wr, int wc, int fr, int fq) const {
        const int row0 = u.pm * BM + wr * 64 + fr, col0 = u.pn * BM + wc * 32 + 8 * fq;
#pragma unroll
        for (int ai = 0; ai < 2; ++ai)
#pragma unroll
            for (int m = 0; m < 4; ++m) { bf16_t* rowp = pp + (size_t)(row0 + ai * HALF + m * 16) * 1024 + col0;
#pragma unroll
                for (int bj = 0; bj < 2; ++bj) { const f32x4 v0 = acc[ai][bj][m][0], v1 = acc[ai][bj][m][1];
                    u32x4 w; w.x = cvt_pk_bf16(v0[0], v0[1]); w.y = cvt_pk_bf16(v0[2], v0[3]); w.z = cvt_pk_bf16(v1[0], v1[1]); w.w = cvt_pk_bf16(v1[2], v1[3]);
                    *(u32x4*)(rowp + bj * HALF) = w;
                    acc[ai][bj][m][0] = (f32x4){0.f, 0.f, 0.f, 0.f}; acc[ai][bj][m][1] = (f32x4){0.f, 0.f, 0.f, 0.f}; } }
    }
    __device__ __forceinline__ void operator()(const f32x4 (&acc)[2][2][4][2], const Unit& u, int wr, int wc, int fr, int fq) const {
        const int row0 = u.pm * BM + wr * 64 + fr, col0 = u.pn * BM + wc * 32 + 8 * fq;
#pragma unroll
        for (int ai = 0; ai < 2; ++ai)
#pragma unroll
            for (int m = 0; m < 4; ++m) { const size_t row = (size_t)(row0 + ai * HALF + m * 16);
                const float rv = __builtin_amdgcn_rsqf(rowss2[row] * (1.0f / 1024.0f) + eps);
#pragma unroll
                for (int bj = 0; bj < 2; ++bj) { const size_t off = row * 1024 + col0 + bj * HALF;
                    const u32x4 xw = *(const u32x4*)(aple + row * 1280 + 256 + col0 + bj * HALF);
                    const f32x4 x0 = {bf_lo(xw.x), bf_hi(xw.x), bf_lo(xw.y), bf_hi(xw.y)}, x1 = {bf_lo(xw.z), bf_hi(xw.z), bf_lo(xw.w), bf_hi(xw.w)};
                    const u32x4 pw = *(const u32x4*)(pp + off);
                    const f32x4 a0 = acc[ai][bj][m][0] * rv, a1 = acc[ai][bj][m][1] * rv;
                    f32x4 o0, o1;
                    o0[0] = x0[0] + sigmoidf_(a0[0]) * bf_lo(pw.x); o0[1] = x0[1] + sigmoidf_(a0[1]) * bf_hi(pw.x);
                    o0[2] = x0[2] + sigmoidf_(a0[2]) * bf_lo(pw.y); o0[3] = x0[3] + sigmoidf_(a0[3]) * bf_hi(pw.y);
                    o1[0] = x1[0] + sigmoidf_(a1[0]) * bf_lo(pw.z); o1[1] = x1[1] + sigmoidf_(a1[1]) * bf_hi(pw.z);
                    o1[2] = x1[2] + sigmoidf_(a1[2]) * bf_lo(pw.w); o1[3] = x1[3] + sigmoidf_(a1[3]) * bf_hi(pw.w);
                    __builtin_nontemporal_store(o0, (f32x4*)(out + off)); __builtin_nontemporal_store(o1, (f32x4*)(out + off + 4)); } }
    }
};

__device__ __forceinline__ int key_enc(float s, int idx, int mask) { int b = __float_as_int(s); b = (b & ~mask) | idx; return b ^ ((b >> 31) & 0x7fffffff); }
__device__ __forceinline__ int key_dec(int k) { return k ^ ((k >> 31) & 0x7fffffff); }
__device__ __forceinline__ void ce_desc(int& a, int& b) { const int mx = a > b ? a : b, mn = a > b ? b : a; a = mx; b = mn; }
template <int N> __device__ __forceinline__ void bitonic_sort_desc(int (&v)[N]) {
#pragma unroll
    for (int k = 2; k <= N; k <<= 1)
#pragma unroll
        for (int j = k >> 1; j > 0; j >>= 1)
#pragma unroll
            for (int i = 0; i < N; ++i) { const int l = i ^ j; if (l > i) { if ((i & k) == 0) ce_desc(v[i], v[l]); else ce_desc(v[l], v[i]); } }
}
__device__ __forceinline__ void merge16_desc(int (&a)[16], const int (&b)[16]) {
#pragma unroll
    for (int i = 0; i < 16; ++i) { const int o = b[15 - i]; a[i] = a[i] > o ? a[i] : o; }
#pragma unroll
    for (int j = 8; j > 0; j >>= 1)
#pragma unroll
        for (int i = 0; i < 16; ++i) { const int l = i ^ j; if (l > i) ce_desc(a[i], a[l]); }
}

struct EpiTopk {
    static constexpr bool PERM = true, AFTER_DRAIN = true, MIDHOOK = false;
    const float* rowss; unsigned short* IDX; float* GW; float eps;
    static constexpr int LDW = 132;
    __device__ __forceinline__ void fused(const f32x4 (&acc)[2][2][4][2], const Unit& u, int wr, int wc, int fr, int fq, PG8_LAS unsigned char* lds, int wid, int lane) const {
        PG8_LAS float* S = (PG8_LAS float*)lds;
        const int tid = wid * 64 + lane, trow = tid >> 1, half = tid & 1;
        float rinv[2][4];
#pragma unroll
        for (int ai = 0; ai < 2; ++ai)
#pragma unroll
            for (int m = 0; m < 4; ++m) rinv[ai][m] = __builtin_amdgcn_rsqf(rowss[u.pm * BM + ai * HALF + wr * 64 + m * 16 + fr] * (1.0f / 1024.0f) + eps);
        int L[2][16];
#pragma unroll
        for (int p = 0; p < 2; ++p) {
#pragma unroll
            for (int ai = 0; ai < 2; ++ai)
#pragma unroll
                for (int m = 0; m < 4; ++m) { const int r = ai * HALF + wr * 64 + m * 16 + fr; PG8_LAS float* sp = S + r * LDW + wc * 32 + 8 * fq;
                    *(PG8_LAS f32x4*)sp = acc[ai][p][m][0] * rinv[ai][m]; *(PG8_LAS f32x4*)(sp + 4) = acc[ai][p][m][1] * rinv[ai][m]; }
            __syncthreads();
            int run[16];
            const PG8_LAS float* rp = S + trow * LDW + half * 64;
#pragma unroll
            for (int q = 0; q < 4; ++q) {
                int gq[16];
#pragma unroll
                for (int i4 = 0; i4 < 4; ++i4) { const f32x4 v = *(const PG8_LAS f32x4*)(rp + q * 16 + i4 * 4);
#pragma unroll
                    for (int j = 0; j < 4; ++j) gq[i4 * 4 + j] = key_enc(v[j], half * 64 + q * 16 + i4 * 4 + j, 0x7f); }
                bitonic_sort_desc<16>(gq);
                if (q == 0) {
#pragma unroll
                    for (int i = 0; i < 16; ++i) run[i] = gq[i];
                } else merge16_desc(run, gq);
            }
            int o[16];
#pragma unroll
            for (int i = 0; i < 16; ++i) o[i] = __shfl_xor(run[i], 1);
            merge16_desc(run, o);
#pragma unroll
            for (int i = 0; i < 16; ++i) L[p][i] = run[i];
            __syncthreads();
        }
        float v1[16], v2[16];
        PG8_LAS unsigned char* tb = lds + tid * 32;
#pragma unroll
        for (int i = 0; i < 16; ++i) { const int b1 = key_dec(L[0][i]), b2 = key_dec(L[1][i]); v1[i] = __int_as_float(b1 & ~0x7f); v2[i] = __int_as_float(b2 & ~0x7f);
            tb[i] = (unsigned char)(b1 & 0x7f); tb[16 + i] = (unsigned char)(b2 & 0x7f); }
        const int NEG = (int)0x80000000;
        int X[16], Y[16], Z[16];
        const bool hb = half != 0;
#define CAND(iA, jA, iB, jB) key_enc((hb ? v1[iB] : v1[iA]) + (hb ? v2[jB] : v2[jA]), hb ? ((iB) * 16 + (jB)) : ((iA) * 16 + (jA)), 0xff)
#pragma unroll
        for (int j = 0; j < 16; ++j) { if (j < 8) X[j] = CAND(0, j, 1, j); else { const int k0 = key_enc(v1[0] + v2[j], j, 0xff); X[j] = hb ? NEG : k0; } }
        {
            constexpr int yi[16] = {2, 2, 2, 2, 2, 3, 3, 3, 3, 4, 4, 4, 5, 5, 6, 6}, yj[16] = {0, 1, 2, 3, 4, 0, 1, 2, 3, 0, 1, 2, 0, 1, 0, 1};
#pragma unroll
            for (int n = 0; n < 16; ++n) { const int kb = key_enc(v1[yi[n]] + v2[yj[n]], yi[n] * 16 + yj[n], 0xff);
                if (n < 8) { const int ka = key_enc(v1[8 + n] + v2[0], (8 + n) * 16, 0xff); Y[n] = hb ? kb : ka; } else Y[n] = hb ? kb : NEG; }
        }
#pragma unroll
        for (int n = 0; n < 16; ++n) { if (n < 2) { const int kb = key_enc(v1[7] + v2[n], 7 * 16 + n, 0xff); Z[n] = hb ? kb : NEG; } else Z[n] = NEG; }
#undef CAND
        bitonic_sort_desc<16>(Y);
        merge16_desc(X, Y); merge16_desc(X, Z);
        int o2[16];
#pragma unroll
        for (int i = 0; i < 16; ++i) o2[i] = __shfl_xor(X[i], 1);
        merge16_desc(X, o2);
        float sv[16], e[16]; float sum = 0.f;
#pragma unroll
        for (int i = 0; i < 16; ++i) { sv[i] = __int_as_float(key_dec(X[i]) & ~0xff); }
#pragma unroll
        for (int i = 0; i < 16; ++i) { e[i] = __builtin_amdgcn_exp2f((sv[i] - sv[0]) * 1.4426950408889634f); sum += e[i]; }
        const float rs = 1.0f / sum;
        asm volatile("s_waitcnt lgkmcnt(0)" ::: "memory");
        if (!hb) {
            const size_t ob = (size_t)(u.pm * BM + trow) * 128 + u.pn * 16;
            unsigned ids[16];
#pragma unroll
            for (int i4 = 0; i4 < 4; ++i4) { f32x4 gv;
#pragma unroll
                for (int j = 0; j < 4; ++j) { const int i = i4 * 4 + j; const int pid = key_dec(X[i]) & 0xff; const int i1 = tb[pid >> 4], i2 = tb[16 + (pid & 15)];
                    ids[i] = (unsigned)(i1 * 128 + i2); gv[j] = e[i] * rs; }
                *(f32x4*)(GW + ob + i4 * 4) = gv; }
            *(u32x4*)(IDX + ob) = (u32x4){ids[0] | (ids[1] << 16), ids[2] | (ids[3] << 16), ids[4] | (ids[5] << 16), ids[6] | (ids[7] << 16)};
            *(u32x4*)(IDX + ob + 8) = (u32x4){ids[8] | (ids[9] << 16), ids[10] | (ids[11] << 16), ids[12] | (ids[13] << 16), ids[14] | (ids[15] << 16)};
        }
        __syncthreads();
    }
};
}
#include <hip/hip_bf16.h>
#include <cmath>
namespace attn_body {
using bf16=__hip_bfloat16;
using bf16x8=__attribute__((ext_vector_type(8)))short;
using s16x4=__attribute__((ext_vector_type(4)))short;
using f32x16=__attribute__((ext_vector_type(16)))float;
using u32x4=__attribute__((ext_vector_type(4)))unsigned;
constexpr int BATCH=8,NHEAD=8,NKV=2,SEQ=4096,D=64,DM=768;
constexpr int NW=8,QBLK=32,QB=QBLK*NW,KVBLK=64,NQB=SEQ/QB;
constexpr int ATTN_PITCH=DM, ATTN_UNIT_ROWS=QB, ODM=1024;
__device__ __forceinline__ int crow(int r,int hi){return (r&3)+8*(r>>2)+4*hi;}
#define SBAR() __builtin_amdgcn_sched_barrier(0)
__device__ __forceinline__ void cmask(f32x16&p0,f32x16&p1,int jb,int qrel,int hi){
  const float NEG=-INFINITY; int kb=64*jb+4*hi;
  #pragma unroll
  for(int r=0;r<16;++r){int kv=kb+(r&3)+8*(r>>2); if(kv>qrel)p0[r]=NEG; if(kv+32>qrel)p1[r]=NEG;}
}

constexpr int NSLOT=3, SLOTB=8192;
constexpr int LDS_K=0, LDS_V=NSLOT*SLOTB, LDS_WS=2*NSLOT*SLOTB, LDS_OST=LDS_WS+NW*64*4, LDS_BYTES=LDS_OST+NW*4096;
constexpr float C2=0.125f*1.4426950408889634f;
__device__ __forceinline__ void glds16(const void*gsrc,unsigned lds_dst){unsigned keep;
  asm volatile("s_mov_b32 %0, m0\n\ts_mov_b32 m0, %2\n\ts_nop 0\n\tglobal_load_lds_dwordx4 %1, off\n\ts_mov_b32 m0, %0":"=&s"(keep):"v"(gsrc),"s"(lds_dst):"memory");}
__device__ __forceinline__ float max3f(float a,float b,float c){float r;asm("v_max3_f32 %0, %1, %2, %3":"=v"(r):"v"(a),"v"(b),"v"(c));return r;}
__device__ __forceinline__ float max2f(float a,float b){float r;asm("v_max_f32_e32 %0, %1, %2":"=v"(r):"v"(a),"v"(b));return r;}
__device__ __forceinline__ float fadd_s(float a,float b){float r;asm("v_add_f32_e32 %0, %1, %2":"=v"(r):"v"(a),"v"(b));return r;}
__device__ __forceinline__ float fsub_s(float a,float b){float r;asm("v_sub_f32_e32 %0, %1, %2":"=v"(r):"v"(a),"v"(b));return r;}
typedef float f32x2_t __attribute__((ext_vector_type(2))); typedef __bf16 bf16x2_t __attribute__((ext_vector_type(2)));
__device__ __forceinline__ unsigned cvtpk_s(float lo,float hi){f32x2_t v={lo,hi};bf16x2_t b=__builtin_convertvector(v,bf16x2_t);return __builtin_bit_cast(unsigned,b);}
#define WAIT_BAR(N) asm volatile("s_waitcnt vmcnt(" #N ") lgkmcnt(0)\n\ts_barrier":::"memory")

__device__ __forceinline__ void qkt(f32x16&p0,f32x16&p1,const char*Kslot,const bf16x8*qr,const f32x16&negm,int r32,int hi){
  const char*kb=Kslot+hi*1024+r32*16;
  #pragma unroll
  for(int d0=0;d0<4;++d0){
    const bf16x8 b0=*reinterpret_cast<const bf16x8*>(kb+d0*2048);
    const bf16x8 b1=*reinterpret_cast<const bf16x8*>(kb+d0*2048+512);
    if(d0==0){p0=__builtin_amdgcn_mfma_f32_32x32x16_bf16(b0,qr[0],negm,0,0,0);p1=__builtin_amdgcn_mfma_f32_32x32x16_bf16(b1,qr[0],negm,0,0,0);}
    else{p0=__builtin_amdgcn_mfma_f32_32x32x16_bf16(b0,qr[d0],p0,0,0,0);p1=__builtin_amdgcn_mfma_f32_32x32x16_bf16(b1,qr[d0],p1,0,0,0);}}
}
typedef __attribute__((address_space(3))) const char* lds_cptr;
typedef short v4i16_t __attribute__((ext_vector_type(4)));
__device__ __forceinline__ void kload8(bf16x8*kf,lds_cptr kp){
  kf[0]=*(const __attribute__((address_space(3))) bf16x8*)(kp);      kf[1]=*(const __attribute__((address_space(3))) bf16x8*)(kp+512);
  kf[2]=*(const __attribute__((address_space(3))) bf16x8*)(kp+2048); kf[3]=*(const __attribute__((address_space(3))) bf16x8*)(kp+2560);
  kf[4]=*(const __attribute__((address_space(3))) bf16x8*)(kp+4096); kf[5]=*(const __attribute__((address_space(3))) bf16x8*)(kp+4608);
  kf[6]=*(const __attribute__((address_space(3))) bf16x8*)(kp+6144); kf[7]=*(const __attribute__((address_space(3))) bf16x8*)(kp+6656);
}
__device__ __forceinline__ void kload2(bf16x8*kf,lds_cptr kp,int j){ kf[2*j]=*(const __attribute__((address_space(3))) bf16x8*)(kp+j*2048); kf[2*j+1]=*(const __attribute__((address_space(3))) bf16x8*)(kp+j*2048+512); }
__device__ __forceinline__ s16x4 vtr(lds_cptr p){ return __builtin_bit_cast(s16x4,__builtin_amdgcn_ds_read_tr16_b64_v4i16((__attribute__((address_space(3))) v4i16_t*)p)); }
__device__ __forceinline__ float rowmax(const f32x16&p0,const f32x16&p1){
  float a=max3f(p0[0],p0[1],p1[0]),b=max3f(p0[2],p0[3],p1[1]);a=max3f(a,p1[2],p1[3]);
  #pragma unroll
  for(int r=4;r<16;r+=4){a=max3f(a,p0[r],p0[r+1]);b=max3f(b,p0[r+2],p0[r+3]);a=max3f(a,p1[r],p1[r+1]);b=max3f(b,p1[r+2],p1[r+3]);}
  const float m=max2f(a,b);
  auto rr=__builtin_amdgcn_permlane32_swap(__float_as_uint(m),__float_as_uint(m),false,false);
  return max2f(__uint_as_float(rr[0]),__uint_as_float(rr[1]));
}
__device__ __forceinline__ void pv(f32x16*o,int vb,bf16x8 pa0,bf16x8 pa1,bf16x8 pa2,bf16x8 pa3){
  #pragma unroll
  for(int d0=0;d0<2;++d0){s16x4 lo[4],hi[4];
    #pragma unroll
    for(int ks=0;ks<4;++ks){
      asm volatile("ds_read_b64_tr_b16 %0,%1 offset:%c2":"=&v"(lo[ks]):"v"(vb),"i"(d0*4096+ks*1024):"memory");
      asm volatile("ds_read_b64_tr_b16 %0,%1 offset:%c2":"=&v"(hi[ks]):"v"(vb),"i"(d0*4096+ks*1024+512):"memory");}
    asm volatile("s_waitcnt lgkmcnt(0)":::"memory");SBAR();
    #define PK(k) (bf16x8){lo[k][0],lo[k][1],lo[k][2],lo[k][3],hi[k][0],hi[k][1],hi[k][2],hi[k][3]}
    o[d0]=__builtin_amdgcn_mfma_f32_32x32x16_bf16(pa0,PK(0),o[d0],0,0,0);
    o[d0]=__builtin_amdgcn_mfma_f32_32x32x16_bf16(pa1,PK(1),o[d0],0,0,0);
    o[d0]=__builtin_amdgcn_mfma_f32_32x32x16_bf16(pa2,PK(2),o[d0],0,0,0);
    o[d0]=__builtin_amdgcn_mfma_f32_32x32x16_bf16(pa3,PK(3),o[d0],0,0,0);
    #undef PK
  }
}

#ifndef ATTN_STORE16
#define ATTN_STORE16(p,v) (*(u32x4*)(p)=(v))
#endif
template<int THRL> __device__ __forceinline__ void attn_unit(int wave_id,int b,int h,int qb,const bf16*Q,const bf16*__restrict__ K,const bf16*__restrict__ V,bf16*O,char*shm){
  int tid_; asm volatile("v_mbcnt_lo_u32_b32 %0, -1, 0\n\tv_mbcnt_hi_u32_b32 %0, -1, %0":"=v"(tid_)); tid_+=wave_id*64; const int tid=tid_,lane=tid&63,r32=lane&31,hi=lane>>5; const int wid=__builtin_amdgcn_readfirstlane(tid>>6);
  const long rowbase=(long)b*SEQ; const int q0=qb*QB;
  const bf16*Qw=Q+(rowbase+q0+wid*QBLK)*DM+h*D;
  const bf16*Kh=K+rowbase*DM+(h/(NHEAD/NKV))*D,*Vh=V+rowbase*DM+(h/(NHEAD/NKV))*D;
  const unsigned lds0=(unsigned)(uintptr_t)shm;
  float*wsf=(float*)(shm+LDS_WS)+wid*64;
  const bf16*ksrc=Kh+(long)lane*DM+wid*8;
  const bf16*vsrc=Vh+(long)(16*(wid&3)+(lane>>2))*DM+(wid>>2)*32+(lane&3)*8;
  const unsigned kdst=lds0+LDS_K+wid*1024, vdst=lds0+LDS_V+wid*1024;
  #define DMA_K(t,slot) glds16(ksrc+(long)(t)*KVBLK*DM,(unsigned)__builtin_amdgcn_readfirstlane(kdst+(slot)))
  #define DMA_V(t,slot) glds16(vsrc+(long)(t)*KVBLK*DM,(unsigned)__builtin_amdgcn_readfirstlane(vdst+(slot)))
  const int vb0=(int)(lds0+LDS_V)+((lane>>4)&1)*32+(lane&3)*8+(4*hi+((lane&15)>>2))*64;
  const char*Kbase=shm+LDS_K; bf16x8 kf[8];
  const lds_cptr shm3=(lds_cptr)shm; const lds_cptr kp0=shm3+LDS_K+hi*1024+r32*16; const lds_cptr vp0=shm3+LDS_V+((lane>>4)&1)*32+(lane&3)*8+(4*hi+((lane&15)>>2))*64;
  constexpr int NT=SEQ/KVBLK;
  DMA_K(0,0);DMA_V(0,0);DMA_K(1,SLOTB);
  bf16x8 qr[4];
  #pragma unroll
  for(int d0=0;d0<4;++d0)qr[d0]=*reinterpret_cast<const bf16x8*>(&Qw[(long)r32*DM+d0*16+hi*8]);
  float mhat=0.f,l_reg=0.f;f32x16 o[2];o[0]=f32x16{};o[1]=f32x16{};f32x16 negm=f32x16{};asm volatile("":"+v"(negm));
  const int qrel=wid*QBLK+r32;
  #define CMASK(P0,P1,t) do{}while(0)
  bool resc=false;
  #define START(P0,P1) do{ const float rm=rowmax(P0,P1); resc=false; \
    { const float dl=rm; mhat=fadd_s(mhat,dl); \
      _Pragma("unroll") for(int r=0;r<16;++r){P0[r]=fsub_s(P0[r],dl);P1[r]=fsub_s(P1[r],dl);} \
      _Pragma("unroll") for(int r=0;r<16;++r)negm[r]=-mhat; asm volatile("":"+v"(negm)); } \
    _Pragma("unroll") for(int r=0;r<16;++r)P0[r]=__builtin_amdgcn_exp2f(P0[r]); }while(0)
  #define RESC() do{ if(resc){ asm volatile("s_waitcnt lgkmcnt(0)":::"memory"); \
      _Pragma("unroll") for(int d_=0;d_<2;++d_) _Pragma("unroll") for(int r=0;r<16;++r)o[d_][r]*=wsf[crow(r,hi)]; } }while(0)
  f32x16 pA0,pA1,pB0,pB1;
  int sl_prev=0,sl_cur=0,sl_next=SLOTB;
  #define ROT() do{sl_prev=sl_cur;sl_cur=sl_next;sl_next=(sl_next==(NSLOT-1)*SLOTB)?0:sl_next+SLOTB;}while(0)
  DMA_K(2,2*SLOTB);
  WAIT_BAR(3);
  qkt(pA0,pA1,Kbase,qr,negm,r32,hi);asm volatile("s_nop 15\n\ts_nop 7":"+v"(pA0),"+v"(pA1));CMASK(pA0,pA1,0);
  START(pA0,pA1);
  _Pragma("unroll") for(int r=0;r<16;++r)pA1[r]=__builtin_amdgcn_exp2f(pA1[r]);
  WAIT_BAR(0);
  DMA_K(3,0);DMA_V(1,SLOTB);
  ROT();
  kload8(kf,kp0+sl_cur);
  WAIT_BAR(2);
  s16x4 vlo[8],vhi[8]; u32x4 pw0,pw1,pw2,pw3;
  #define PKW(P,B) cvtpk_s(P[B],P[B+1])
  #define PAF(k) __builtin_bit_cast(bf16x8,pw##k)
  #define VFR(i) (bf16x8){vlo[i][0],vlo[i][1],vlo[i][2],vlo[i][3],vhi[i][0],vhi[i][1],vhi[i][2],vhi[i][3]}
  #define PIN(x) asm volatile("":"+v"(x))
  #define MX3(a,b,c) __builtin_fmaxf(__builtin_fmaxf((a),(b)),(c))
  #define GAPA(MF,A0,A1,A2,A3,W0,W1,PW) do{ MF; sacc+=A0; sacc+=A1; sacc+=A2; sacc+=A3; PIN(sacc); W0; W1; PIN(PW); SBAR(); }while(0)
  #define EX(v) __builtin_amdgcn_exp2f(v)
  #define GAPB(MF,X,B) do{ MF; X[B]=EX(X[B]); X[B+1]=EX(X[B+1]); X[B+2]=EX(X[B+2]); X[B+3]=EX(X[B+3]); PIN(X); SBAR(); }while(0)
  #define VRD(i) do{ vlo[i]=vtr(vp_+(((i)>>2)*4096+((i)&3)*1024)); vhi[i]=vtr(vp_+(((i)>>2)*4096+((i)&3)*1024+512)); }while(0)
  #define KRD(G,j) do{ if(G){ kload2(kf,kp0+sl_next,j); SBAR(); } }while(0)
  #define STEP(C0,C1,P0,P1,t,GK,GV,GL) do{ SBAR(); \
    const lds_cptr vp_=vp0+sl_prev; \
    VRD(0); SBAR(); float sacc=(P0[0]+P0[1]); \
    GAPA(C0=__builtin_amdgcn_mfma_f32_32x32x16_bf16(kf[0],qr[0],negm,0,0,0), P0[2],P0[3],P0[4],P0[5],     pw0[0]=PKW(P0,0), pw0[1]=PKW(P0,2), pw0); \
    VRD(4); SBAR(); GAPA(C1=__builtin_amdgcn_mfma_f32_32x32x16_bf16(kf[1],qr[0],negm,0,0,0), P0[6],P0[7],P0[8],P0[9],     pw0[2]=PKW(P0,4), pw0[3]=PKW(P0,6), pw0); \
    VRD(1); SBAR(); GAPA(C0=__builtin_amdgcn_mfma_f32_32x32x16_bf16(kf[2],qr[1],C0,0,0,0),   P0[10],P0[11],P0[12],P0[13], pw1[0]=PKW(P0,8), pw1[1]=PKW(P0,10), pw1); \
    VRD(5); SBAR(); GAPA(C1=__builtin_amdgcn_mfma_f32_32x32x16_bf16(kf[3],qr[1],C1,0,0,0),   P0[14],P0[15],P1[0],P1[1],   pw1[2]=PKW(P0,12),pw1[3]=PKW(P0,14), pw1); \
    VRD(2); SBAR(); GAPA(C0=__builtin_amdgcn_mfma_f32_32x32x16_bf16(kf[4],qr[2],C0,0,0,0),   P1[2],P1[3],P1[4],P1[5],     pw2[0]=PKW(P1,0), pw2[1]=PKW(P1,2), pw2); \
    VRD(6); SBAR(); GAPA(C1=__builtin_amdgcn_mfma_f32_32x32x16_bf16(kf[5],qr[2],C1,0,0,0),   P1[6],P1[7],P1[8],P1[9],     pw2[2]=PKW(P1,4), pw2[3]=PKW(P1,6), pw2); \
    VRD(3); SBAR(); GAPA(C0=__builtin_amdgcn_mfma_f32_32x32x16_bf16(kf[6],qr[3],C0,0,0,0),   P1[10],P1[11],P1[12],P1[13], pw3[0]=PKW(P1,8), pw3[1]=PKW(P1,10), pw3); \
    VRD(7); SBAR(); GAPA(C1=__builtin_amdgcn_mfma_f32_32x32x16_bf16(kf[7],qr[3],C1,0,0,0),   P1[14],P1[15],0.f,0.f,       pw3[2]=PKW(P1,12),pw3[3]=PKW(P1,14), pw3); \
    l_reg+=sacc; \
    if(GK){DMA_K((t)+3,sl_cur);} if(GV){DMA_V((t)+1,sl_next);} \
    CMASK(C0,C1,t); \
    { float a=MX3(C0[0],C0[1],C1[0]),b=MX3(C0[2],C0[3],C1[1]); a=MX3(a,C1[2],C1[3]); \
      _Pragma("unroll") for(int r=4;r<16;r+=4){a=MX3(a,C0[r],C0[r+1]);b=MX3(b,C0[r+2],C0[r+3]);a=MX3(a,C1[r],C1[r+1]);b=MX3(b,C1[r+2],C1[r+3]);} \
      float rm=__builtin_fmaxf(a,b); { auto rr=__builtin_amdgcn_permlane32_swap(__float_as_uint(rm),__float_as_uint(rm),false,false); rm=__builtin_fmaxf(__uint_as_float(rr[0]),__uint_as_float(rr[1])); } \
      resc=false; \
      if(__builtin_expect(__any(rm>(float)THRL),0)){ const float dl=__builtin_fmaxf(rm,0.f); mhat+=dl; \
        _Pragma("unroll") for(int r=0;r<16;++r){C0[r]-=dl;C1[r]-=dl;} \
        _Pragma("unroll") for(int r=0;r<16;++r)negm[r]=-mhat; asm volatile("":"+v"(negm)); \
        const float f=__builtin_amdgcn_exp2f(-dl); l_reg*=f; if(hi==0)wsf[r32]=f; resc=true; } } \
    SBAR(); \
    GAPB(o[0]=__builtin_amdgcn_mfma_f32_32x32x16_bf16(PAF(0),VFR(0),o[0],0,0,0), C0,0); \
    GAPB(o[1]=__builtin_amdgcn_mfma_f32_32x32x16_bf16(PAF(0),VFR(4),o[1],0,0,0), C0,4); \
    KRD(GL,0); GAPB(o[0]=__builtin_amdgcn_mfma_f32_32x32x16_bf16(PAF(1),VFR(1),o[0],0,0,0), C0,8); \
    KRD(GL,1); GAPB(o[1]=__builtin_amdgcn_mfma_f32_32x32x16_bf16(PAF(1),VFR(5),o[1],0,0,0), C0,12); \
    KRD(GL,2); GAPB(o[0]=__builtin_amdgcn_mfma_f32_32x32x16_bf16(PAF(2),VFR(2),o[0],0,0,0), C1,0); \
    KRD(GL,3); GAPB(o[1]=__builtin_amdgcn_mfma_f32_32x32x16_bf16(PAF(2),VFR(6),o[1],0,0,0), C1,4); \
    GAPB(o[0]=__builtin_amdgcn_mfma_f32_32x32x16_bf16(PAF(3),VFR(3),o[0],0,0,0), C1,8); \
    GAPB(o[1]=__builtin_amdgcn_mfma_f32_32x32x16_bf16(PAF(3),VFR(7),o[1],0,0,0), C1,12); \
    }while(0)
  int t=1;
  #undef CMASK
  #define CMASK(P0,P1,t) do{}while(0)
  for(;t+5<NT;t+=2){
    STEP(pB0,pB1,pA0,pA1,t,true,true,true);     WAIT_BAR(2); RESC(); ROT();
    STEP(pA0,pA1,pB0,pB1,t+1,true,true,true);   WAIT_BAR(2); RESC(); ROT();
  }
  #undef CMASK
  #define CMASK(P0,P1,t) do{}while(0)
  #define ENDW(tt) do{ if((tt)+3<NT){WAIT_BAR(2);} else if((tt)+2<NT){WAIT_BAR(1);} else {WAIT_BAR(0);} }while(0)
  for(;t+1<NT;t+=2){
    STEP(pB0,pB1,pA0,pA1,t,(t+3<NT),(t+1<NT),(t+1<NT));       ENDW(t);   RESC(); ROT();
    STEP(pA0,pA1,pB0,pB1,t+1,(t+4<NT),(t+2<NT),(t+2<NT));     ENDW(t+1); RESC(); ROT();
  }
  STEP(pB0,pB1,pA0,pA1,NT-1,false,false,false); RESC();
  { float sacc=pB0[0]+pB0[1]; _Pragma("unroll") for(int r=2;r<16;++r)sacc+=pB0[r]; _Pragma("unroll") for(int r=0;r<16;++r)sacc+=pB1[r]; l_reg+=sacc;
    pw0=(u32x4){PKW(pB0,0),PKW(pB0,2),PKW(pB0,4),PKW(pB0,6)};pw1=(u32x4){PKW(pB0,8),PKW(pB0,10),PKW(pB0,12),PKW(pB0,14)};pw2=(u32x4){PKW(pB1,0),PKW(pB1,2),PKW(pB1,4),PKW(pB1,6)};pw3=(u32x4){PKW(pB1,8),PKW(pB1,10),PKW(pB1,12),PKW(pB1,14)};
    SBAR(); pv(o,vb0+sl_cur,PAF(0),PAF(1),PAF(2),PAF(3)); }
  #undef PKW
  #undef PAF
  #undef VFR
  #undef PIN
  #undef MX3
  #undef GAPA
  #undef GAPB
  #undef EX
  #undef VRD
  #undef KRD
  #undef STEP
  #undef ENDW
  {auto rr=__builtin_amdgcn_permlane32_swap(__float_as_uint(l_reg),__float_as_uint(l_reg),false,false);l_reg=__uint_as_float(rr[0])+__uint_as_float(rr[1]);}
  if(hi==0)wsf[32+r32]=l_reg;asm volatile("s_waitcnt lgkmcnt(0)":::"memory");
  float rli[16];
  #pragma unroll
  for(int r=0;r<16;++r)rli[r]=__builtin_amdgcn_rcpf(wsf[32+crow(r,hi)]);
  bf16*Ow=O+(rowbase+q0+wid*QBLK)*ODM+h*D;
  { bf16*stg=(bf16*)(shm+LDS_OST)+wid*2048;
    #pragma unroll
    for(int r=0;r<16;++r){const int orow=crow(r,hi);
      #pragma unroll
      for(int d0=0;d0<2;++d0)stg[orow*64+d0*32+r32]=__float2bfloat16(o[d0][r]*rli[r]);}
    asm volatile("s_waitcnt lgkmcnt(0)":::"memory");
    #pragma unroll
    for(int i=0;i<4;++i){const int row=i*8+(lane>>3),ch=lane&7; const u32x4 v=*(const u32x4*)(stg+row*64+ch*8); ATTN_STORE16(Ow+(long)row*ODM+ch*8,v);} }
  asm volatile("s_waitcnt lgkmcnt(0)\n\ts_barrier":::"memory");
  #undef DMA_K
  #undef DMA_V
  #undef CMASK
  #undef START
  #undef RESC
  #undef ROT
}
constexpr int ATTN_LDS_BYTES=LDS_BYTES;
struct AttnTensors { const bf16* Q; const bf16* K; const bf16* V; bf16* O; };
struct AttnUnit { int bh; int qb; };
__device__ __forceinline__ void unit_decode(int n,AttnUnit&u){ const int grp=n>>6,wi=n&63; const int b=grp>>1,kvh=grp&1; u.bh=b*NHEAD+kvh*(NHEAD/NKV)+(wi>>4); u.qb=wi&15; }
#undef SBAR
#undef WAIT_BAR
}
constexpr int NWAVES = 8;
constexpr int BATCH = 8, SEQ = 4096, DMODEL = 1024, T = BATCH * SEQ;
constexpr int INW = 5376, QKVW = 768, HGW = 2560, GATEW = 2048;
constexpr int NEXP = 16384, PLED = 256;
constexpr float EPS = 1e-6f;
constexpr size_t MiB = 1u << 20;
constexpr size_t WS_CTL = 0, CTL_ZERO_BYTES = 1 * MiB;
constexpr size_t WS_ROPE = 1 * MiB;
constexpr size_t WS_GINV = WS_ROPE + 256 * 1024, WS_RMS = WS_GINV + 65536 * 4;
constexpr size_t WS_WIN = 2 * MiB;
constexpr size_t WS_WUA = 13 * MiB;
constexpr size_t WS_WOUT = 15 * MiB;
constexpr size_t WS_WPEER = 17 * MiB;
constexpr size_t WS_WPG = 21 * MiB;
constexpr size_t WS_XN = 24 * MiB;
constexpr size_t WS_QKV = 88 * MiB;
constexpr size_t WS_HG = 136 * MiB;
constexpr size_t WS_GATE = 296 * MiB;
constexpr size_t WS_END = 507 * MiB;
constexpr size_t WS_UB8 = 424 * MiB, WS_VB8 = 440 * MiB, WS_US = 456 * MiB;
constexpr size_t WS_IDX = WS_HG + 80 * MiB, WS_GW = WS_HG + 96 * MiB, WS_W = WS_HG + 112 * MiB;
constexpr size_t WS_H8 = 474 * MiB, WS_TSC = 506 * MiB;
constexpr size_t WS_X1B = WS_GATE, WS_PP = WS_GATE + 64 * MiB;
constexpr int CW_BAR = 4096;
constexpr int CW_QUEUE = 16384;
constexpr int CW_ROWSS = 131072;
constexpr int CW_ROWSS2 = CW_ROWSS + 32768;
static_assert((CW_ROWSS2 + 32768) * 4 <= (int)CTL_ZERO_BYTES, "ctl");
constexpr int SCR_BYTES = 147456;
constexpr int LDSCTL_OFF = SCR_BYTES, MISC_OFF = LDSCTL_OFF + 320;
constexpr int LDS_BYTES = SCR_BYTES + 1024;

#define GAS __attribute__((address_space(1)))
#define LAS __attribute__((address_space(3)))
typedef unsigned short bf16;
typedef unsigned v4u __attribute__((ext_vector_type(4)));
typedef unsigned v2u __attribute__((ext_vector_type(2)));
typedef float f32x4 __attribute__((ext_vector_type(4)));
typedef float f32x16 __attribute__((ext_vector_type(16)));
typedef short bf16x8 __attribute__((ext_vector_type(8)));
typedef GAS unsigned gu32;
#define RLX_AGENT __ATOMIC_RELAXED, __HIP_MEMORY_SCOPE_AGENT
#define LDS_WAIT() asm volatile("s_waitcnt lgkmcnt(0)" ::: "memory")
#define VM_WAIT() asm volatile("s_waitcnt vmcnt(0)" ::: "memory")
#define DI __device__ __forceinline__
DI int lane_id() { int l; asm volatile("v_mbcnt_lo_u32_b32 %0, -1, 0\n\tv_mbcnt_hi_u32_b32 %0, -1, %0" : "=v"(l)); return l; }
DI unsigned f2bf(float f) { unsigned u = __builtin_bit_cast(unsigned, f); return (u + 0x7fffu + ((u >> 16) & 1u)) >> 16; }
DI unsigned pk2(float lo, float hi) { typedef float f2 __attribute__((ext_vector_type(2))); typedef __bf16 b2 __attribute__((ext_vector_type(2))); f2 v = {lo, hi}; b2 b = __builtin_convertvector(v, b2); return __builtin_bit_cast(unsigned, b); }
DI float bflo(unsigned w) { return __uint_as_float(w << 16); }
DI float bfhi(unsigned w) { return __uint_as_float(w & 0xffff0000u); }
DI float fsigmoid(float x) { return __builtin_amdgcn_rcpf(1.0f + __builtin_amdgcn_exp2f(-1.4426950408889634f * x)); }
DI float fexp(float x) { return __builtin_amdgcn_exp2f(1.4426950408889634f * x); }
DI float wave_sum(float v) {
#pragma unroll
    for (int o = 1; o < 64; o <<= 1) v += __shfl_xor(v, o);
    return v;
}

#define XB_TMO      128
#define XB_XCNT(j)  (256  + 64 * (j))
#define XB_XSUB(j)  (1280 + 64 * (j))
#define XB_XGEN(j)  (2304 + 64 * (j))
#define XB_TOP      3328
#define XB_TOPGEN   3392
#define XCD_BAR_WORDS 3456
#define XB_SPIN_CAP (1u << 18)
DI unsigned xb_ld(unsigned* p)              { return __hip_atomic_load(p, __ATOMIC_RELAXED, __HIP_MEMORY_SCOPE_AGENT); }
DI unsigned xb_add(unsigned* p, unsigned v) { return __hip_atomic_fetch_add(p, v, __ATOMIC_RELAXED, __HIP_MEMORY_SCOPE_AGENT); }
DI unsigned xb_xcc_id() { return (unsigned)__builtin_amdgcn_s_getreg((3 << 11) | 20) & 0xFu; }
#define XB_SPIN(cond, bar) do { unsigned _sp = 0; while (cond) { __builtin_amdgcn_s_sleep(1); \
    if ((++_sp & 255u) == 0u) { if (xb_ld(&(bar)[XB_TMO])) break; if (_sp > XB_SPIN_CAP) { atomicAdd(&(bar)[XB_TMO], 1u); break; } } } } while (0)
struct XcdBarrier { unsigned* bar; unsigned x; volatile LAS unsigned* st; };
DI XcdBarrier xcd_barrier_post(unsigned* bar, volatile LAS unsigned* st, bool t0) {
    XcdBarrier b; b.bar = bar; b.x = xb_xcc_id(); b.st = st;
    if (t0) st[2] = xb_add(&bar[XB_XCNT(b.x)], 1u);
    return b;
}
DI void xcd_barrier_complete(unsigned* bar, unsigned x, unsigned& nloc, unsigned& nx) {
    const unsigned G = gridDim.x * gridDim.y * gridDim.z;
    unsigned sum, cnt, mine, sp = 0u;
    for (;;) {
        sum = 0u; cnt = 0u; mine = 0u;
#pragma unroll
        for (unsigned j = 0; j < 16; ++j) { const unsigned c = xb_ld(&bar[XB_XCNT(j)]); sum += c; cnt += (c > 0u) ? 1u : 0u; mine = (j == x) ? c : mine; }
        if (sum == G) break;
        __builtin_amdgcn_s_sleep(1);
        if ((++sp & 255u) == 0u) { if (xb_ld(&bar[XB_TMO])) break; if (sp > XB_SPIN_CAP) { atomicAdd(&bar[XB_TMO], 1u); break; } }
    }
    nloc = mine > 0u ? mine : 1u; nx = cnt > 0u ? cnt : 1u;
}
DI void xcd_barrier(const XcdBarrier& b, bool t0) {
    asm volatile("s_waitcnt vmcnt(0)" ::: "memory");
    __syncthreads();
    if (t0) {
        unsigned* bar = b.bar;
        __builtin_amdgcn_s_waitcnt(0);
        unsigned nloc = b.st[0], nx = b.st[1];
        if (nloc == 0u) { xcd_barrier_complete(bar, b.x, nloc, nx); b.st[0] = nloc; b.st[1] = nx; }
        const unsigned old = xb_add(&bar[XB_XSUB(b.x)], 1u);
        const unsigned gen = old / nloc;
        if (old + 1u == (gen + 1u) * nloc) {
            __builtin_amdgcn_fence(__ATOMIC_RELEASE, "agent");
            asm volatile("s_waitcnt vmcnt(0)" ::: "memory");
            const unsigned og = xb_add(&bar[XB_TOP], 1u);
            const unsigned tg = og / nx;
            if (og + 1u == (tg + 1u) * nx) xb_add(&bar[XB_TOPGEN], 1u);
            else XB_SPIN(xb_ld(&bar[XB_TOPGEN]) == tg, bar);
            __builtin_amdgcn_fence(__ATOMIC_ACQUIRE, "agent");
            xb_add(&bar[XB_XGEN(b.x)], 1u);
            asm volatile("s_waitcnt vmcnt(0)" ::: "memory");
        } else {
            XB_SPIN(xb_ld(&bar[XB_XGEN(b.x)]) == gen, bar);
            __builtin_amdgcn_fence(__ATOMIC_ACQUIRE, "agent");
            asm volatile("s_waitcnt vmcnt(0)" ::: "memory");
        }
    }
    __syncthreads();
}
DI void xcd_census(unsigned* bar, unsigned x, int& v, int& nx, int& nloc) {
    int vv = 0, cnt = 0, mine = 1;
#pragma unroll
    for (unsigned j = 0; j < 16; ++j) { const unsigned c = xb_ld(&bar[XB_XCNT(j)]); cnt += (c > 0u) ? 1 : 0; vv += (c > 0u && j < x) ? 1 : 0; if (j == x) mine = (int)c; }
    v = vv; nx = cnt > 0 ? cnt : 1; nloc = mine > 0 ? mine : 1;
}
DI void wg_l1_refresh(bool t0) {
    asm volatile("s_waitcnt vmcnt(0)" ::: "memory");
    __syncthreads();
    if (t0) { __builtin_amdgcn_fence(__ATOMIC_ACQUIRE, "agent"); asm volatile("s_waitcnt vmcnt(0)" ::: "memory"); }
    __syncthreads();
}

struct Frame {
    LAS unsigned char* lds;
    volatile LAS unsigned* MISC;
    gu32* ctl;
    int wave;
    int vcu, G;
    unsigned char* ws;
    float* out;
};
enum { I_X = 0, I_P, I_NORM_MIX, I_W_IN, I_Q_NORM, I_K_NORM, I_HG_LB, I_HG_ONORM, I_W_UP_ATT, I_W_UP_HG, I_W_OUT, I_NORM_FFN, I_PEER_WQ, I_PEER_SK, I_PEER_U, I_PEER_V, I_NORM_PLE, I_PLE_GATE, I_PLE_PROJ };
DI const float* inp(int k) {
    typedef const float* cfp;
    const __attribute__((address_space(4))) char* ka = (const __attribute__((address_space(4))) char*)__builtin_amdgcn_kernarg_segment_ptr();
    return *(const volatile __attribute__((address_space(4))) cfp*)(ka + 8 * k);
}

DI void p0_transpose_item(const float* W, int K, int N, bf16* WT, LAS float* scr, int item, int lane, const float* kgain = nullptr, int ldt = 0, int koff = 0) {
    if (ldt == 0) ldt = K;
    const int nblk = N / 32, kb = item / nblk, nb = item % nblk, k0 = 64 * kb, n0 = 32 * nb;
    float wv_[32];
#pragma unroll
    for (int i = 0; i < 32; ++i) { const int kk = 2 * i + (lane >> 5); wv_[i] = W[(size_t)(k0 + kk) * N + n0 + (lane & 31)]; }
#pragma unroll
    for (int i = 0; i < 32; ++i) { const int kk = 2 * i + (lane >> 5); scr[kk * 33 + (lane & 31)] = wv_[i] * (kgain ? kgain[k0 + kk] : 1.0f); }
    LDS_WAIT(); asm volatile("" ::: "memory");
    const int c = lane & 7;
#pragma unroll
    for (int j = 0; j < 4; ++j) { const int n = (lane >> 3) + 8 * j; const LAS float* s = scr + (8 * c) * 33 + n;
        v4u o; o.x = pk2(s[0 * 33], s[1 * 33]); o.y = pk2(s[2 * 33], s[3 * 33]); o.z = pk2(s[4 * 33], s[5 * 33]); o.w = pk2(s[6 * 33], s[7 * 33]);
        *(GAS v4u*)(WT + (size_t)(n0 + n) * ldt + koff + k0 + 8 * c) = o; }
    LDS_WAIT(); asm volatile("" ::: "memory");
}
DI void rms_row_to_bf16(int lane, const float* xrow, const float* gain, bf16* orow) {
    const GAS f32x4* xr = (const GAS f32x4*)xrow + lane; const GAS f32x4* gr = (const GAS f32x4*)gain + lane;
    f32x4 v[4]; float s = 0.f;
#pragma unroll
    for (int j = 0; j < 4; ++j) { v[j] = xr[64 * j]; s += (v[j].x * v[j].x + v[j].y * v[j].y) + (v[j].z * v[j].z + v[j].w * v[j].w); }
    const float rinv = __builtin_amdgcn_rsqf(wave_sum(s) * (1.f / DMODEL) + EPS);
    GAS unsigned long long* o8 = (GAS unsigned long long*)orow + lane;
#pragma unroll
    for (int j = 0; j < 4; ++j) { const f32x4 g = gr[64 * j]; o8[64 * j] = (unsigned long long)pk2(v[j].x * rinv * g.x, v[j].y * rinv * g.y) | ((unsigned long long)pk2(v[j].z * rinv * g.z, v[j].w * rinv * g.w) << 32); }
}
DI void p0_peer_w_item(Frame& F, int it) {
    const float* peer_subkeys = inp(I_PEER_SK); const float* peer_wq = inp(I_PEER_WQ); const float* norm_ffn = inp(I_NORM_FFN);
    const int hp = it >> 4, k0 = (it & 15) * 64, tid = (F.wave * 64 + lane_id());
    LAS float* skL = (LAS float*)F.lds; LAS float* wqL = (LAS float*)(F.lds + 128 * 132 * 4);
    const float* sk = peer_subkeys + (size_t)hp * 16384;
#pragma unroll
    for (int i = 0; i < 8; ++i) { const int idx = i * 2048 + tid * 4; const f32x4 v = *(const f32x4*)(sk + idx); *(LAS f32x4*)(skL + (idx >> 7) * 132 + (idx & 127)) = v; }
#pragma unroll
    for (int i = 0; i < 4; ++i) { const int idx = i * 2048 + tid * 4; const int k = idx >> 7, c = idx & 127; const f32x4 v = *(const f32x4*)(peer_wq + (size_t)(k0 + k) * 2048 + hp * 128 + c); *(LAS f32x4*)(wqL + k * 132 + c) = v; }
    __syncthreads();
    const int k = tid & 63, n0 = (tid >> 6) * 16;
    float acc[16];
#pragma unroll
    for (int n = 0; n < 16; ++n) acc[n] = 0.f;
    for (int c4 = 0; c4 < 32; ++c4) { const f32x4 wv = *(const LAS f32x4*)(wqL + k * 132 + c4 * 4);
#pragma unroll
        for (int n = 0; n < 16; ++n) { const f32x4 sv = *(const LAS f32x4*)(skL + (n0 + n) * 132 + c4 * 4); acc[n] += (wv.x * sv.x + wv.y * sv.y) + (wv.z * sv.z + wv.w * sv.w); } }
    const float gffn = norm_ffn[k0 + k];
    bf16* WT = (bf16*)(F.ws + WS_WPEER);
#pragma unroll
    for (int n = 0; n < 16; ++n) WT[(size_t)(hp * 128 + n0 + n) * 1024 + k0 + k] = (bf16)f2bf(acc[n] * gffn);
    __syncthreads();
}
DI void p0_prologue(Frame& F) {
    { float* rope = (float*)(F.ws + WS_ROPE);
      for (int e = (int)blockIdx.x * (NWAVES * 64) + (F.wave * 64 + lane_id()); e < 1024; e += F.G * NWAVES * 64) { const int pos = e >> 4, fi = e & 15;
          const float ang = (float)pos * __builtin_powf(10000.0f, -(float)fi * (1.0f / 16.0f)); rope[2 * e] = cosf(ang); rope[2 * e + 1] = sinf(ang);
          ((float*)(F.ws + WS_GINV))[e] = 1.0f / inp(I_NORM_MIX)[e]; } }
    for (int it = blockIdx.x; it < 256; it += F.G) p0_peer_w_item(F, it);
    LAS float* scr = (LAS float*)(F.lds + F.wave * 16384);
    const int gw = F.vcu * NWAVES + F.wave, NGW = F.G * NWAVES;
    constexpr int I_IN = (1024 / 64) * (INW / 32), I_UA = (512 / 64) * (1024 / 32), I_OUT = (1024 / 64) * (1024 / 32), I_PP = (256 / 64) * (1024 / 32);
    constexpr int NITEMS = I_IN + 2 * I_UA + 2 * I_OUT + I_PP;
    for (int it = gw; it < NITEMS; it += NGW) {
        int r = it;
        if (r < I_IN) { p0_transpose_item(inp(I_W_IN), 1024, INW, (bf16*)(F.ws + WS_WIN), scr, r, lane_id()); continue; } r -= I_IN;
        if (r < I_UA) { p0_transpose_item(inp(I_W_UP_ATT), 512, 1024, (bf16*)(F.ws + WS_WUA), scr, r, lane_id(), nullptr, 1024, 0); continue; } r -= I_UA;
        if (r < I_UA) { p0_transpose_item(inp(I_W_UP_HG), 512, 1024, (bf16*)(F.ws + WS_WUA), scr, r, lane_id(), nullptr, 1024, 512); continue; } r -= I_UA;
        if (r < I_OUT) { p0_transpose_item(inp(I_W_OUT), 1024, 1024, (bf16*)(F.ws + WS_WOUT), scr, r, lane_id()); continue; } r -= I_OUT;
        if (r < I_OUT) { p0_transpose_item(inp(I_PLE_GATE), 1024, 1024, (bf16*)(F.ws + WS_WPG), scr, r, lane_id(), inp(I_NORM_PLE), 1280, 256); continue; } r -= I_OUT;
        p0_transpose_item(inp(I_PLE_PROJ), 256, 1024, (bf16*)(F.ws + WS_WPG), scr, r, lane_id(), nullptr, 1280, 0);
    }
    bf16* XN = (bf16*)(F.ws + WS_XN);
    const float* x = inp(I_X); const float* norm_mix = inp(I_NORM_MIX);
    {
        int lane_ = lane_id(); asm volatile("" : "+v"(lane_));
        const int lane = lane_;
        f32x4 gq[4], vn[4];
#pragma unroll
        for (int j = 0; j < 4; ++j) gq[j] = ((const GAS f32x4*)norm_mix)[lane + 64 * j];
        if (gw < T) {
#pragma unroll
            for (int j = 0; j < 4; ++j) vn[j] = ((const GAS f32x4*)(x + (size_t)gw * DMODEL))[lane + 64 * j]; }
        for (int m = gw; m < T; m += NGW) {
            f32x4 v[4];
#pragma unroll
            for (int j = 0; j < 4; ++j) v[j] = vn[j];
            if (m + NGW < T) {
#pragma unroll
                for (int j = 0; j < 4; ++j) vn[j] = ((const GAS f32x4*)(x + (size_t)(m + NGW) * DMODEL))[lane + 64 * j]; }
            float sq = 0.f;
#pragma unroll
            for (int j = 0; j < 4; ++j) sq += (v[j].x * v[j].x + v[j].y * v[j].y) + (v[j].z * v[j].z + v[j].w * v[j].w);
            const float rinv = __builtin_amdgcn_rsqf(wave_sum(sq) * (1.f / DMODEL) + EPS);
            if (lane == 0) ((float*)(F.ws + WS_RMS))[m] = 1.0f / rinv;
            GAS unsigned long long* o8 = (GAS unsigned long long*)(XN + (size_t)m * DMODEL) + lane;
#pragma unroll
            for (int j = 0; j < 4; ++j) o8[64 * j] = (unsigned long long)pk2(v[j].x * rinv * gq[j].x, v[j].y * rinv * gq[j].y) | ((unsigned long long)pk2(v[j].z * rinv * gq[j].z, v[j].w * rinv * gq[j].w) << 32);
        }
    }
}

DI void p1b_rope(Frame& F) {
    const int gw = F.vcu * NWAVES + F.wave, NGW = F.G * NWAVES, lane = lane_id();
    bf16* QKV = (bf16*)(F.ws + WS_QKV);
    const float gq = inp(I_Q_NORM)[lane], gk = inp(I_K_NORM)[lane];
    const int axis = lane >> 5, hf = (lane >> 4) & 1, fi = lane & 15;
    const float inv = __builtin_powf(10000.0f, -(float)fi * (1.0f / 16.0f));
    constexpr float C2 = 0.125f * 1.4426950408889634f;
    for (int m = gw; m < T; m += NGW) {
        const int t = m & (SEQ - 1); const float pos = (float)(axis ? (t & 63) : (t >> 6));
        const float ang = pos * inv; float sn, cs;
        sn = sinf(ang); cs = cosf(ang);
        bf16* row = QKV + (size_t)m * QKVW;
        float xv[10];
#pragma unroll
        for (int hh = 0; hh < 10; ++hh) xv[hh] = __uint_as_float((unsigned)row[hh * 64 + lane] << 16);
#pragma unroll
        for (int hh = 0; hh < 10; ++hh) {
            const float ss = wave_sum(xv[hh] * xv[hh]);
            const float y = xv[hh] * __builtin_amdgcn_rsqf(ss * (1.0f / 64.0f) + EPS) * (hh < 8 ? gq : gk);
            const float yp = __shfl_xor(y, 16);
            float o = hf ? (yp * sn + y * cs) : (y * cs - yp * sn);
            if (hh < 8) o *= C2;
            row[hh * 64 + lane] = (bf16)f2bf(o);
        }
    }
}
#define MFMA32(a, b, c) __builtin_amdgcn_mfma_f32_32x32x16_bf16((a), (b), (c), 0, 0, 0)
DI int crow16(int r, int hi) { return (r & 3) + 8 * (r >> 2) + 4 * hi; }
template <int CTRL, int RM> DI float dpp0(float x) { return __int_as_float(__builtin_amdgcn_update_dpp(0, __float_as_int(x), CTRL, RM, 0xf, false)); }
DI float wave_incl_scan(float x) {
    x += dpp0<0x111, 0xf>(x); x += dpp0<0x112, 0xf>(x); x += dpp0<0x114, 0xf>(x); x += dpp0<0x118, 0xf>(x);
    x += dpp0<0x142, 0xa>(x); x += dpp0<0x143, 0xc>(x);
    return x;
}
template <int K> DI void mma_tile(f32x16& acc, const LAS bf16* A, int lda, int m0, const LAS bf16* Bt, int ldb, int n0, int r32, int hi) {
    const LAS bf16* ap = A + (m0 + r32) * lda + 8 * hi; const LAS bf16* bp = Bt + (n0 + r32) * ldb + 8 * hi;
    bf16x8 a[K / 16], b[K / 16];
#pragma unroll
    for (int k = 0; k < K / 16; ++k) { a[k] = *(const LAS bf16x8*)(ap + 16 * k); b[k] = *(const LAS bf16x8*)(bp + 16 * k); }
    __builtin_amdgcn_sched_barrier(0);
#pragma unroll
    for (int k = 0; k < K / 16; ++k) acc = MFMA32(a[k], b[k], acc);
}
constexpr int HG_LDK = 136, HG_LDS_ = 72;
constexpr int HGO_QT = 0, HGO_KT = HGO_QT + 64 * HG_LDK * 2, HGO_QE = HGO_KT + 64 * HG_LDK * 2, HGO_KDT = HGO_QE + 64 * HG_LDK * 2, HGO_VT = HGO_KDT + 128 * HG_LDS_ * 2,
              HGO_AM = HGO_VT + 128 * HG_LDS_ * 2, HGO_ST = HGO_AM + 64 * HG_LDS_ * 2, HGO_DEC = HGO_ST + 128 * HG_LDK * 2, HGO_END = HGO_DEC + 512;
static_assert(HGO_END <= SCR_BYTES, "hgrn lds");
#ifndef HG_SKIP
#define HG_SKIP 0
#endif
#define LDS_BAR() asm volatile("s_waitcnt lgkmcnt(0)\n\ts_barrier" ::: "memory")
DI void hgrn_item(Frame& F, int item) {
    const int b = item >> 3, h = (item >> 1) & 3, dir = item & 1;
    int tid_ = F.wave * 64 + lane_id(); asm volatile("" : "+v"(tid_));
    const int tid = tid_, lane = tid & 63, w = __builtin_amdgcn_readfirstlane(tid >> 6), r32 = lane & 31, hi = lane >> 5;
    LAS bf16* QT = (LAS bf16*)(F.lds + HGO_QT); LAS bf16* KT = (LAS bf16*)(F.lds + HGO_KT); LAS bf16* QE = (LAS bf16*)(F.lds + HGO_QE);
    LAS bf16* KDT = (LAS bf16*)(F.lds + HGO_KDT); LAS bf16* VT = (LAS bf16*)(F.lds + HGO_VT); LAS bf16* AM = (LAS bf16*)(F.lds + HGO_AM);
    LAS bf16* ST = (LAS bf16*)(F.lds + HGO_ST); LAS float* DEC = (LAS float*)(F.lds + HGO_DEC);
    __syncthreads();
    for (int i = tid; i < (128 * HG_LDK * 2) / 16; i += NWAVES * 64) ((LAS v4u*)ST)[i] = (v4u){0u, 0u, 0u, 0u};
    for (int i = tid; i < (64 * HG_LDS_ * 2) / 16; i += NWAVES * 64) ((LAS v4u*)AM)[i] = (v4u){0u, 0u, 0u, 0u};
    const bf16* HGb = (const bf16*)(F.ws + WS_HG);
    bf16* OD = (bf16*)(F.ws + WS_HG) + 512 * (1 + dir);
    const int colq = h * 128, colf = 512 * (1 + dir) + h * 128, coli = 1536 + h * 128;
    f32x16 s0, s1;
#pragma unroll
    for (int i = 0; i < 16; ++i) { s0[i] = 0.f; s1[i] = 0.f; }
    const int pt0 = tid >> 4, pc8 = (tid & 15) * 8;
    v4u nq[2], nf[2], ni[2];
    { const int chunk = dir ? 63 : 0;
#pragma unroll
      for (int pp = 0; pp < 2; ++pp) { const int t = pt0 + 32 * pp; const size_t tok = (size_t)b * SEQ + chunk * 64 + (dir ? 63 - t : t); const bf16* row = HGb + tok * HGW + pc8;
          nq[pp] = *(const v4u*)(row + colq); nf[pp] = *(const v4u*)(row + colf); }
      { const size_t tok = (size_t)b * SEQ + chunk * 64 + (dir ? 63 - lane : lane); const bf16* row = HGb + tok * HGW + coli + 16 * w; ni[0] = *(const v4u*)row; ni[1] = *(const v4u*)(row + 8); } }
    const int tb = w & 1, eb = w >> 1, db = w & 3, eb2 = 2 * (w >> 2);
    for (int step = 0; step < 64; ++step) {
        const int chunk = dir ? 63 - step : step;
        const size_t tok0 = (size_t)b * SEQ + chunk * 64;
#pragma unroll
        for (int pp = 0; pp < 2; ++pp) { const int t = pt0 + 32 * pp;
            *(LAS v4u*)(QT + t * HG_LDK + pc8) = nq[pp]; *(LAS v4u*)(KT + t * HG_LDK + pc8) = nf[pp]; }
        { const unsigned va[8] = {ni[0].x, ni[0].y, ni[0].z, ni[0].w, ni[1].x, ni[1].y, ni[1].z, ni[1].w};
#pragma unroll
          for (int j = 0; j < 8; ++j) { VT[(16 * w + 2 * j) * HG_LDS_ + lane] = (bf16)(va[j] & 0xffffu); VT[(16 * w + 2 * j + 1) * HG_LDS_ + lane] = (bf16)(va[j] >> 16); } }
        if (step + 1 < 64 && !(HG_SKIP & 16)) { const int nchunk = dir ? 62 - step : step + 1;
#pragma unroll
            for (int pp = 0; pp < 2; ++pp) { const int t = pt0 + 32 * pp; const size_t tok = (size_t)b * SEQ + nchunk * 64 + (dir ? 63 - t : t); const bf16* row = HGb + tok * HGW + pc8;
                nq[pp] = *(const v4u*)(row + colq); nf[pp] = *(const v4u*)(row + colf); }
            { const size_t tok = (size_t)b * SEQ + nchunk * 64 + (dir ? 63 - lane : lane); const bf16* row = HGb + tok * HGW + coli + 16 * w; ni[0] = *(const v4u*)row; ni[1] = *(const v4u*)(row + 8); } }
        LDS_BAR();
        const v4u cq0 = *(const LAS v4u*)(QT + lane * HG_LDK + 16 * w), cq1 = *(const LAS v4u*)(QT + lane * HG_LDK + 16 * w + 8);
        const v4u cf0 = *(const LAS v4u*)(KT + lane * HG_LDK + 16 * w), cf1 = *(const LAS v4u*)(KT + lane * HG_LDK + 16 * w + 8);
        if (!(HG_SKIP & 1)) {
            const unsigned qa[8] = {cq0.x, cq0.y, cq0.z, cq0.w, cq1.x, cq1.y, cq1.z, cq1.w};
            const unsigned fa[8] = {cf0.x, cf0.y, cf0.z, cf0.w, cf1.x, cf1.y, cf1.z, cf1.w};
            float qt[16], kt[16], qe[16], kd[16];
            {
                float bc[16], kk[16];
#pragma unroll
                for (int j = 0; j < 16; ++j) { bc[j] = (j & 1) ? bfhi(fa[j >> 1]) : bflo(fa[j >> 1]); kk[j] = 1.0f - __builtin_amdgcn_exp2f(bc[j]); }
#pragma unroll
                for (int j = 0; j < 16; ++j) bc[j] += dpp0<0x111, 0xf>(bc[j]);
#pragma unroll
                for (int j = 0; j < 16; ++j) bc[j] += dpp0<0x112, 0xf>(bc[j]);
#pragma unroll
                for (int j = 0; j < 16; ++j) bc[j] += dpp0<0x114, 0xf>(bc[j]);
#pragma unroll
                for (int j = 0; j < 16; ++j) bc[j] += dpp0<0x118, 0xf>(bc[j]);
#pragma unroll
                for (int j = 0; j < 16; ++j) bc[j] += dpp0<0x142, 0xa>(bc[j]);
#pragma unroll
                for (int j = 0; j < 16; ++j) bc[j] += dpp0<0x143, 0xc>(bc[j]);
#pragma unroll
                for (int j = 0; j < 16; ++j) {
                    const float q = (j & 1) ? bfhi(qa[j >> 1]) : bflo(qa[j >> 1]);
                    const float E = __builtin_amdgcn_exp2f(bc[j]), R = __builtin_amdgcn_exp2f(-bc[j]);
                    const float E31 = __int_as_float(__builtin_amdgcn_readlane(__float_as_int(E), 31));
                    const float E63 = __int_as_float(__builtin_amdgcn_readlane(__float_as_int(E), 63));
                    const float R31 = __int_as_float(__builtin_amdgcn_readlane(__float_as_int(R), 31));
                    const float kR = kk[j] * R;
                    qe[j] = q * E; qt[j] = qe[j] * R31; kt[j] = kR * E31; kd[j] = kR * E63;
                    if (lane == 63) DEC[16 * w + j] = E63;
                }
            }
            v4u o;
            o = (v4u){pk2(qt[0], qt[1]), pk2(qt[2], qt[3]), pk2(qt[4], qt[5]), pk2(qt[6], qt[7])}; *(LAS v4u*)(QT + lane * HG_LDK + 16 * w) = o;
            o = (v4u){pk2(qt[8], qt[9]), pk2(qt[10], qt[11]), pk2(qt[12], qt[13]), pk2(qt[14], qt[15])}; *(LAS v4u*)(QT + lane * HG_LDK + 16 * w + 8) = o;
            o = (v4u){pk2(kt[0], kt[1]), pk2(kt[2], kt[3]), pk2(kt[4], kt[5]), pk2(kt[6], kt[7])}; *(LAS v4u*)(KT + lane * HG_LDK + 16 * w) = o;
            o = (v4u){pk2(kt[8], kt[9]), pk2(kt[10], kt[11]), pk2(kt[12], kt[13]), pk2(kt[14], kt[15])}; *(LAS v4u*)(KT + lane * HG_LDK + 16 * w + 8) = o;
            o = (v4u){pk2(qe[0], qe[1]), pk2(qe[2], qe[3]), pk2(qe[4], qe[5]), pk2(qe[6], qe[7])}; *(LAS v4u*)(QE + lane * HG_LDK + 16 * w) = o;
            o = (v4u){pk2(qe[8], qe[9]), pk2(qe[10], qe[11]), pk2(qe[12], qe[13]), pk2(qe[14], qe[15])}; *(LAS v4u*)(QE + lane * HG_LDK + 16 * w + 8) = o;
#pragma unroll
            for (int j = 0; j < 16; j += 2) { const unsigned kp = pk2(kd[j], kd[j + 1]);
                KDT[(16 * w + j) * HG_LDS_ + lane] = (bf16)(kp & 0xffffu); KDT[(16 * w + j + 1) * HG_LDS_ + lane] = (bf16)(kp >> 16);
            }
        }
        LDS_BAR();
        f32x16 o;
#pragma unroll
        for (int i = 0; i < 16; ++i) o[i] = 0.f;
        if (!(HG_SKIP & 2)) mma_tile<128>(o, QE, HG_LDK, tb * 32, ST, HG_LDK, eb * 32, r32, hi);
        if (w < 3 && !(HG_SKIP & 2)) {
            const int ti = (w == 0) ? 0 : 1, sj = (w == 2) ? 1 : 0;
            f32x16 a;
#pragma unroll
            for (int i = 0; i < 16; ++i) a[i] = 0.f;
            mma_tile<128>(a, QT, HG_LDK, ti * 32, KT, HG_LDK, sj * 32, r32, hi);
#pragma unroll
            for (int i = 0; i < 16; i += 2) { const int tl = crow16(i, hi); float v0 = a[i], v1 = a[i + 1]; if (ti == sj && r32 > tl) v0 = 0.f; if (ti == sj && r32 > tl + 1) v1 = 0.f; const unsigned pp = pk2(v0, v1);
                AM[(ti * 32 + tl) * HG_LDS_ + sj * 32 + r32] = (bf16)(pp & 0xffffu); AM[(ti * 32 + tl + 1) * HG_LDS_ + sj * 32 + r32] = (bf16)(pp >> 16); }
        }
        LDS_BAR();
        if (!(HG_SKIP & 4)) { if (tb) mma_tile<64>(o, AM, HG_LDS_, 32, VT, HG_LDS_, eb * 32, r32, hi); else mma_tile<32>(o, AM, HG_LDS_, 0, VT, HG_LDS_, eb * 32, r32, hi); }
        if (!(HG_SKIP & 8))
#pragma unroll
        for (int i = 0; i < 16; i += 2) { const int tl = tb * 32 + crow16(i, hi); const size_t tokA = tok0 + (dir ? 63 - tl : tl), tokB = tok0 + (dir ? 62 - tl : tl + 1); const unsigned pp = pk2(o[i], o[i + 1]);
            OD[tokA * HGW + h * 128 + eb * 32 + r32] = (bf16)(pp & 0xffffu); OD[tokB * HGW + h * 128 + eb * 32 + r32] = (bf16)(pp >> 16); }
        if (!(HG_SKIP & 4)) {
            float dc[16];
#pragma unroll
            for (int i = 0; i < 16; ++i) dc[i] = DEC[db * 32 + crow16(i, hi)];
#pragma unroll
            for (int i = 0; i < 16; ++i) { s0[i] *= dc[i]; s1[i] *= dc[i]; }
            mma_tile<64>(s0, KDT, HG_LDS_, db * 32, VT, HG_LDS_, eb2 * 32, r32, hi);
            mma_tile<64>(s1, KDT, HG_LDS_, db * 32, VT, HG_LDS_, (eb2 + 1) * 32, r32, hi);
#pragma unroll
            for (int g4 = 0; g4 < 4; ++g4) {
                v2u p0 = {pk2(s0[4 * g4], s0[4 * g4 + 1]), pk2(s0[4 * g4 + 2], s0[4 * g4 + 3])}; *(LAS v2u*)(ST + (eb2 * 32 + r32) * HG_LDK + db * 32 + 8 * g4 + 4 * hi) = p0;
                v2u p1 = {pk2(s1[4 * g4], s1[4 * g4 + 1]), pk2(s1[4 * g4 + 2], s1[4 * g4 + 3])}; *(LAS v2u*)(ST + ((eb2 + 1) * 32 + r32) * HG_LDK + db * 32 + 8 * g4 + 4 * hi) = p1;
            }
        }
        LDS_BAR();
    }
}

DI void p2b_ohn(Frame& F, bf16* AO) {
    int lane_ = lane_id(); asm volatile("" : "+v"(lane_));
    const int gw = F.vcu * NWAVES + F.wave, NGW = F.G * NWAVES, lane = lane_;
    bf16* HGb = (bf16*)(F.ws + WS_HG);
    float gn[8];
#pragma unroll
    for (int j = 0; j < 8; ++j) gn[j] = inp(I_HG_ONORM)[(8 * lane + j) & 127];
    for (int m = gw; m < T; m += NGW) {
        const v4u a = *(const v4u*)(HGb + (size_t)m * HGW + 512 + 8 * lane), bb = *(const v4u*)(HGb + (size_t)m * HGW + 1024 + 8 * lane), gg = *(const v4u*)(HGb + (size_t)m * HGW + 2048 + 8 * lane);
        const unsigned aa[4] = {a.x, a.y, a.z, a.w}, ba[4] = {bb.x, bb.y, bb.z, bb.w}, ga[4] = {gg.x, gg.y, gg.z, gg.w};
        float v[8]; float ss = 0.f;
#pragma unroll
        for (int j = 0; j < 4; ++j) { v[2 * j] = bflo(aa[j]) + bflo(ba[j]); v[2 * j + 1] = bfhi(aa[j]) + bfhi(ba[j]); ss += v[2 * j] * v[2 * j] + v[2 * j + 1] * v[2 * j + 1]; }
        ss += __shfl_xor(ss, 1); ss += __shfl_xor(ss, 2); ss += __shfl_xor(ss, 4); ss += __shfl_xor(ss, 8);
        const float rinv = __builtin_amdgcn_rsqf(ss * (1.0f / 128.0f) + EPS);
        float o[8];
#pragma unroll
        for (int j = 0; j < 8; ++j) { const float hg = (j & 1) ? bfhi(ga[j >> 1]) : bflo(ga[j >> 1]); o[j] = v[j] * rinv * gn[j] * hg; }
        *(v4u*)(AO + (size_t)m * 1024 + 512 + 8 * lane) = (v4u){pk2(o[0], o[1]), pk2(o[2], o[3]), pk2(o[4], o[5]), pk2(o[6], o[7])};
    }
}

DI void cvt_f32_bf16(Frame& F, const float* src, bf16* dst, size_t g_lo, size_t g_hi) {
    for (size_t i = g_lo + (F.wave * 64 + lane_id()); i < g_hi; i += NWAVES * 64) { const f32x4 a = *(const f32x4*)(src + i * 8), b = *(const f32x4*)(src + i * 8 + 4);
        *(v4u*)(dst + i * 8) = (v4u){pk2(a.x, a.y), pk2(a.z, a.w), pk2(b.x, b.y), pk2(b.z, b.w)}; }
}

DI void cvt_p_rows(Frame& F, const float* p, bf16* aple, int r0, int r1) {
    const int tid = F.wave * 64 + lane_id();
    for (int r = r0 + (tid >> 5); r < r1; r += (NWAVES * 64) >> 5) { const int c = (tid & 31) * 8; const f32x4 a = *(const f32x4*)(p + (size_t)r * PLED + c), b = *(const f32x4*)(p + (size_t)r * PLED + c + 4);
        *(v4u*)(aple + (size_t)r * 1280 + c) = (v4u){pk2(a.x, a.y), pk2(a.z, a.w), pk2(b.x, b.y), pk2(b.z, b.w)}; }
}
template <bool SLICED> DI void cvt_rows_fp8(Frame& F, const float* src, unsigned char* dst8, float* scale2, int which, int e0, int e1) {
    int lane_ = lane_id(); asm volatile("" : "+v"(lane_));
    const int lane = lane_;
    for (int e = e0 + F.wave; e < e1; e += NWAVES) {
        const float* r = src + (size_t)e * DMODEL + 16 * lane;
        const f32x4 a = *(const f32x4*)r, b = *(const f32x4*)(r + 4), c = *(const f32x4*)(r + 8), d = *(const f32x4*)(r + 12);
        float m = fmaxf(fmaxf(fmaxf(fabsf(a.x), fabsf(a.y)), fmaxf(fabsf(a.z), fabsf(a.w))), fmaxf(fmaxf(fabsf(b.x), fabsf(b.y)), fmaxf(fabsf(b.z), fabsf(b.w))));
        m = fmaxf(m, fmaxf(fmaxf(fmaxf(fabsf(c.x), fabsf(c.y)), fmaxf(fabsf(c.z), fabsf(c.w))), fmaxf(fmaxf(fabsf(d.x), fabsf(d.y)), fmaxf(fabsf(d.z), fabsf(d.w)))));
#pragma unroll
        for (int o = 1; o < 64; o <<= 1) m = fmaxf(m, __shfl_xor(m, o));
        const float sc = m > 0.f ? m * (1.0f / 256.0f) : 1.0f, inv = 1.0f / sc;
        v4u w;
        { int t = 0; t = __builtin_amdgcn_cvt_pk_fp8_f32(a.x * inv, a.y * inv, t, false); t = __builtin_amdgcn_cvt_pk_fp8_f32(a.z * inv, a.w * inv, t, true); w.x = (unsigned)t; }
        { int t = 0; t = __builtin_amdgcn_cvt_pk_fp8_f32(b.x * inv, b.y * inv, t, false); t = __builtin_amdgcn_cvt_pk_fp8_f32(b.z * inv, b.w * inv, t, true); w.y = (unsigned)t; }
        { int t = 0; t = __builtin_amdgcn_cvt_pk_fp8_f32(c.x * inv, c.y * inv, t, false); t = __builtin_amdgcn_cvt_pk_fp8_f32(c.z * inv, c.w * inv, t, true); w.z = (unsigned)t; }
        { int t = 0; t = __builtin_amdgcn_cvt_pk_fp8_f32(d.x * inv, d.y * inv, t, false); t = __builtin_amdgcn_cvt_pk_fp8_f32(d.z * inv, d.w * inv, t, true); w.w = (unsigned)t; }
        if (SLICED) *(v4u*)(dst8 + ((size_t)(lane >> 3) * NEXP + e) * 128 + (lane & 7) * 16) = w;
        else *(v4u*)(dst8 + (size_t)e * DMODEL + 16 * lane) = w;
        if (lane == 0) scale2[2 * e + which] = sc;
    }
}
DI void cvt_rows_i8(Frame& F, const float* src, unsigned char* dst8, float* scale2, int which, int e0, int e1) {
    int lane_ = lane_id(); asm volatile("" : "+v"(lane_));
    const int lane = lane_;
    for (int e = e0 + F.wave; e < e1; e += NWAVES) {
        const float* r = src + (size_t)e * DMODEL + 16 * lane;
        const f32x4 a = *(const f32x4*)r, b = *(const f32x4*)(r + 4), c = *(const f32x4*)(r + 8), d = *(const f32x4*)(r + 12);
        float m = fmaxf(fmaxf(fmaxf(fabsf(a.x), fabsf(a.y)), fmaxf(fabsf(a.z), fabsf(a.w))), fmaxf(fmaxf(fabsf(b.x), fabsf(b.y)), fmaxf(fabsf(b.z), fabsf(b.w))));
        m = fmaxf(m, fmaxf(fmaxf(fmaxf(fabsf(c.x), fabsf(c.y)), fmaxf(fabsf(c.z), fabsf(c.w))), fmaxf(fmaxf(fabsf(d.x), fabsf(d.y)), fmaxf(fabsf(d.z), fabsf(d.w)))));
#pragma unroll
        for (int o = 1; o < 64; o <<= 1) m = fmaxf(m, __shfl_xor(m, o));
        const float sc = m > 0.f ? m * (1.0f / 127.0f) : 1.0f, inv = 1.0f / sc;
#define PK4I8(v) ((unsigned)((int)__builtin_rintf((v).x * inv) & 0xff) | ((unsigned)((int)__builtin_rintf((v).y * inv) & 0xff) << 8) | ((unsigned)((int)__builtin_rintf((v).z * inv) & 0xff) << 16) | ((unsigned)((int)__builtin_rintf((v).w * inv) & 0xff) << 24))
        const v4u w = {PK4I8(a), PK4I8(b), PK4I8(c), PK4I8(d)};
#undef PK4I8
        *(v4u*)(dst8 + (size_t)e * DMODEL + 16 * lane) = w;
        if (lane == 0) scale2[2 * e + which] = sc;
    }
}
DI void cvt_rows_fp4(Frame& F, const float* src, unsigned char* dst4, float* scale2, int which, int e0, int e1) {
    int lane_ = lane_id(); asm volatile("" : "+v"(lane_));
    const int lane = lane_;
    for (int e = e0 + F.wave; e < e1; e += NWAVES) {
        const float* r = src + (size_t)e * DMODEL + 16 * lane;
        const f32x4 a = *(const f32x4*)r, b = *(const f32x4*)(r + 4), c = *(const f32x4*)(r + 8), d = *(const f32x4*)(r + 12);
        float ss = a.x * a.x + a.y * a.y + a.z * a.z + a.w * a.w + b.x * b.x + b.y * b.y + b.z * b.z + b.w * b.w + c.x * c.x + c.y * c.y + c.z * c.z + c.w * c.w + d.x * d.x + d.y * d.y + d.z * d.z + d.w * d.w;
#pragma unroll
        for (int o = 1; o < 64; o <<= 1) ss += __shfl_xor(ss, o);
        const float sc = ss > 0.f ? 0.5f * __builtin_sqrtf(ss * (1.0f / 1024.0f)) : 1.0f, inv = 1.0f / sc;
        const float xs[16] = {a.x, a.y, a.z, a.w, b.x, b.y, b.z, b.w, c.x, c.y, c.z, c.w, d.x, d.y, d.z, d.w};
        unsigned w[2] = {0u, 0u};
#pragma unroll
        for (int k = 0; k < 16; ++k) { const float m = fabsf(xs[k]) * inv;
            const unsigned code = (m > 0.25f ? 1u : 0u) + (m > 0.75f ? 1u : 0u) + (m > 1.25f ? 1u : 0u) + (m > 1.75f ? 1u : 0u) + (m > 2.5f ? 1u : 0u) + (m > 3.5f ? 1u : 0u) + (m > 5.0f ? 1u : 0u);
            w[k >> 3] |= (code | (xs[k] < 0.f ? 8u : 0u)) << (4 * (k & 7)); }
        *(v2u*)(dst4 + ((size_t)(lane >> 4) * NEXP + e) * 128 + 8 * (lane & 15)) = (v2u){w[0], w[1]};
        if (lane == 0) scale2[2 * e + which] = sc;
    }
}
DI void cvt_rows_i4(Frame& F, const float* src, unsigned char* dst4, float* scale2, int which, int e0, int e1) {
    int lane_ = lane_id(); asm volatile("" : "+v"(lane_));
    const int lane = lane_;
    for (int e = e0 + F.wave; e < e1; e += NWAVES) {
        const float* r = src + (size_t)e * DMODEL + 16 * lane;
        const f32x4 a = *(const f32x4*)r, b = *(const f32x4*)(r + 4), c = *(const f32x4*)(r + 8), d = *(const f32x4*)(r + 12);
        float ss = a.x * a.x + a.y * a.y + a.z * a.z + a.w * a.w + b.x * b.x + b.y * b.y + b.z * b.z + b.w * b.w + c.x * c.x + c.y * c.y + c.z * c.z + c.w * c.w + d.x * d.x + d.y * d.y + d.z * d.z + d.w * d.w;
#pragma unroll
        for (int o = 1; o < 64; o <<= 1) ss += __shfl_xor(ss, o);
        const float sc = ss > 0.f ? 0.355f * __builtin_sqrtf(ss * (1.0f / 1024.0f)) : 1.0f, inv = 1.0f / sc;
#define Q4(v) ((unsigned)((int)fminf(fmaxf(__builtin_rintf((v) * inv), -7.0f), 7.0f)) & 0xfu)
        const v2u w = {Q4(a.x) | (Q4(a.y) << 4) | (Q4(a.z) << 8) | (Q4(a.w) << 12) | (Q4(b.x) << 16) | (Q4(b.y) << 20) | (Q4(b.z) << 24) | (Q4(b.w) << 28),
                       Q4(c.x) | (Q4(c.y) << 4) | (Q4(c.z) << 8) | (Q4(c.w) << 12) | (Q4(d.x) << 16) | (Q4(d.y) << 20) | (Q4(d.z) << 24) | (Q4(d.w) << 28)};
#undef Q4
        *(v2u*)(dst4 + (size_t)e * 512 + 8 * lane) = w;
        if (lane == 0) scale2[2 * e + which] = sc;
    }
}
struct XcdPart { int v, nx, li, nloc; };
DI float gelu_tanh(float a) { const float u = 0.7978845608028654f * (a + 0.044715f * a * a * a); const float e = __builtin_amdgcn_exp2f(2.0f * 1.4426950408889634f * u); const float th = 1.0f - 2.0f * __builtin_amdgcn_rcpf(e + 1.0f); return 0.5f * a * (1.0f + th); }
typedef float f32x2_ __attribute__((ext_vector_type(2)));
DI void dq16(const v4u& w, float (&o)[16]) {
    const unsigned a[4] = {w.x, w.y, w.z, w.w};
#pragma unroll
    for (int j = 0; j < 4; ++j) { const f32x2_ lo = __builtin_amdgcn_cvt_pk_f32_fp8((int)a[j], false), hi = __builtin_amdgcn_cvt_pk_f32_fp8((int)a[j], true); o[4 * j] = lo.x; o[4 * j + 1] = lo.y; o[4 * j + 2] = hi.x; o[4 * j + 3] = hi.y; }
}
DI void p5_quant_h(Frame& F) {
    int lane_ = lane_id(); asm volatile("" : "+v"(lane_));
    const int gw = F.vcu * NWAVES + F.wave, NGW = F.G * NWAVES, lane = lane_;
    const bf16* X1B = (const bf16*)(F.ws + WS_X1B); const float* rowss = (const float*)(F.ws + WS_CTL) + CW_ROWSS;
    unsigned char* H8 = (unsigned char*)(F.ws + WS_H8); float* TSC = (float*)(F.ws + WS_TSC);
    float gn[16];
    { const float* nf = inp(I_NORM_FFN) + 16 * lane;
#pragma unroll
      for (int d = 0; d < 16; ++d) gn[d] = nf[d]; }
    for (int m = gw; m < T; m += NGW) {
        const v4u xa = *(const v4u*)(X1B + (size_t)m * DMODEL + 16 * lane), xb = *(const v4u*)(X1B + (size_t)m * DMODEL + 16 * lane + 8);
        const unsigned xw_[8] = {xa.x, xa.y, xa.z, xa.w, xb.x, xb.y, xb.z, xb.w};
        float hv[16]; float mx = 0.f;
#pragma unroll
        for (int d = 0; d < 8; ++d) { hv[2 * d] = bflo(xw_[d]) * gn[2 * d]; hv[2 * d + 1] = bfhi(xw_[d]) * gn[2 * d + 1]; mx = fmaxf(mx, fmaxf(fabsf(hv[2 * d]), fabsf(hv[2 * d + 1]))); }
#pragma unroll
        for (int o = 1; o < 64; o <<= 1) mx = fmaxf(mx, __shfl_xor(mx, o));
        const float qs = mx > 0.f ? 119.0f / mx : 0.f;
        unsigned pa[2] = {0u, 0u}, pb[2] = {0u, 0u};
#pragma unroll
        for (int d = 0; d < 16; ++d) { const int h = (int)__builtin_rintf(hv[d] * qs); const int a = (h + 8) >> 4, b = h - 16 * a;
            pa[d >> 3] |= ((unsigned)a & 0xfu) << (4 * (d & 7)); pb[d >> 3] |= ((unsigned)b & 0xfu) << (4 * (d & 7)); }
        *(v2u*)(H8 + (size_t)m * DMODEL + 8 * lane) = (v2u){pa[0], pa[1]};
        *(v2u*)(H8 + (size_t)m * DMODEL + 512 + 8 * lane) = (v2u){pb[0], pb[1]};
        if (lane == 0) TSC[m] = (mx > 0.f ? mx * (1.0f / 119.0f) : 0.f) * __builtin_amdgcn_rsqf(rowss[m] * (1.0f / 1024.0f) + EPS);
    }
}
#ifndef P6_SKIP
#define P6_SKIP 0
#endif
template <int CTRL> DI int dppi0(int x) { return __builtin_amdgcn_update_dpp(0, x, CTRL, 0xf, 0xf, false); }
typedef float f32x2v __attribute__((ext_vector_type(2)));
constexpr int P6A_HSTR = 1024 + 64;
constexpr int P6A_WBYTES = 4096 + 2048 + 4 * P6A_HSTR;
static_assert(8 * P6A_WBYTES <= SCR_BYTES, "p6a lds");
DI void p6a_dots(Frame& F, const XcdPart P) {
    int lane_ = lane_id(); asm volatile("" : "+v"(lane_));
    const int lane = lane_, q = lane >> 4, i = lane & 15, q8 = lane >> 3; const unsigned i16 = 16u * (unsigned)(lane & 7);
    const unsigned char* UB8 = (const unsigned char*)(F.ws + WS_UB8); const f32x2_* US2 = (const f32x2_*)(F.ws + WS_US);
    const unsigned short* IDX = (const unsigned short*)(F.ws + WS_IDX); const float* GWp = (const float*)(F.ws + WS_GW); bf16* Wp = (bf16*)(F.ws + WS_W);
    const unsigned char* H8 = (const unsigned char*)(F.ws + WS_H8); const float* TSC = (const float*)(F.ws + WS_TSC);
    LAS unsigned char* wb = F.lds + F.wave * P6A_WBYTES;
    LAS v2u* list = (LAS v2u*)wb;
    LAS float* res = (LAS float*)(wb + 4096);
    LAS unsigned char* hb = wb + 4096 + 2048;
    const int wrank = P.li * NWAVES + F.wave, wstride = P.nloc * NWAVES;
    for (int s_ = P.v; s_ < 8; s_ += P.nx) {
        const int s = s_ & 3, tlo = (s_ >> 2) * (T / 2), thi = tlo + T / 2;
        v4u ean;
        if (tlo + wrank * 4 < thi) ean = *(const v4u*)(IDX + (size_t)(tlo + wrank * 4 + q) * 128 + 8 * i);
        for (int m0 = tlo + wrank * 4; m0 < thi; m0 += wstride * 4) {
            const int tok = m0 + q;
            const v4u ea = ean;
            if (m0 + wstride * 4 < thi) ean = *(const v4u*)(IDX + (size_t)(tok + wstride * 4) * 128 + 8 * i);
            v4u hv[4];
#pragma unroll
            for (int j = 0; j < 4; ++j) hv[j] = *(const v4u*)(H8 + (size_t)tok * DMODEL + 256 * j + 16 * i);
            const unsigned ev[8] = {ea.x & 0xffffu, ea.x >> 16, ea.y & 0xffffu, ea.y >> 16, ea.z & 0xffffu, ea.z >> 16, ea.w & 0xffffu, ea.w >> 16};
            int cnt = 0;
#pragma unroll
            for (int j = 0; j < 8; ++j) cnt += ((int)(ev[j] >> 12) == s) ? 1 : 0;
            int pre = cnt;
            pre += dppi0<0x111>(pre); pre += dppi0<0x112>(pre); pre += dppi0<0x114>(pre); pre += dppi0<0x118>(pre);
            const int n0 = __builtin_amdgcn_readlane(pre, 15), n1 = __builtin_amdgcn_readlane(pre, 31), n2 = __builtin_amdgcn_readlane(pre, 47), n3 = __builtin_amdgcn_readlane(pre, 63);
            const int p0 = (n0 + 1) & ~1, p1 = (n1 + 1) & ~1, p2 = (n2 + 1) & ~1, p3 = (n3 + 1) & ~1;
            const int ntot = p0 + p1 + p2 + p3;
            const int offq = (q > 0 ? p0 : 0) + (q > 1 ? p1 : 0) + (q > 2 ? p2 : 0), nq = q == 0 ? n0 : q == 1 ? n1 : q == 2 ? n2 : n3;
            int pos = pre - cnt + offq; unsigned fe = 0u;
#pragma unroll
            for (int j = 0; j < 8; ++j) if ((int)(ev[j] >> 12) == s) { list[pos] = (v2u){ev[j], (unsigned)(8 * i + j) | ((unsigned)q << 8)}; fe = ev[j]; ++pos; }
            if ((nq & 1) && cnt > 0) list[offq + nq] = (v2u){fe, 0x80000000u | ((unsigned)q << 8)};
#pragma unroll
            for (int j = 0; j < 4; ++j) *(LAS v4u*)(hb + q * P6A_HSTR + 256 * j + 16 * i) = hv[j];
            f32x2_ fsc = {0.f, 0.f}, fsc1 = {0.f, 0.f}; float fg = 0.f, ftsc = 0.f, fg1 = 0.f, ftsc1 = 0.f; size_t fo = 0, fo1 = 0; bool fv = false, fv1 = false;
            if (lane < ntot) { const v2u ek = list[lane]; fv = !(ek.y >> 31); const int tq = (int)(ek.y >> 8) & 3; fo = (size_t)(m0 + tq) * 128 + (ek.y & 255u); if (fv) { fsc = US2[ek.x]; fg = GWp[fo]; ftsc = TSC[m0 + tq]; } }
            if (lane + 64 < ntot) { const v2u ek = list[lane + 64]; fv1 = !(ek.y >> 31); const int tq = (int)(ek.y >> 8) & 3; fo1 = (size_t)(m0 + tq) * 128 + (ek.y & 255u); if (fv1) { fsc1 = US2[ek.x]; fg1 = GWp[fo1]; ftsc1 = TSC[m0 + tq]; } }
#define P6A_LOAD(U, TQ, base_) do { _Pragma("unroll") for (int st = 0; st < 2; ++st) if ((base_) + 16 * st < ntot) { const int slot = (base_) + 16 * st + 2 * q8; const int sl = slot < ntot ? slot : ntot - 2; \
                    const v4u ek2 = *(const LAS v4u*)(list + sl); TQ[st] = (int)(ek2.y >> 8) & 3; \
                    const unsigned ro0 = (ek2.x << 9) | i16, ro1 = (ek2.z << 9) | i16; \
                    _Pragma("unroll") for (int j = 0; j < 4; ++j) { U[st][0][j] = *(const v4u*)(UB8 + (ro0 + 128u * j)); U[st][1][j] = *(const v4u*)(UB8 + (ro1 + 128u * j)); } } } while (0)
#define P6A_DOT4(acc_, uu, hh) do { acc_ = __builtin_amdgcn_sdot8((int)(uu).x, (int)(hh).x, acc_, false); acc_ = __builtin_amdgcn_sdot8((int)(uu).y, (int)(hh).y, acc_, false); \
                    acc_ = __builtin_amdgcn_sdot8((int)(uu).z, (int)(hh).z, acc_, false); acc_ = __builtin_amdgcn_sdot8((int)(uu).w, (int)(hh).w, acc_, false); } while (0)
#define P6A_COMP(U, TQ, base_) do { _Pragma("unroll") for (int st = 0; st < 2; ++st) if ((base_) + 16 * st < ntot) { const LAS unsigned char* hp_ = hb + TQ[st] * P6A_HSTR + i16; \
                    v4u ha[4], hb4[4]; _Pragma("unroll") for (int j = 0; j < 4; ++j) { ha[j] = *(const LAS v4u*)(hp_ + 128 * j); hb4[j] = *(const LAS v4u*)(hp_ + 512 + 128 * j); } \
                    __builtin_amdgcn_sched_barrier(0);        \
                    int isa0 = 0, isb0 = 0, isa1 = 0, isb1 = 0; \
                    _Pragma("unroll") for (int j = 0; j < 4; ++j) { P6A_DOT4(isa0, U[st][0][j], ha[j]); P6A_DOT4(isb0, U[st][0][j], hb4[j]); P6A_DOT4(isa1, U[st][1][j], ha[j]); P6A_DOT4(isb1, U[st][1][j], hb4[j]); } \
                    int is0 = 16 * isa0 + isb0, is1 = 16 * isa1 + isb1; \
                    is0 += dppi0<0x111>(is0); is1 += dppi0<0x111>(is1); is0 += dppi0<0x112>(is0); is1 += dppi0<0x112>(is1); is0 += dppi0<0x114>(is0); is1 += dppi0<0x114>(is1); \
                    if ((lane & 7) == 7 && (base_) + 16 * st + 2 * q8 < ntot) *(LAS f32x2_*)(res + (base_) + 16 * st + 2 * q8) = (f32x2_){(float)is0, (float)is1}; } } while (0)
            v4u UA[2][2][4], UB[2][2][4]; int TA[2], TB[2];
            if (ntot > 0) P6A_LOAD(UA, TA, 0);
            if (ntot > 32) P6A_LOAD(UB, TB, 32);
            for (int base = 0; base < ntot; base += 64) {
                if (base > 0 && base + 32 < ntot) P6A_LOAD(UB, TB, base + 32);
                P6A_COMP(UA, TA, base);
                if (base + 64 < ntot) P6A_LOAD(UA, TA, base + 64);
                if (base + 32 < ntot) P6A_COMP(UB, TB, base + 32);
            }
#undef P6A_LOAD
#undef P6A_COMP
#undef P6A_DOT4
            if (fv) Wp[fo] = (bf16)f2bf(gelu_tanh(res[lane] * ftsc * fsc.x) * fg * fsc.y);
            if (fv1) Wp[fo1] = (bf16)f2bf(gelu_tanh(res[lane + 64] * ftsc1 * fsc1.x) * fg1 * fsc1.y);
            for (int idx = 128 + lane; idx < ntot; idx += 64) { const v2u ek = list[idx]; if (ek.y >> 31) continue; const f32x2_ sc = US2[ek.x]; const int tq = (int)(ek.y >> 8) & 3; const size_t o = (size_t)(m0 + tq) * 128 + (ek.y & 255u);
                Wp[o] = (bf16)f2bf(gelu_tanh(res[idx] * TSC[m0 + tq] * sc.x) * GWp[o] * sc.y); }
        }
    }
}
constexpr int P6B_RSTR = 160;
static_assert(8 * 64 * P6B_RSTR <= SCR_BYTES, "p6b lds");
DI void p6b_axpy(Frame& F, const XcdPart P) {
    int lane_ = lane_id(); asm volatile("" : "+v"(lane_));
    const int lane = lane_, c = lane & 7, g = lane >> 3;
    const unsigned short* IDX = (const unsigned short*)(F.ws + WS_IDX); const bf16* Wp = (const bf16*)(F.ws + WS_W);
    float* rowss2 = (float*)(F.ws + WS_CTL) + CW_ROWSS2;
    bf16* X2B = (bf16*)(F.ws + WS_XN) + 256;
    const bf16* X1B = (const bf16*)(F.ws + WS_X1B);
    const int wrank = P.li * NWAVES + F.wave, wstride = P.nloc * NWAVES;
    const int j4 = 4 * g;
    LAS unsigned char* redw = F.lds + F.wave * (64 * P6B_RSTR) + lane * P6B_RSTR;
    const LAS unsigned char* redr = F.lds + F.wave * (64 * P6B_RSTR) + c * P6B_RSTR + 16 * g;
    for (int s = P.v; s < 8; s += P.nx) {
        const unsigned char* Vb = (const unsigned char*)(F.ws + WS_VB8) + (size_t)(s & 3) * NEXP * 128;
        const unsigned c16 = (unsigned)c * 16u;
        const int ch = (s & 3) * 256 + 32 * c + j4;
        const int tlo = (s >> 2) * (T / 2), thi = tlo + T / 2;
#define P6B_GATHER(R, E) do { const unsigned e_[8] = {E[0].x, E[0].y, E[0].z, E[0].w, E[1].x, E[1].y, E[1].z, E[1].w}; _Pragma("unroll") for (int j = 0; j < 8; ++j) { \
            R[2 * j] = *(const v4u*)(Vb + (((e_[j] & 0xffffu) << 7) | c16)); R[2 * j + 1] = *(const v4u*)(Vb + (((e_[j] >> 16) << 7) | c16)); } } while (0)
#define P6B_TOKEN(R, W, m) do { const unsigned w_[8] = {W[0].x, W[0].y, W[0].z, W[0].w, W[1].x, W[1].y, W[1].z, W[1].w}; \
            f32x2v acc[16]; _Pragma("unroll") for (int k = 0; k < 16; ++k) acc[k] = (f32x2v){0.f, 0.f}; \
            _Pragma("unroll") for (int j = 0; j < 16; ++j) { const float wj = (j & 1) ? bfhi(w_[j >> 1]) : bflo(w_[j >> 1]); const f32x2v w2 = {wj, wj}; const unsigned ua[4] = {R[j].x, R[j].y, R[j].z, R[j].w}; \
                _Pragma("unroll") for (int k = 0; k < 4; ++k) { \
                    acc[4 * k] = __builtin_elementwise_fma(w2, __builtin_amdgcn_cvt_scalef32_pk_f32_fp4(ua[k], 1.0f, 0), acc[4 * k]); acc[4 * k + 1] = __builtin_elementwise_fma(w2, __builtin_amdgcn_cvt_scalef32_pk_f32_fp4(ua[k], 1.0f, 1), acc[4 * k + 1]); \
                    acc[4 * k + 2] = __builtin_elementwise_fma(w2, __builtin_amdgcn_cvt_scalef32_pk_f32_fp4(ua[k], 1.0f, 2), acc[4 * k + 2]); acc[4 * k + 3] = __builtin_elementwise_fma(w2, __builtin_amdgcn_cvt_scalef32_pk_f32_fp4(ua[k], 1.0f, 3), acc[4 * k + 3]); } } \
            _Pragma("unroll") for (int k = 0; k < 16; ++k) *(LAS f32x2v*)(redw + 8 * k) = acc[k]; \
            f32x4 q4v = *(const LAS f32x4*)(redr); _Pragma("unroll") for (int gg = 1; gg < 8; ++gg) { const f32x4 t_ = *(const LAS f32x4*)(redr + gg * 8 * P6B_RSTR); q4v.x += t_.x; q4v.y += t_.y; q4v.z += t_.z; q4v.w += t_.w; } \
            const float q4[4] = {q4v.x, q4v.y, q4v.z, q4v.w}; \
            const v2u x1w = *(const v2u*)(X1B + (size_t)(m) * DMODEL + ch); \
            const float x20 = bflo(x1w.x) + q4[0], x21 = bfhi(x1w.x) + q4[1], x22 = bflo(x1w.y) + q4[2], x23 = bfhi(x1w.y) + q4[3]; \
            *(v2u*)(X2B + (size_t)(m) * 1280 + ch) = (v2u){pk2(x20, x21), pk2(x22, x23)}; \
            const float tot = wave_incl_scan(x20 * x20 + x21 * x21 + x22 * x22 + x23 * x23); \
            if (lane == 63) atomicAdd(rowss2 + (m), tot); } while (0)
#define P6B_LDE(E, tokn) do { E[0] = *(const v4u*)(IDX + (size_t)(tokn) * 128 + 16 * g); E[1] = *(const v4u*)(IDX + (size_t)(tokn) * 128 + 16 * g + 8); } while (0)
#define P6B_LDW(W, tokn) do { W[0] = *(const v4u*)(Wp + (size_t)(tokn) * 128 + 16 * g); W[1] = *(const v4u*)(Wp + (size_t)(tokn) * 128 + 16 * g + 8); } while (0)
        v4u EA[2], EB[2], RA[16], RB[16], WCA[2], WCB[2];
        const int m_0 = tlo + wrank;
        if (m_0 < thi) { P6B_LDE(EA, m_0); P6B_LDW(WCA, m_0); P6B_GATHER(RA, EA); }
        if (m_0 + wstride < thi) { P6B_LDE(EB, m_0 + wstride); P6B_LDW(WCB, m_0 + wstride); P6B_GATHER(RB, EB); }
        if (m_0 + 2 * wstride < thi) P6B_LDE(EA, m_0 + 2 * wstride);
        if (m_0 + 3 * wstride < thi) P6B_LDE(EB, m_0 + 3 * wstride);
        for (int m = m_0; m < thi; m += 2 * wstride) {
            const int mb = m + wstride;
            P6B_TOKEN(RA, WCA, m);
            if (m + 2 * wstride < thi) { P6B_GATHER(RA, EA); P6B_LDW(WCA, m + 2 * wstride); if (m + 4 * wstride < thi) P6B_LDE(EA, m + 4 * wstride); }
            if (mb < thi) { P6B_TOKEN(RB, WCB, mb);
                if (mb + 2 * wstride < thi) { P6B_GATHER(RB, EB); P6B_LDW(WCB, mb + 2 * wstride); if (mb + 4 * wstride < thi) P6B_LDE(EB, mb + 4 * wstride); } }
        }
#undef P6B_LDE
#undef P6B_LDW
#undef P6B_GATHER
#undef P6B_TOKEN
    }
}
#ifndef PH_MASK
#define PH_MASK 0xffff
#endif
#define PH(k) (PH_MASK & (1 << (k)))
#ifndef DBG_SKIP
#define DBG_SKIP 0
#endif
struct Args { const float* in[19]; float* out; unsigned char* ws; };
__global__ void __launch_bounds__(NWAVES * 64, 2) fwd_megakernel(Args args) {
    extern __shared__ __attribute__((aligned(16))) unsigned char lds[];
    Frame F;
    F.lds = (LAS unsigned char*)lds;
    F.MISC = (volatile LAS unsigned*)(F.lds + MISC_OFF);
    F.wave = __builtin_amdgcn_readfirstlane((int)threadIdx.x >> 6);
    F.G = gridDim.x; { const int bx = blockIdx.x; F.vcu = (F.G % 8 == 0) ? (bx % 8) * (F.G / 8) + bx / 8 : bx; }
    F.ws = args.ws; F.ctl = (gu32*)(args.ws + WS_CTL); F.out = args.out;
    for (int u = threadIdx.x; u < (LDS_BYTES - LDSCTL_OFF) / 4; u += NWAVES * 64) ((LAS unsigned*)(F.lds + LDSCTL_OFF))[u] = 0u;
    __syncthreads();
    XcdBarrier bar = xcd_barrier_post((unsigned*)(F.ctl + CW_BAR), F.MISC + 8, threadIdx.x == 0);
#ifdef TIMING_A
#ifndef TIMING_QUANT
#define TIMING_QUANT 50.0f
#endif
    unsigned long long ts_[16]; int nts_ = 0;
#define STAMP() do { if (nts_ < 16) ts_[nts_++] = __builtin_amdgcn_s_memrealtime(); } while (0)
#else
#define STAMP() do {} while (0)
#endif
    STAMP();
#define T0() (F.wave == 0 && lane_id() == 0)
#define GRID_BAR() do { xcd_barrier(bar, T0()); STAMP(); } while (0)
    unsigned char* ws = args.ws;
    bf16* XN = (bf16*)(ws + WS_XN); bf16* QKV = (bf16*)(ws + WS_QKV); bf16* HGB = (bf16*)(ws + WS_HG); bf16* GATE = (bf16*)(ws + WS_GATE);
    float* rowss = (float*)(ws + WS_CTL) + CW_ROWSS;

    if (PH(0)) p0_prologue(F);
    GRID_BAR();
    if (!(DBG_SKIP & 1)) {
    if (PH(1)) {   pg8::Gemm g{XN, (const bf16*)(ws + WS_WIN), T, INW, 1024, 1024, 1024}; pg8::StaticOrder S; S.init(T, INW, F.G, (int)blockIdx.x);
        pg8::EpiRoute E{QKV, HGB, GATE, I_HG_LB, I_Q_NORM, I_K_NORM, (const float*)(ws + WS_ROPE), (LAS float*)(F.lds + 131072)};
        pg8::gemm_phase<pg8::EpiRoute, pg8::StaticOrder, true, true>(F.lds, g, S, E, F.wave); }
    GRID_BAR();
    {
        volatile LAS unsigned* qslot = F.MISC + 16;
        for (;;) {
            __syncthreads();
            if ((F.wave * 64 + lane_id()) == 0) *qslot = __hip_atomic_fetch_add((unsigned*)(F.ctl + CW_QUEUE), 1u, __ATOMIC_RELAXED, __HIP_MEMORY_SCOPE_AGENT);
            __syncthreads();
            const int n = (int)__builtin_amdgcn_readfirstlane(*qslot);
            if (n >= 64 + 1024 + 256) break;
            if (n >= 64 + 1024) {
                const int c = n - (64 + 1024);
                cvt_rows_i4(F, inp(I_PEER_U), ws + WS_UB8, (float*)(ws + WS_US), 0, 64 * c, 64 * c + 64);
                cvt_rows_fp4(F, inp(I_PEER_V), ws + WS_VB8, (float*)(ws + WS_US), 1, 64 * c, 64 * c + 64);
                continue; }
#ifdef TIMING_Q
            const unsigned long long tq0_ = __builtin_amdgcn_s_memrealtime();
#endif
            if (n < 64) { if (PH(3)) hgrn_item(F, n); }
            else if (PH(4)) { attn_body::AttnUnit u; attn_body::unit_decode(n - 64, u);
                attn_body::attn_unit<8>(F.wave, u.bh / attn_body::NHEAD, u.bh % attn_body::NHEAD, u.qb, (const attn_body::bf16*)QKV, (const attn_body::bf16*)(QKV + 512), (const attn_body::bf16*)(QKV + 640), (attn_body::bf16*)F.out, (char*)lds); }
#ifdef TIMING_Q
            if (n == TIMING_Q && T0()) F.ctl[CW_QUEUE + 64] = (unsigned)(__builtin_amdgcn_s_memrealtime() - tq0_);
#endif
        }
    }
    GRID_BAR();
    if (PH(5)) p2b_ohn(F, (bf16*)F.out);
    GRID_BAR();
    if (PH(6)) {   pg8::Gemm g{(const bf16*)F.out, (const bf16*)(ws + WS_WUA), T, 1024, 1024, 1024, 1024}; pg8::StaticOrder S; S.init(T, 1024, F.G, (int)blockIdx.x);
        pg8::EpiMergeFused E{(bf16*)(ws + WS_HG), (const unsigned char*)GATE};
        pg8::gemm_phase<pg8::EpiMergeFused, pg8::StaticOrder, true, true>(F.lds, g, S, E, F.wave); }
    GRID_BAR();
    }
    if (PH(8) && !(DBG_SKIP & 1)) {
        pg8::Gemm g{(const bf16*)(ws + WS_HG), (const bf16*)(ws + WS_WOUT), T, 1024, 1024, 1024, 1024}; pg8::StaticOrder S; S.init(T, 1024, F.G, (int)blockIdx.x);
        pg8::EpiResid E{XN, (const float*)(ws + WS_GINV), (bf16*)(ws + WS_X1B), rowss};
        pg8::gemm_phase<pg8::EpiResid, pg8::StaticOrder, true, true>(F.lds, g, S, E, F.wave);
    }
    GRID_BAR();
    if (PH(9) && !(DBG_SKIP & 2)) {
        pg8::Gemm g{(const bf16*)(ws + WS_X1B), (const bf16*)(ws + WS_WPEER), T, 2048, 1024, 1024, 1024}; pg8::StaticOrder S; S.init(T, 2048, F.G, (int)blockIdx.x);
        pg8::EpiTopk E{rowss, (unsigned short*)(ws + WS_IDX), (float*)(ws + WS_GW), EPS};
        pg8::OneUnit one;
        for (int i = 0; S.next(i, one.u); ++i) pg8::gemm_phase<pg8::EpiTopk, pg8::OneUnit, false, true>(F.lds, g, one, E, F.wave);
    }
    if (PH(9)) p5_quant_h(F);
    GRID_BAR();
    {   XcdPart P; xcd_census((unsigned*)(F.ctl + CW_BAR), bar.x, P.v, P.nx, P.nloc); P.li = (int)__builtin_amdgcn_readfirstlane(F.MISC[10]);
        if (PH(10)) { const int rpb = (T + F.G - 1) / F.G; const int r0 = (int)blockIdx.x * rpb; cvt_p_rows(F, inp(I_P), (bf16*)(ws + WS_XN), r0, min(r0 + rpb, T)); }
        if (PH(10)) p6a_dots(F, P);
        GRID_BAR();
        if (PH(10)) p6b_axpy(F, P);
    }
    GRID_BAR();
    if (PH(12)) {   pg8::Gemm g{XN, (const bf16*)(ws + WS_WPG), T, 1024, 1280, 1280, 1280}; pg8::StaticOrder S; S.init(T, 1024, F.G, (int)blockIdx.x);
        pg8::EpiPleFused E{F.out, (bf16*)(ws + WS_PP), rowss + 32768, EPS, XN};
        pg8::gemm_phase<pg8::EpiPleFused, pg8::StaticOrder, true, true>(F.lds, g, S, E, F.wave); }
#ifdef TIMING_A
    GRID_BAR();
    if (blockIdx.x == 0 && (F.wave * 64 + lane_id()) == 0) {
#ifdef TIMING_Q
        const float dq_ = 4.0f * __builtin_rintf((float)__hip_atomic_load((unsigned*)(F.ctl + CW_QUEUE + 64), __ATOMIC_RELAXED, __HIP_MEMORY_SCOPE_AGENT) * (0.01f / 20.0f));
        F.out[2] += dq_;
#endif
#if TIMING_A >= 100
        const float da = (TIMING_QUANT / 20.0f) * __builtin_rintf((float)(ts_[nts_ - 1] - ts_[0]) * (0.01f / TIMING_QUANT));
#else
        const float da = (TIMING_QUANT / 5.0f) * __builtin_rintf((float)(ts_[TIMING_A + 1] - ts_[TIMING_A]) * (0.01f / TIMING_QUANT));
#endif
        F.out[0] += da;
#ifdef TIMING_B
        const float db = (float)(ts_[TIMING_B + 1] - ts_[TIMING_B]) * (0.01f / 5.0f);
        F.out[1] += db;
#endif
    }
#endif
}

extern "C" void kernel_launch(void* const* d_in, const int* in_sizes, int n_in, void* d_out, int out_size, void* d_ws, size_t ws_size, hipStream_t stream) {
    static int grid = 0;
    if (grid == 0) {
        if (n_in != 19 || out_size != T * DMODEL || ws_size < WS_END) { fprintf(stderr, "kernel_launch: unexpected shapes (n_in %d out %d ws %zu)\n", n_in, out_size, ws_size); grid = -1; return; }
        int dev = 0, cus = 0, per_cu = 0;
        if (hipGetDevice(&dev) != hipSuccess || hipDeviceGetAttribute(&cus, hipDeviceAttributeMultiprocessorCount, dev) != hipSuccess) { grid = -1; return; }
        if (hipFuncSetAttribute((const void*)fwd_megakernel, hipFuncAttributeMaxDynamicSharedMemorySize, LDS_BYTES) != hipSuccess) { fprintf(stderr, "kernel_launch: hipFuncSetAttribute failed\n"); grid = -1; return; }
        if (hipOccupancyMaxActiveBlocksPerMultiprocessor(&per_cu, (const void*)fwd_megakernel, NWAVES * 64, LDS_BYTES) != hipSuccess || per_cu < 1) fprintf(stderr, "kernel_launch: occupancy query says %d\n", per_cu);
        (void)hipGetLastError();
        grid = cus;
    }
    if (grid < 0) return;
    (void)hipMemsetAsync((char*)d_ws + WS_CTL, 0, CTL_ZERO_BYTES, stream);
    Args a{};
    for (int i = 0; i < 19; ++i) a.in[i] = (const float*)d_in[i];
    a.out = (float*)d_out; a.ws = (unsigned char*)d_ws;
    hipLaunchKernelGGL(fwd_megakernel, dim3(grid), dim3(NWAVES * 64), LDS_BYTES, stream, a);
}
```

```cpp
#include <hip/hip_runtime.h>
#include <cstdio>
#include <cstdint>
namespace pg8 {
#define PG8_LAS __attribute__((address_space(3)))
typedef unsigned short bf16_t;
typedef short bf16x8 __attribute__((ext_vector_type(8)));
typedef float f32x4 __attribute__((ext_vector_type(4)));
typedef unsigned u32x4 __attribute__((ext_vector_type(4)));
typedef unsigned u32x2 __attribute__((ext_vector_type(2)));
constexpr int BM = 256, BK = 64, HALF = 128, HTB = HALF * BK * 2  , STAGE_BYTES = 8 * HTB, NXCD = 8, WGM = 8;

__host__ __device__ __forceinline__ int lds_byte(int r, int c) { const int st = (r >> 4) * 2 + (c >> 5), rr = r & 15, cc = c & 31, ob = rr * 64 + cc * 2; return st * 1024 + (ob ^ (((ob >> 9) & 1) << 5)); }
__host__ __device__ __forceinline__ void stage_rc(int b, int& R, int& C) { const int st = b / 1024, sb = b % 1024, swz = sb ^ (((sb >> 9) & 1) << 5); R = (st >> 1) * 16 + swz / 64; C = (st & 1) * 32 + (swz % 64) / 2; }
__host__ __device__ __forceinline__ int perm32(int rho) { const int n = rho >> 4, i = rho & 15; return 8 * (i >> 2) + 4 * n + (i & 3); }

struct Unit { int pm, pn; };
struct Gemm { const bf16_t* A; const bf16_t* Bt; int M, N, K, lda, ldb; };

struct StaticOrder {
    int nM, nN, nwg, G, c;
    __host__ __device__ void init(int M, int N, int G_, int c_) { nM = M / BM; nN = N / BM; nwg = nM * nN; G = G_; c = c_; }
    __host__ __device__ bool next(int i, Unit& u) const {
        const long L = (long)i * G + c; if (L >= nwg) return false;
        int wgid = (int)L; { const int q = nwg / NXCD, r = nwg % NXCD, xcd = wgid % NXCD, off = wgid / NXCD; wgid = (xcd < r ? xcd * (q + 1) : r * (q + 1) + (xcd - r) * q) + off; }
        const int nig = WGM * nN, gid = wgid / nig, fm = gid * WGM, gsz = (nM - fm) < WGM ? (nM - fm) : WGM;
        u.pm = fm + ((wgid % nig) % gsz); u.pn = (wgid % nig) / gsz; return true;
    }
    __device__ __forceinline__ void a_ready(const Unit&) const {}
    __device__ __forceinline__ void done(const Unit&) const {}
};
struct OneUnit {
    Unit u;
    __device__ __forceinline__ bool next(int i, Unit& o) const { if (i != 0) return false; o = u; return true; }
    __device__ __forceinline__ void a_ready(const Unit&) const {}
    __device__ __forceinline__ void done(const Unit&) const {}
};

__device__ __forceinline__ unsigned cvt_pk_bf16(float lo, float hi) { unsigned r; asm volatile("v_cvt_pk_bf16_f32 %0, %1, %2" : "=v"(r) : "v"(lo), "v"(hi)); return r; }
__device__ __forceinline__ float bf_lo(unsigned w) { return __uint_as_float(w << 16); }
__device__ __forceinline__ float bf_hi(unsigned w) { return __uint_as_float(w & 0xffff0000u); }
__device__ __forceinline__ float sigmoidf_(float x) { return __builtin_amdgcn_rcpf(1.0f + __builtin_amdgcn_exp2f(-1.4426950408889634f * x)); }


template <class Epi, class Sched, bool ALIGN_EPI = false, bool SP2 = false>
__device__ __forceinline__ void gemm_phase(PG8_LAS unsigned char* lds, const Gemm g, const Sched& S, const Epi& E, const int wave_id) {
    int tid_; asm volatile("v_mbcnt_lo_u32_b32 %0, -1, 0\n\tv_mbcnt_hi_u32_b32 %0, -1, %0" : "=v"(tid_)); tid_ += wave_id * 64;
    const int tid = tid_, wid = __builtin_amdgcn_readfirstlane(tid >> 6), lane = tid & 63, wr = wid >> 2, wc = wid & 3, fr = lane & 15, fq = lane >> 4;
    int K_ = g.K; asm volatile("" : "+s"(K_));
    const int K = K_, nt = K / BK;
    unsigned voffA[2], voffB[2];
#pragma unroll
    for (int i = 0; i < 2; ++i) { int R, C; stage_rc(tid * 16 + i * 8192, R, C); const int Rb = Epi::PERM ? ((R & ~31) + perm32(R & 31)) : R;
        voffA[i] = (unsigned)(R * g.lda + C) * 2u; voffB[i] = (unsigned)(Rb * g.ldb + C) * 2u; }
    const size_t kstep = (size_t)(BK * 2);
    const size_t hstepA = (size_t)HALF * g.lda * 2, hstepB = (size_t)HALF * g.ldb * 2;
    const size_t tstepA = 2 * hstepA, tstepB = 2 * hstepB;
    const unsigned ldsw = (unsigned)wid * 1024u;
    const int aoff = lds_byte(wr * 64 + fr, fq * 8), boff = lds_byte(wc * 32 + fr, fq * 8);
#define PG8_SA(b, h) (((b) * 2 + (h)) * HTB)
#define PG8_SB(b, h) ((4 + (b) * 2 + (h)) * HTB)
#define PG8_STAGE(bufoff, gbase, voff) do { _Pragma("unroll") for (int _i = 0; _i < 2; ++_i) \
        __builtin_amdgcn_global_load_lds((const unsigned*)((const char*)(gbase) + (voff)[_i]), (PG8_LAS unsigned*)(lds + (bufoff) + ldsw + _i * 8192), 16, 0, 0); } while (0)
#define PG8_LDA(dst, b, h) do { _Pragma("unroll") for (int m = 0; m < 4; ++m) _Pragma("unroll") for (int k = 0; k < 2; ++k) dst[m][k] = *(const PG8_LAS bf16x8*)(lds + PG8_SA(b, h) + aoff + m * 2048 + k * 1024); } while (0)
#define PG8_LDB(dst, b, h) do { _Pragma("unroll") for (int n = 0; n < 2; ++n) _Pragma("unroll") for (int k = 0; k < 2; ++k) dst[n][k] = *(const PG8_LAS bf16x8*)(lds + PG8_SB(b, h) + boff + n * 2048 + k * 1024); } while (0)
#define PG8_MMA(ai, bj, At, Bt) do { __builtin_amdgcn_s_setprio(1); _Pragma("unroll") for (int m = 0; m < 4; ++m) _Pragma("unroll") for (int n = 0; n < 2; ++n) _Pragma("unroll") for (int k = 0; k < 2; ++k) \
        acc[ai][bj][m][n] = __builtin_amdgcn_mfma_f32_16x16x32_bf16(Bt[n][k], At[m][k], acc[ai][bj][m][n], 0, 0, 0); __builtin_amdgcn_s_setprio(0); } while (0)
#define PG8_WAIT_V(n) asm volatile("s_waitcnt vmcnt(" #n ")" ::: "memory")
#define PG8_WAIT_L(n) asm volatile("s_waitcnt lgkmcnt(" #n ")" ::: "memory")
#define PG8_BAR __builtin_amdgcn_s_barrier()
#define PG8_SCHED __builtin_amdgcn_sched_barrier(0)
    Unit cur, nxt; int ui = 0;
    if (!S.next(0, cur)) return;
    f32x4 acc[2][2][4][2];
#pragma unroll
    for (int a = 0; a < 2; ++a)
#pragma unroll
        for (int b = 0; b < 2; ++b)
#pragma unroll
            for (int m = 0; m < 4; ++m)
#pragma unroll
                for (int n = 0; n < 2; ++n) acc[a][b][m][n] = (f32x4){0.f, 0.f, 0.f, 0.f};
    bf16x8 At[4][2], B0[2][2], B1[2][2];
    const char* cA = (const char*)g.A + (size_t)cur.pm * tstepA; const char* cB = (const char*)g.Bt + (size_t)cur.pn * tstepB;
    S.a_ready(cur);
    if constexpr (SP2) {
        PG8_STAGE(PG8_SB(0, 0), cB, voffB); PG8_STAGE(PG8_SB(0, 1), cB + hstepB, voffB); PG8_STAGE(PG8_SA(0, 0), cA, voffA); PG8_STAGE(PG8_SA(0, 1), cA + hstepA, voffA);
        if (wr == 1) PG8_BAR;
        PG8_WAIT_V(2); PG8_BAR;
        PG8_STAGE(PG8_SB(1, 0), cB + kstep, voffB); PG8_STAGE(PG8_SA(1, 0), cA + kstep, voffA); PG8_STAGE(PG8_SB(1, 1), cB + hstepB + kstep, voffB);
        PG8_WAIT_V(6); PG8_BAR;
    } else {
        PG8_STAGE(PG8_SB(0, 0), cB, voffB); PG8_STAGE(PG8_SA(0, 0), cA, voffA); PG8_STAGE(PG8_SB(0, 1), cB + hstepB, voffB); PG8_STAGE(PG8_SA(0, 1), cA + hstepA, voffA);
        if (wr == 1) PG8_BAR;
        PG8_WAIT_V(4); PG8_BAR;
        PG8_STAGE(PG8_SB(1, 0), cB + kstep, voffB); PG8_STAGE(PG8_SA(1, 0), cA + kstep, voffA); PG8_STAGE(PG8_SB(1, 1), cB + hstepB + kstep, voffB);
        PG8_WAIT_V(6); PG8_BAR;
    }
    for (;;) {
        const bool has_next = S.next(ui + 1, nxt);
        const char* nA = has_next ? (const char*)g.A + (size_t)nxt.pm * tstepA : cA; const char* nB = has_next ? (const char*)g.Bt + (size_t)nxt.pn * tstepB : cB;
        for (int t = 0; t < nt; t += 2) {
            const bool last = (t == nt - 2);
            const char* a1 = cA + (size_t)(t + 1) * kstep;
            const char* a2 = last ? nA : cA + (size_t)(t + 2) * kstep; const char* b2 = last ? nB : cB + (size_t)(t + 2) * kstep;
            const char* a3 = a2 + kstep; const char* b3 = b2 + kstep;
            if (last && has_next) S.a_ready(nxt);
            if constexpr (SP2) {
            PG8_LDB(B0, 0, 0); PG8_LDB(B1, 0, 1); PG8_SCHED; PG8_LDA(At, 0, 0); PG8_STAGE(PG8_SA(1, 1), a1 + hstepA, voffA);
            PG8_WAIT_V(8); PG8_WAIT_L(0); PG8_BAR; PG8_MMA(0, 0, At, B0); PG8_MMA(0, 1, At, B1); PG8_BAR; PG8_SCHED;
            PG8_LDA(At, 0, 1); PG8_STAGE(PG8_SB(0, 0), b2, voffB); PG8_STAGE(PG8_SB(0, 1), b2 + hstepB, voffB); PG8_STAGE(PG8_SA(0, 0), a2, voffA);
            PG8_WAIT_V(8); PG8_WAIT_L(0); PG8_BAR; PG8_MMA(1, 0, At, B0); PG8_MMA(1, 1, At, B1); PG8_BAR; PG8_SCHED;
            PG8_LDB(B0, 1, 0); PG8_LDB(B1, 1, 1); PG8_SCHED; PG8_LDA(At, 1, 0); PG8_STAGE(PG8_SA(0, 1), a2 + hstepA, voffA);
            PG8_WAIT_V(8); PG8_WAIT_L(0); PG8_BAR; PG8_MMA(0, 0, At, B0); PG8_MMA(0, 1, At, B1); PG8_BAR; PG8_SCHED;
            PG8_LDA(At, 1, 1); PG8_STAGE(PG8_SB(1, 0), b3, voffB); PG8_STAGE(PG8_SB(1, 1), b3 + hstepB, voffB); PG8_STAGE(PG8_SA(1, 0), a3, voffA);
            PG8_WAIT_V(8); PG8_WAIT_L(0); PG8_BAR; PG8_MMA(1, 0, At, B0); PG8_MMA(1, 1, At, B1); PG8_BAR; PG8_SCHED;
            } else {
            PG8_LDB(B0, 0, 0); PG8_SCHED; PG8_LDA(At, 0, 0); PG8_STAGE(PG8_SA(1, 1), a1 + hstepA, voffA);
            PG8_WAIT_L(8); PG8_BAR; PG8_WAIT_L(0); PG8_MMA(0, 0, At, B0); PG8_BAR; PG8_SCHED;
            PG8_LDB(B1, 0, 1); PG8_STAGE(PG8_SB(0, 0), b2, voffB);
            PG8_BAR; PG8_WAIT_L(0); PG8_MMA(0, 1, At, B1); PG8_BAR;
            PG8_LDA(At, 0, 1); PG8_STAGE(PG8_SA(0, 0), a2, voffA);
            PG8_BAR; PG8_WAIT_L(0); PG8_MMA(1, 0, At, B0); PG8_BAR; PG8_SCHED;
            PG8_STAGE(PG8_SB(0, 1), b2 + hstepB, voffB);
            PG8_WAIT_V(6); PG8_BAR; PG8_MMA(1, 1, At, B1); PG8_BAR;
            PG8_LDB(B0, 1, 0); PG8_SCHED; PG8_LDA(At, 1, 0); PG8_STAGE(PG8_SA(0, 1), a2 + hstepA, voffA);
            PG8_WAIT_L(8); PG8_BAR; PG8_WAIT_L(0); PG8_MMA(0, 0, At, B0); PG8_BAR; PG8_SCHED;
            PG8_LDB(B1, 1, 1); PG8_STAGE(PG8_SB(1, 0), b3, voffB);
            PG8_BAR; PG8_WAIT_L(0); PG8_MMA(0, 1, At, B1); PG8_BAR;
            PG8_LDA(At, 1, 1); PG8_STAGE(PG8_SA(1, 0), a3, voffA);
            PG8_BAR; PG8_WAIT_L(0); PG8_MMA(1, 0, At, B0); PG8_BAR; PG8_SCHED;
            PG8_STAGE(PG8_SB(1, 1), b3 + hstepB, voffB);
            PG8_WAIT_V(6); PG8_BAR; PG8_MMA(1, 1, At, B1); PG8_BAR;
            }
            if constexpr (Epi::MIDHOOK) { if (t + 2 == Epi::MID_TILES) E.mid(acc, cur, wr, wc, fr, fq); }
        }
        if constexpr (ALIGN_EPI) { if (wr == 0) PG8_BAR; }
        if constexpr (!Epi::AFTER_DRAIN) { E(acc, cur, wr, wc, fr, fq); S.done(cur); }
        if (!has_next) break;
#pragma unroll
        for (int a = 0; a < 2; ++a)
#pragma unroll
            for (int b = 0; b < 2; ++b)
#pragma unroll
                for (int m = 0; m < 4; ++m)
#pragma unroll
                    for (int n = 0; n < 2; ++n) acc[a][b][m][n] = (f32x4){0.f, 0.f, 0.f, 0.f};
        cur = nxt; cA = nA; cB = nB; ++ui;
        if constexpr (ALIGN_EPI) { if (wr == 1) PG8_BAR; }
    }
    PG8_WAIT_V(0);
    if constexpr (!ALIGN_EPI) { if (wr == 0) PG8_BAR; }
    PG8_BAR;
    if constexpr (Epi::AFTER_DRAIN) { E.fused(acc, cur, wr, wc, fr, fq, lds, wid, lane); S.done(cur); }
#undef PG8_SA
#undef PG8_SB
#undef PG8_STAGE
#undef PG8_LDA
#undef PG8_LDB
#undef PG8_MMA
#undef PG8_WAIT_V
#undef PG8_WAIT_L
#undef PG8_BAR
#undef PG8_SCHED
}
}
namespace pg8 {
__device__ __forceinline__ const float* kin(int k) {
    typedef const float* cfp;
    const __attribute__((address_space(4))) char* ka = (const __attribute__((address_space(4))) char*)__builtin_amdgcn_kernarg_segment_ptr();
    return *(const volatile __attribute__((address_space(4))) cfp*)(ka + 8 * k);
}
struct EpiRoute {
    static constexpr bool PERM = true, AFTER_DRAIN = false, MIDHOOK = false;
    bf16_t* qkv; bf16_t* hg; bf16_t* gate; int k_lb, k_qn, k_kn;
    const float* rope;
    PG8_LAS float* xs;
    __device__ __forceinline__ void operator()(const f32x4 (&acc)[2][2][4][2], const Unit& u, int wr, int wc, int fr, int fq) const {
        bf16_t* base; int ldc, colt, mode = 0;
        if (u.pn < 3) { base = qkv; ldc = 768; colt = u.pn * 256; mode = 4; }
        else if (u.pn < 13) { base = hg; ldc = 2560; colt = (u.pn - 3) * 256; mode = (u.pn < 5 || u.pn >= 11) ? 1 : (u.pn < 7 ? 2 : (u.pn < 9 ? 3 : 0)); }
        else { base = gate; ldc = 2048; colt = (u.pn - 13) * 256; mode = 5; }
        const int row0 = u.pm * BM + wr * 64 + fr, col0 = colt + wc * 32 + 8 * fq;
        if (mode == 4) {
            const int nbj = (u.pn == 2) ? 1 : 2;
#pragma unroll
            for (int ai = 0; ai < 2; ++ai)
#pragma unroll
                for (int m = 0; m < 4; ++m)
#pragma unroll
                    for (int bj = 0; bj < 2; ++bj) { if (bj < nbj) { const f32x4 v0 = acc[ai][bj][m][0], v1 = acc[ai][bj][m][1];
                        float ss = (v0[0] * v0[0] + v0[1] * v0[1]) + (v0[2] * v0[2] + v0[3] * v0[3]) + (v1[0] * v1[0] + v1[1] * v1[1]) + (v1[2] * v1[2] + v1[3] * v1[3]);
                        ss += __shfl_xor(ss, 16); ss += __shfl_xor(ss, 32);
                        if (fq == 0) xs[((ai * HALF + wr * 64 + m * 16 + fr) * 4 + 2 * bj + (wc >> 1)) * 2 + (wc & 1)] = ss; } }
            asm volatile("s_waitcnt lgkmcnt(0)\n\ts_barrier" ::: "memory");
            const int d0 = 32 * (wc & 1) + 8 * fq;
            float gn[8];
            { const float* nrm = kin(k_qn + (int)(u.pn == 2) * (k_kn - k_qn));
#pragma unroll
              for (int j = 0; j < 8; ++j) gn[j] = nrm[d0 + j]; }
            const float qs = (u.pn == 2) ? 1.0f : 0.125f * 1.4426950408889634f;
            const int axis = wc & 1, fbase = 8 * (fq & 1);
#pragma unroll
            for (int ai = 0; ai < 2; ++ai)
#pragma unroll
                for (int m = 0; m < 4; ++m) { const int rl = ai * HALF + wr * 64 + m * 16 + fr; const int grow = u.pm * BM + rl; const int t = grow & 4095;
                    const int pos = axis ? (t & 63) : (t >> 6);
                    const f32x4* rp = (const f32x4*)(rope + (pos * 16 + fbase) * 2);
                    const f32x4 c01 = rp[0], c23 = rp[1], c45 = rp[2], c67 = rp[3];
                    const float cs[8] = {c01[0], c01[2], c23[0], c23[2], c45[0], c45[2], c67[0], c67[2]}, sn[8] = {c01[1], c01[3], c23[1], c23[3], c45[1], c45[3], c67[1], c67[3]};
                    bf16_t* rowp = base + (size_t)grow * ldc + col0;
#pragma unroll
                    for (int bj = 0; bj < 2; ++bj) { const f32x4 v0 = acc[ai][bj][m][0], v1 = acc[ai][bj][m][1];
                        float v[8] = {v0[0], v0[1], v0[2], v0[3], v1[0], v1[1], v1[2], v1[3]};
                        if (bj < nbj) {
                            const PG8_LAS float* xp = xs + ((rl * 4 + 2 * bj + (wc >> 1)) * 2);
                            const float rinv = __builtin_amdgcn_rsqf((xp[0] + xp[1]) * (1.0f / 64.0f) + 1e-6f) * qs;
#pragma unroll
                            for (int j = 0; j < 8; ++j) { const float y = v[j] * rinv * gn[j]; const float yp = __shfl_xor(y, 32);
                                v[j] = (fq & 2) ? (yp * sn[j] + y * cs[j]) : (y * cs[j] - yp * sn[j]); }
                        }
                        u32x4 w; w.x = cvt_pk_bf16(v[0], v[1]); w.y = cvt_pk_bf16(v[2], v[3]); w.z = cvt_pk_bf16(v[4], v[5]); w.w = cvt_pk_bf16(v[6], v[7]);
                        *(u32x4*)(rowp + bj * HALF) = w; } }
            return;
        }
        float lb[2][8];
        if (mode == 2 || mode == 3) { const int d = mode - 2; const float* lbraw = kin(k_lb);
#pragma unroll
            for (int bj = 0; bj < 2; ++bj) { const int c = (col0 + bj * HALF) & 511; const float* r0 = lbraw + d * 512 + c; const float* r1 = lbraw + 1024 + d * 512 + c;
#pragma unroll
                for (int j = 0; j < 8; ++j) lb[bj][j] = sigmoidf_(r0[j] - r1[j]); } }
#pragma unroll
        for (int ai = 0; ai < 2; ++ai)
#pragma unroll
            for (int m = 0; m < 4; ++m) { bf16_t* rowp = base + (size_t)(row0 + ai * HALF + m * 16) * ldc + col0;
#pragma unroll
                for (int bj = 0; bj < 2; ++bj) { const f32x4 v0 = acc[ai][bj][m][0], v1 = acc[ai][bj][m][1];
                    float v[8] = {v0[0], v0[1], v0[2], v0[3], v1[0], v1[1], v1[2], v1[3]};
                    if (mode == 1) {
#pragma unroll
                        for (int j = 0; j < 8; ++j) v[j] = v[j] * sigmoidf_(v[j]);
                    } else if (mode == 5) {
                        unsigned q8[8];
#pragma unroll
                        for (int j = 0; j < 8; ++j) q8[j] = (unsigned)__builtin_rintf(255.0f * sigmoidf_(v[j]));
                        unsigned char* gp = (unsigned char*)base + (size_t)(row0 + ai * HALF + m * 16) * 2048 + col0 + bj * HALF;
                        *(unsigned long long*)gp = (unsigned long long)(q8[0] | (q8[1] << 8) | (q8[2] << 16) | (q8[3] << 24)) | ((unsigned long long)(q8[4] | (q8[5] << 8) | (q8[6] << 16) | (q8[7] << 24)) << 32);
                        continue;
                    } else if (mode >= 2) {
#pragma unroll
                        for (int j = 0; j < 8; ++j) v[j] = __builtin_amdgcn_logf(lb[bj][j] + (1.0f - lb[bj][j]) * sigmoidf_(v[j]));
                    }
                    u32x4 w; w.x = cvt_pk_bf16(v[0], v[1]); w.y = cvt_pk_bf16(v[2], v[3]); w.z = cvt_pk_bf16(v[4], v[5]); w.w = cvt_pk_bf16(v[6], v[7]);
                    *(u32x4*)(rowp + bj * HALF) = w; } }
    }
};
struct EpiBf16Plain {
    static constexpr bool PERM = true, AFTER_DRAIN = false, MIDHOOK = false;
    bf16_t* O; int ldc;
    __device__ __forceinline__ void operator()(const f32x4 (&acc)[2][2][4][2], const Unit& u, int wr, int wc, int fr, int fq) const {
        const int row0 = u.pm * BM + wr * 64 + fr, col0 = u.pn * BM + wc * 32 + 8 * fq;
#pragma unroll
        for (int ai = 0; ai < 2; ++ai)
#pragma unroll
            for (int m = 0; m < 4; ++m) { bf16_t* rowp = O + (size_t)(row0 + ai * HALF + m * 16) * ldc + col0;
#pragma unroll
                for (int bj = 0; bj < 2; ++bj) { const f32x4 v0 = acc[ai][bj][m][0], v1 = acc[ai][bj][m][1];
                    u32x4 w; w.x = cvt_pk_bf16(v0[0], v0[1]); w.y = cvt_pk_bf16(v0[2], v0[3]); w.z = cvt_pk_bf16(v1[0], v1[1]); w.w = cvt_pk_bf16(v1[2], v1[3]);
                    *(u32x4*)(rowp + bj * HALF) = w; } }
    }
};
struct EpiMergeFused {
    static constexpr bool PERM = true, AFTER_DRAIN = false, MIDHOOK = true; static constexpr int MID_TILES = 8;
    bf16_t* MG; const unsigned char* gate;
    __device__ __forceinline__ void mid(f32x4 (&acc)[2][2][4][2], const Unit& u, int wr, int wc, int fr, int fq) const {
        const int row0 = u.pm * BM + wr * 64 + fr, col0 = u.pn * BM + wc * 32 + 8 * fq;
#pragma unroll
        for (int ai = 0; ai < 2; ++ai)
#pragma unroll
            for (int m = 0; m < 4; ++m) { const size_t row = (size_t)(row0 + ai * HALF + m * 16);
#pragma unroll
                for (int bj = 0; bj < 2; ++bj) { const int col = col0 + bj * HALF;
                    const unsigned long long ga = *(const unsigned long long*)(gate + row * 2048 + col), gb = *(const unsigned long long*)(gate + row * 2048 + 1024 + col);
#pragma unroll
                    for (int j = 0; j < 8; ++j) { const float a = (float)((unsigned)(ga >> (8 * j)) & 0xffu), b = fmaxf((float)((unsigned)(gb >> (8 * j)) & 0xffu), 9.5367431640625e-7f);
                        acc[ai][bj][m][j >> 2][j & 3] *= a * __builtin_amdgcn_rcpf(b); } } }
    }
    __device__ __forceinline__ void operator()(const f32x4 (&acc)[2][2][4][2], const Unit& u, int wr, int wc, int fr, int fq) const {
        const int row0 = u.pm * BM + wr * 64 + fr, col0 = u.pn * BM + wc * 32 + 8 * fq;
#pragma unroll
        for (int ai = 0; ai < 2; ++ai)
#pragma unroll
            for (int m = 0; m < 4; ++m) { const size_t row = (size_t)(row0 + ai * HALF + m * 16);
#pragma unroll
                for (int bj = 0; bj < 2; ++bj) { const int col = col0 + bj * HALF;
                    const unsigned long long gb = *(const unsigned long long*)(gate + row * 2048 + 1024 + col);
                    float v[8] = {acc[ai][bj][m][0][0], acc[ai][bj][m][0][1], acc[ai][bj][m][0][2], acc[ai][bj][m][0][3], acc[ai][bj][m][1][0], acc[ai][bj][m][1][1], acc[ai][bj][m][1][2], acc[ai][bj][m][1][3]};
#pragma unroll
                    for (int j = 0; j < 8; ++j) v[j] *= fmaxf((float)((unsigned)(gb >> (8 * j)) & 0xffu), 9.5367431640625e-7f) * (1.0f / 255.0f);
                    u32x4 w; w.x = cvt_pk_bf16(v[0], v[1]); w.y = cvt_pk_bf16(v[2], v[3]); w.z = cvt_pk_bf16(v[4], v[5]); w.w = cvt_pk_bf16(v[6], v[7]);
                    *(u32x4*)(MG + row * 1024 + col) = w; } }
    }
};
struct EpiResid {
    static constexpr bool PERM = true, AFTER_DRAIN = false, MIDHOOK = false;
    const bf16_t* xn; const float* aux; bf16_t* xb; float* rowss;
    __device__ __forceinline__ void operator()(const f32x4 (&acc)[2][2][4][2], const Unit& u, int wr, int wc, int fr, int fq) const {
        const int row0 = u.pm * BM + wr * 64 + fr, col0 = u.pn * BM + wc * 32 + 8 * fq;
#pragma unroll
        for (int ai = 0; ai < 2; ++ai)
#pragma unroll
            for (int m = 0; m < 4; ++m) { const size_t row = (size_t)(row0 + ai * HALF + m * 16); float ss = 0.f; const float rr = aux[65536 + row];
#pragma unroll
                for (int bj = 0; bj < 2; ++bj) { const size_t off = row * 1024 + col0 + bj * HALF;
                    const u32x4 xw = *(const u32x4*)(xn + off);
                    const f32x4 g0 = *(const f32x4*)(aux + col0 + bj * HALF) * rr, g1 = *(const f32x4*)(aux + col0 + bj * HALF + 4) * rr;
                    const f32x4 x0 = {bf_lo(xw.x) * g0[0], bf_hi(xw.x) * g0[1], bf_lo(xw.y) * g0[2], bf_hi(xw.y) * g0[3]}, x1 = {bf_lo(xw.z) * g1[0], bf_hi(xw.z) * g1[1], bf_lo(xw.w) * g1[2], bf_hi(xw.w) * g1[3]};
                    const f32x4 o0 = x0 + acc[ai][bj][m][0], o1 = x1 + acc[ai][bj][m][1];
                    ss += (o0[0] * o0[0] + o0[1] * o0[1]) + (o0[2] * o0[2] + o0[3] * o0[3]) + (o1[0] * o1[0] + o1[1] * o1[1]) + (o1[2] * o1[2] + o1[3] * o1[3]);
                    u32x4 w; w.x = cvt_pk_bf16(o0[0], o0[1]); w.y = cvt_pk_bf16(o0[2], o0[3]); w.z = cvt_pk_bf16(o1[0], o1[1]); w.w = cvt_pk_bf16(o1[2], o1[3]);
                    *(u32x4*)(xb + off) = w; }
                ss += __shfl_xor(ss, 16); ss += __shfl_xor(ss, 32);
                if (fq == 0) atomicAdd(rowss + row, ss); }
    }
};
struct EpiPleFused {
    static constexpr bool PERM = true, AFTER_DRAIN = false, MIDHOOK = true; static constexpr int MID_TILES = 4;
    float* out; bf16_t* pp; const float* rowss2; float eps; const bf16_t* aple;
    __device__ __forceinline__ void mid(f32x4 (&acc)[2][2][4][2], const Unit& u, int wr, int wc, int fr, int fq) const {
        const int row0 = u.pm * BM + wr * 64 + fr, col0 = u.pn * BM + wc * 32 + 8 * fq;
#pragma unroll
        for (int ai = 0; ai < 2; ++ai)
#pragma unroll
            for (int m = 0; m < 4; ++m) { bf16_t* rowp = pp + (size_t)(row0 + ai * HALF + m * 16) * 1024 + col0;
#pragma unroll
                for (int bj = 0; bj < 2; ++bj) { const f32x4 v0 = acc[ai][bj][m][0], v1 = acc[ai][bj][m][1];
                    u32x4 w; w.x = cvt_pk_bf16(v0[0], v0[1]); w.y = cvt_pk_bf16(v0[2], v0[3]); w.z = cvt_pk_bf16(v1[0], v1[1]); w.w = cvt_pk_bf16(v1[2], v1[3]);
                    *(u32x4*)(rowp + bj * HALF) = w;
                    acc[ai][bj][m][0] = (f32x4){0.f, 0.f, 0.f, 0.f}; acc[ai][bj][m][1] = (f32x4){0.f, 0.f, 0.f, 0.f}; } }
    }
    __device__ __forceinline__ void operator()(const f32x4 (&acc)[2][2][4][2], const Unit& u, int wr, int wc, int fr, int fq) const {
        const int row0 = u.pm * BM + wr * 64 + fr, col0 = u.pn * BM + wc * 32 + 8 * fq;
#pragma unroll
        for (int ai = 0; ai < 2; ++ai)
#pragma unroll
            for (int m = 0; m < 4; ++m) { const size_t row = (size_t)(row0 + ai * HALF + m * 16);
                const float rv = __builtin_amdgcn_rsqf(rowss2[row] * (1.0f / 1024.0f) + eps);
#pragma unroll
                for (int bj = 0; bj < 2; ++bj) { const size_t off = row * 1024 + col0 + bj * HALF;
                    const u32x4 xw = *(const u32x4*)(aple + row * 1280 + 256 + col0 + bj * HALF);
                    const f32x4 x0 = {bf_lo(xw.x), bf_hi(xw.x), bf_lo(xw.y), bf_hi(xw.y)}, x1 = {bf_lo(xw.z), bf_hi(xw.z), bf_lo(xw.w), bf_hi(xw.w)};
                    const u32x4 pw = *(const u32x4*)(pp + off);
                    const f32x4 a0 = acc[ai][bj][m][0] * rv, a1 = acc[ai][bj][m][1] * rv;
                    f32x4 o0, o1;
                    o0[0] = x0[0] + sigmoidf_(a0[0]) * bf_lo(pw.x); o0[1] = x0[1] + sigmoidf_(a0[1]) * bf_hi(pw.x);
                    o0[2] = x0[2] + sigmoidf_(a0[2]) * bf_lo(pw.y); o0[3] = x0[3] + sigmoidf_(a0[3]) * bf_hi(pw.y);
                    o1[0] = x1[0] + sigmoidf_(a1[0]) * bf_lo(pw.z); o1[1] = x1[1] + sigmoidf_(a1[1]) * bf_hi(pw.z);
                    o1[2] = x1[2] + sigmoidf_(a1[2]) * bf_lo(pw.w); o1[3] = x1[3] + sigmoidf_(a1[3]) * bf_hi(pw.w);
                    __builtin_nontemporal_store(o0, (f32x4*)(out + off)); __builtin_nontemporal_store(o1, (f32x4*)(out + off + 4)); } }
    }
};

__device__ __forceinline__ int key_enc(float s, int idx, int mask) { return (__float_as_int(s) & ~mask) | idx; }
__device__ __forceinline__ int key_dec(int k) { return k; }
__device__ __forceinline__ int kmax_(int a, int b) { int r; asm("v_max_f32_e32 %0, %1, %2" : "=v"(r) : "v"(a), "v"(b)); return r; }
__device__ __forceinline__ int kmin_(int a, int b) { int r; asm("v_min_f32_e32 %0, %1, %2" : "=v"(r) : "v"(a), "v"(b)); return r; }
__device__ __forceinline__ void ce_desc(int& a, int& b) { const int mx = kmax_(a, b), mn = kmin_(a, b); a = mx; b = mn; }
__device__ __forceinline__ void sort16_desc(int (&v)[16]) {
#define CE_(i, j) ce_desc(v[i], v[j])
    CE_(0,13); CE_(1,12); CE_(2,15); CE_(3,14); CE_(4,8); CE_(5,6); CE_(7,11); CE_(9,10);
    CE_(0,5); CE_(1,7); CE_(2,9); CE_(3,4); CE_(6,13); CE_(8,14); CE_(10,15); CE_(11,12);
    CE_(0,1); CE_(2,3); CE_(4,5); CE_(6,8); CE_(7,9); CE_(10,11); CE_(12,13); CE_(14,15);
    CE_(0,2); CE_(1,3); CE_(4,10); CE_(5,11); CE_(6,7); CE_(8,9); CE_(12,14); CE_(13,15);
    CE_(1,2); CE_(3,12); CE_(4,6); CE_(5,7); CE_(8,10); CE_(9,11); CE_(13,14);
    CE_(1,4); CE_(2,6); CE_(5,8); CE_(7,10); CE_(9,13); CE_(11,14);
    CE_(2,4); CE_(3,6); CE_(9,12); CE_(11,13);
    CE_(3,5); CE_(6,8); CE_(7,9); CE_(10,12);
    CE_(3,4); CE_(5,6); CE_(7,8); CE_(9,10); CE_(11,12);
    CE_(6,7); CE_(8,9);
#undef CE_
}
template <int N> __device__ __forceinline__ void bitonic_sort_desc(int (&v)[N]) {
#pragma unroll
    for (int k = 2; k <= N; k <<= 1)
#pragma unroll
        for (int j = k >> 1; j > 0; j >>= 1)
#pragma unroll
            for (int i = 0; i < N; ++i) { const int l = i ^ j; if (l > i) { if ((i & k) == 0) ce_desc(v[i], v[l]); else ce_desc(v[l], v[i]); } }
}
__device__ __forceinline__ void merge16_desc(int (&a)[16], const int (&b)[16]) {
#pragma unroll
    for (int i = 0; i < 16; ++i) a[i] = kmax_(a[i], b[15 - i]);
#pragma unroll
    for (int j = 8; j > 0; j >>= 1)
#pragma unroll
        for (int i = 0; i < 16; ++i) { const int l = i ^ j; if (l > i) ce_desc(a[i], a[l]); }
}

struct EpiTopk {
    static constexpr bool PERM = true, AFTER_DRAIN = true, MIDHOOK = false;
    const float* rowss; unsigned short* IDX; float* GW; float eps;
    static constexpr int LDW = 132;
    __device__ __forceinline__ void fused(const f32x4 (&acc)[2][2][4][2], const Unit& u, int wr, int wc, int fr, int fq, PG8_LAS unsigned char* lds, int wid, int lane) const {
        PG8_LAS float* S = (PG8_LAS float*)lds;
        const int tid = wid * 64 + lane, trow = tid >> 1, half = tid & 1;
        float rinv[2][4];
#pragma unroll
        for (int ai = 0; ai < 2; ++ai)
#pragma unroll
            for (int m = 0; m < 4; ++m) rinv[ai][m] = __builtin_amdgcn_rsqf(rowss[u.pm * BM + ai * HALF + wr * 64 + m * 16 + fr] * (1.0f / 1024.0f) + eps);
        int L[2][16];
#pragma unroll
        for (int p = 0; p < 2; ++p) {
#pragma unroll
            for (int ai = 0; ai < 2; ++ai)
#pragma unroll
                for (int m = 0; m < 4; ++m) { const int r = ai * HALF + wr * 64 + m * 16 + fr; PG8_LAS float* sp = S + r * LDW + wc * 32 + 8 * fq;
                    *(PG8_LAS f32x4*)sp = acc[ai][p][m][0] * rinv[ai][m]; *(PG8_LAS f32x4*)(sp + 4) = acc[ai][p][m][1] * rinv[ai][m]; }
            __syncthreads();
            int run[16];
            const PG8_LAS float* rp = S + trow * LDW + half * 64;
#pragma unroll
            for (int q = 0; q < 4; ++q) {
                int gq[16];
#pragma unroll
                for (int i4 = 0; i4 < 4; ++i4) { const f32x4 v = *(const PG8_LAS f32x4*)(rp + q * 16 + i4 * 4);
#pragma unroll
                    for (int j = 0; j < 4; ++j) gq[i4 * 4 + j] = key_enc(v[j], half * 64 + q * 16 + i4 * 4 + j, 0x7f); }
                sort16_desc(gq);
                if (q == 0) {
#pragma unroll
                    for (int i = 0; i < 16; ++i) run[i] = gq[i];
                } else merge16_desc(run, gq);
            }
            int o[16];
#pragma unroll
            for (int i = 0; i < 16; ++i) o[i] = __shfl_xor(run[i], 1);
            merge16_desc(run, o);
#pragma unroll
            for (int i = 0; i < 16; ++i) L[p][i] = run[i];
            __syncthreads();
        }
        float v1[16], v2[16];
        PG8_LAS unsigned char* tb = lds + tid * 32;
#pragma unroll
        for (int i = 0; i < 16; ++i) { const int b1 = key_dec(L[0][i]), b2 = key_dec(L[1][i]); v1[i] = __int_as_float(b1 & ~0x7f); v2[i] = __int_as_float(b2 & ~0x7f);
            tb[i] = (unsigned char)(b1 & 0x7f); tb[16 + i] = (unsigned char)(b2 & 0x7f); }
        const int NEG = (int)0xff800000;
        int X[16], Y[16], Z[16];
        const bool hb = half != 0;
#define CAND(iA, jA, iB, jB) key_enc((hb ? v1[iB] : v1[iA]) + (hb ? v2[jB] : v2[jA]), hb ? ((iB) * 16 + (jB)) : ((iA) * 16 + (jA)), 0xff)
#pragma unroll
        for (int j = 0; j < 16; ++j) { if (j < 8) X[j] = CAND(0, j, 1, j); else { const int k0 = key_enc(v1[0] + v2[j], j, 0xff); X[j] = hb ? NEG : k0; } }
        {
            constexpr int yi[16] = {2, 2, 2, 2, 2, 3, 3, 3, 3, 4, 4, 4, 5, 5, 6, 6}, yj[16] = {0, 1, 2, 3, 4, 0, 1, 2, 3, 0, 1, 2, 0, 1, 0, 1};
#pragma unroll
            for (int n = 0; n < 16; ++n) { const int kb = key_enc(v1[yi[n]] + v2[yj[n]], yi[n] * 16 + yj[n], 0xff);
                if (n < 8) { const int ka = key_enc(v1[8 + n] + v2[0], (8 + n) * 16, 0xff); Y[n] = hb ? kb : ka; } else Y[n] = hb ? kb : NEG; }
        }
#pragma unroll
        for (int n = 0; n < 16; ++n) { if (n < 2) { const int kb = key_enc(v1[7] + v2[n], 7 * 16 + n, 0xff); Z[n] = hb ? kb : NEG; } else Z[n] = NEG; }
#undef CAND
        sort16_desc(Y);
        merge16_desc(X, Y); merge16_desc(X, Z);
        int o2[16];
#pragma unroll
        for (int i = 0; i < 16; ++i) o2[i] = __shfl_xor(X[i], 1);
        merge16_desc(X, o2);
        float sv[16], e[16]; float sum = 0.f;
#pragma unroll
        for (int i = 0; i < 16; ++i) { sv[i] = __int_as_float(key_dec(X[i]) & ~0xff); }
#pragma unroll
        for (int i = 0; i < 16; ++i) { e[i] = __builtin_amdgcn_exp2f((sv[i] - sv[0]) * 1.4426950408889634f); sum += e[i]; }
        const float rs = 1.0f / sum;
        asm volatile("s_waitcnt lgkmcnt(0)" ::: "memory");
        if (!hb) {
            const size_t ob = (size_t)(u.pm * BM + trow) * 128 + u.pn * 16;
            unsigned ids[16];
#pragma unroll
            for (int i4 = 0; i4 < 4; ++i4) { f32x4 gv;
#pragma unroll
                for (int j = 0; j < 4; ++j) { const int i = i4 * 4 + j; const int pid = key_dec(X[i]) & 0xff; const int i1 = tb[pid >> 4], i2 = tb[16 + (pid & 15)];
                    ids[i] = (unsigned)(i1 * 128 + i2); gv[j] = e[i] * rs; }
                *(f32x4*)(GW + ob + i4 * 4) = gv; }
            *(u32x4*)(IDX + ob) = (u32x4){ids[0] | (ids[1] << 16), ids[2] | (ids[3] << 16), ids[4] | (ids[5] << 16), ids[6] | (ids[7] << 16)};
            *(u32x4*)(IDX + ob + 8) = (u32x4){ids[8] | (ids[9] << 16), ids[10] | (ids[11] << 16), ids[12] | (ids[13] << 16), ids[14] | (ids[15] << 16)};
        }
        __syncthreads();
    }
};
}
#include <hip/hip_bf16.h>
#include <cmath>
namespace attn_body {
using bf16=__hip_bfloat16;
using bf16x8=__attribute__((ext_vector_type(8)))short;
using s16x4=__attribute__((ext_vector_type(4)))short;
using f32x16=__attribute__((ext_vector_type(16)))float;
using u32x4=__attribute__((ext_vector_type(4)))unsigned;
constexpr int BATCH=8,NHEAD=8,NKV=2,SEQ=4096,D=64,DM=768;
constexpr int NW=8,QBLK=32,QB=QBLK*NW,KVBLK=64,NQB=SEQ/QB;
constexpr int ATTN_PITCH=DM, ATTN_UNIT_ROWS=QB, ODM=1024;
__device__ __forceinline__ int crow(int r,int hi){return (r&3)+8*(r>>2)+4*hi;}
#define SBAR() __builtin_amdgcn_sched_barrier(0)
__device__ __forceinline__ void cmask(f32x16&p0,f32x16&p1,int jb,int qrel,int hi){
  const float NEG=-INFINITY; int kb=64*jb+4*hi;
  #pragma unroll
  for(int r=0;r<16;++r){int kv=kb+(r&3)+8*(r>>2); if(kv>qrel)p0[r]=NEG; if(kv+32>qrel)p1[r]=NEG;}
}

constexpr int NSLOT=3, SLOTB=8192;
constexpr int LDS_K=0, LDS_V=NSLOT*SLOTB, LDS_WS=2*NSLOT*SLOTB, LDS_OST=LDS_WS+NW*64*4, LDS_BYTES=LDS_OST+NW*4096;
constexpr float C2=0.125f*1.4426950408889634f;
__device__ __forceinline__ void glds16(const void*gsrc,unsigned lds_dst){unsigned keep;
  asm volatile("s_mov_b32 %0, m0\n\ts_mov_b32 m0, %2\n\ts_nop 0\n\tglobal_load_lds_dwordx4 %1, off\n\ts_mov_b32 m0, %0":"=&s"(keep):"v"(gsrc),"s"(lds_dst):"memory");}
__device__ __forceinline__ float max3f(float a,float b,float c){float r;asm("v_max3_f32 %0, %1, %2, %3":"=v"(r):"v"(a),"v"(b),"v"(c));return r;}
__device__ __forceinline__ float max2f(float a,float b){float r;asm("v_max_f32_e32 %0, %1, %2":"=v"(r):"v"(a),"v"(b));return r;}
__device__ __forceinline__ float fadd_s(float a,float b){float r;asm("v_add_f32_e32 %0, %1, %2":"=v"(r):"v"(a),"v"(b));return r;}
__device__ __forceinline__ float fsub_s(float a,float b){float r;asm("v_sub_f32_e32 %0, %1, %2":"=v"(r):"v"(a),"v"(b));return r;}
typedef float f32x2_t __attribute__((ext_vector_type(2))); typedef __bf16 bf16x2_t __attribute__((ext_vector_type(2)));
__device__ __forceinline__ unsigned cvtpk_s(float lo,float hi){f32x2_t v={lo,hi};bf16x2_t b=__builtin_convertvector(v,bf16x2_t);return __builtin_bit_cast(unsigned,b);}
#define WAIT_BAR(N) asm volatile("s_waitcnt vmcnt(" #N ") lgkmcnt(0)\n\ts_barrier":::"memory")

__device__ __forceinline__ void qkt(f32x16&p0,f32x16&p1,const char*Kslot,const bf16x8*qr,const f32x16&negm,int r32,int hi){
  const char*kb=Kslot+hi*1024+r32*16;
  #pragma unroll
  for(int d0=0;d0<4;++d0){
    const bf16x8 b0=*reinterpret_cast<const bf16x8*>(kb+d0*2048);
    const bf16x8 b1=*reinterpret_cast<const bf16x8*>(kb+d0*2048+512);
    if(d0==0){p0=__builtin_amdgcn_mfma_f32_32x32x16_bf16(b0,qr[0],negm,0,0,0);p1=__builtin_amdgcn_mfma_f32_32x32x16_bf16(b1,qr[0],negm,0,0,0);}
    else{p0=__builtin_amdgcn_mfma_f32_32x32x16_bf16(b0,qr[d0],p0,0,0,0);p1=__builtin_amdgcn_mfma_f32_32x32x16_bf16(b1,qr[d0],p1,0,0,0);}}
}
typedef __attribute__((address_space(3))) const char* lds_cptr;
typedef short v4i16_t __attribute__((ext_vector_type(4)));
__device__ __forceinline__ void kload8(bf16x8*kf,lds_cptr kp){
  kf[0]=*(const __attribute__((address_space(3))) bf16x8*)(kp);      kf[1]=*(const __attribute__((address_space(3))) bf16x8*)(kp+512);
  kf[2]=*(const __attribute__((address_space(3))) bf16x8*)(kp+2048); kf[3]=*(const __attribute__((address_space(3))) bf16x8*)(kp+2560);
  kf[4]=*(const __attribute__((address_space(3))) bf16x8*)(kp+4096); kf[5]=*(const __attribute__((address_space(3))) bf16x8*)(kp+4608);
  kf[6]=*(const __attribute__((address_space(3))) bf16x8*)(kp+6144); kf[7]=*(const __attribute__((address_space(3))) bf16x8*)(kp+6656);
}
__device__ __forceinline__ void kload2(bf16x8*kf,lds_cptr kp,int j){ kf[2*j]=*(const __attribute__((address_space(3))) bf16x8*)(kp+j*2048); kf[2*j+1]=*(const __attribute__((address_space(3))) bf16x8*)(kp+j*2048+512); }
__device__ __forceinline__ s16x4 vtr(lds_cptr p){ return __builtin_bit_cast(s16x4,__builtin_amdgcn_ds_read_tr16_b64_v4i16((__attribute__((address_space(3))) v4i16_t*)p)); }
__device__ __forceinline__ float rowmax(const f32x16&p0,const f32x16&p1){
  float a=max3f(p0[0],p0[1],p1[0]),b=max3f(p0[2],p0[3],p1[1]);a=max3f(a,p1[2],p1[3]);
  #pragma unroll
  for(int r=4;r<16;r+=4){a=max3f(a,p0[r],p0[r+1]);b=max3f(b,p0[r+2],p0[r+3]);a=max3f(a,p1[r],p1[r+1]);b=max3f(b,p1[r+2],p1[r+3]);}
  const float m=max2f(a,b);
  auto rr=__builtin_amdgcn_permlane32_swap(__float_as_uint(m),__float_as_uint(m),false,false);
  return max2f(__uint_as_float(rr[0]),__uint_as_float(rr[1]));
}
__device__ __forceinline__ void pv(f32x16*o,int vb,bf16x8 pa0,bf16x8 pa1,bf16x8 pa2,bf16x8 pa3){
  #pragma unroll
  for(int d0=0;d0<2;++d0){s16x4 lo[4],hi[4];
    #pragma unroll
    for(int ks=0;ks<4;++ks){
      asm volatile("ds_read_b64_tr_b16 %0,%1 offset:%c2":"=&v"(lo[ks]):"v"(vb),"i"(d0*4096+ks*1024):"memory");
      asm volatile("ds_read_b64_tr_b16 %0,%1 offset:%c2":"=&v"(hi[ks]):"v"(vb),"i"(d0*4096+ks*1024+512):"memory");}
    asm volatile("s_waitcnt lgkmcnt(0)":::"memory");SBAR();
    #define PK(k) (bf16x8){lo[k][0],lo[k][1],lo[k][2],lo[k][3],hi[k][0],hi[k][1],hi[k][2],hi[k][3]}
    o[d0]=__builtin_amdgcn_mfma_f32_32x32x16_bf16(pa0,PK(0),o[d0],0,0,0);
    o[d0]=__builtin_amdgcn_mfma_f32_32x32x16_bf16(pa1,PK(1),o[d0],0,0,0);
    o[d0]=__builtin_amdgcn_mfma_f32_32x32x16_bf16(pa2,PK(2),o[d0],0,0,0);
    o[d0]=__builtin_amdgcn_mfma_f32_32x32x16_bf16(pa3,PK(3),o[d0],0,0,0);
    #undef PK
  }
}

#ifndef ATTN_STORE16
#define ATTN_STORE16(p,v) (*(u32x4*)(p)=(v))
#endif
template<int THRL> __device__ __forceinline__ void attn_unit(int wave_id,int b,int h,int qb,const bf16*Q,const bf16*__restrict__ K,const bf16*__restrict__ V,bf16*O,char*shm){
  int tid_; asm volatile("v_mbcnt_lo_u32_b32 %0, -1, 0\n\tv_mbcnt_hi_u32_b32 %0, -1, %0":"=v"(tid_)); tid_+=wave_id*64; const int tid=tid_,lane=tid&63,r32=lane&31,hi=lane>>5; const int wid=__builtin_amdgcn_readfirstlane(tid>>6);
  const long rowbase=(long)b*SEQ; const int q0=qb*QB;
  const bf16*Qw=Q+(rowbase+q0+wid*QBLK)*DM+h*D;
  const bf16*Kh=K+rowbase*DM+(h/(NHEAD/NKV))*D,*Vh=V+rowbase*DM+(h/(NHEAD/NKV))*D;
  const unsigned lds0=(unsigned)(uintptr_t)shm;
  float*wsf=(float*)(shm+LDS_WS)+wid*64;
  const bf16*ksrc=Kh+(long)lane*DM+wid*8;
  const bf16*vsrc=Vh+(long)(16*(wid&3)+(lane>>2))*DM+(wid>>2)*32+(lane&3)*8;
  const unsigned kdst=lds0+LDS_K+wid*1024, vdst=lds0+LDS_V+wid*1024;
  #define DMA_K(t,slot) glds16(ksrc+(long)(t)*KVBLK*DM,(unsigned)__builtin_amdgcn_readfirstlane(kdst+(slot)))
  #define DMA_V(t,slot) glds16(vsrc+(long)(t)*KVBLK*DM,(unsigned)__builtin_amdgcn_readfirstlane(vdst+(slot)))
  const int vb0=(int)(lds0+LDS_V)+((lane>>4)&1)*32+(lane&3)*8+(4*hi+((lane&15)>>2))*64;
  const char*Kbase=shm+LDS_K; bf16x8 kf[8];
  const lds_cptr shm3=(lds_cptr)shm; const lds_cptr kp0=shm3+LDS_K+hi*1024+r32*16; const lds_cptr vp0=shm3+LDS_V+((lane>>4)&1)*32+(lane&3)*8+(4*hi+((lane&15)>>2))*64;
  constexpr int NT=SEQ/KVBLK;
  DMA_K(0,0);DMA_V(0,0);DMA_K(1,SLOTB);
  bf16x8 qr[4];
  #pragma unroll
  for(int d0=0;d0<4;++d0)qr[d0]=*reinterpret_cast<const bf16x8*>(&Qw[(long)r32*DM+d0*16+hi*8]);
  float mhat=0.f,l_reg=0.f;f32x16 o[2];o[0]=f32x16{};o[1]=f32x16{};f32x16 negm=f32x16{};asm volatile("":"+v"(negm));
  const int qrel=wid*QBLK+r32;
  #define CMASK(P0,P1,t) do{}while(0)
  bool resc=false;
  #define START(P0,P1) do{ const float rm=rowmax(P0,P1); resc=false; \
    { const float dl=rm; mhat=fadd_s(mhat,dl); \
      _Pragma("unroll") for(int r=0;r<16;++r){P0[r]=fsub_s(P0[r],dl);P1[r]=fsub_s(P1[r],dl);} \
      _Pragma("unroll") for(int r=0;r<16;++r)negm[r]=-mhat; asm volatile("":"+v"(negm)); } \
    _Pragma("unroll") for(int r=0;r<16;++r)P0[r]=__builtin_amdgcn_exp2f(P0[r]); }while(0)
  #define RESC() do{ if(resc){ asm volatile("s_waitcnt lgkmcnt(0)":::"memory"); \
      _Pragma("unroll") for(int d_=0;d_<2;++d_) _Pragma("unroll") for(int r=0;r<16;++r)o[d_][r]*=wsf[crow(r,hi)]; } }while(0)
  f32x16 pA0,pA1,pB0,pB1;
  int sl_prev=0,sl_cur=0,sl_next=SLOTB;
  #define ROT() do{sl_prev=sl_cur;sl_cur=sl_next;sl_next=(sl_next==(NSLOT-1)*SLOTB)?0:sl_next+SLOTB;}while(0)
  DMA_K(2,2*SLOTB);
  WAIT_BAR(3);
  qkt(pA0,pA1,Kbase,qr,negm,r32,hi);asm volatile("s_nop 15\n\ts_nop 7":"+v"(pA0),"+v"(pA1));CMASK(pA0,pA1,0);
  START(pA0,pA1);
  _Pragma("unroll") for(int r=0;r<16;++r)pA1[r]=__builtin_amdgcn_exp2f(pA1[r]);
  WAIT_BAR(0);
  DMA_K(3,0);DMA_V(1,SLOTB);
  ROT();
  kload8(kf,kp0+sl_cur);
  WAIT_BAR(2);
  s16x4 vlo[8],vhi[8]; u32x4 pw0,pw1,pw2,pw3;
  #define PKW(P,B) cvtpk_s(P[B],P[B+1])
  #define PAF(k) __builtin_bit_cast(bf16x8,pw##k)
  #define VFR(i) (bf16x8){vlo[i][0],vlo[i][1],vlo[i][2],vlo[i][3],vhi[i][0],vhi[i][1],vhi[i][2],vhi[i][3]}
  #define PIN(x) asm volatile("":"+v"(x))
  #define MX3(a,b,c) __builtin_fmaxf(__builtin_fmaxf((a),(b)),(c))
  #define GAPA(MF,A0,A1,A2,A3,W0,W1,PW) do{ MF; sacc+=A0; sacc+=A1; sacc+=A2; sacc+=A3; PIN(sacc); W0; W1; PIN(PW); SBAR(); }while(0)
  #define EX(v) __builtin_amdgcn_exp2f(v)
  #define GAPB(MF,X,B) do{ MF; X[B]=EX(X[B]); X[B+1]=EX(X[B+1]); X[B+2]=EX(X[B+2]); X[B+3]=EX(X[B+3]); PIN(X); SBAR(); }while(0)
  #define VRD(i) do{ vlo[i]=vtr(vp_+(((i)>>2)*4096+((i)&3)*1024)); vhi[i]=vtr(vp_+(((i)>>2)*4096+((i)&3)*1024+512)); }while(0)
  #define KRD(G,j) do{ if(G){ kload2(kf,kp0+sl_next,j); SBAR(); } }while(0)
  #define STEP(C0,C1,P0,P1,t,GK,GV,GL) do{ SBAR(); \
    const lds_cptr vp_=vp0+sl_prev; \
    VRD(0); SBAR(); float sacc=(P0[0]+P0[1]); \
    GAPA(C0=__builtin_amdgcn_mfma_f32_32x32x16_bf16(kf[0],qr[0],negm,0,0,0), P0[2],P0[3],P0[4],P0[5],     pw0[0]=PKW(P0,0), pw0[1]=PKW(P0,2), pw0); \
    VRD(4); SBAR(); GAPA(C1=__builtin_amdgcn_mfma_f32_32x32x16_bf16(kf[1],qr[0],negm,0,0,0), P0[6],P0[7],P0[8],P0[9],     pw0[2]=PKW(P0,4), pw0[3]=PKW(P0,6), pw0); \
    VRD(1); SBAR(); GAPA(C0=__builtin_amdgcn_mfma_f32_32x32x16_bf16(kf[2],qr[1],C0,0,0,0),   P0[10],P0[11],P0[12],P0[13], pw1[0]=PKW(P0,8), pw1[1]=PKW(P0,10), pw1); \
    VRD(5); SBAR(); GAPA(C1=__builtin_amdgcn_mfma_f32_32x32x16_bf16(kf[3],qr[1],C1,0,0,0),   P0[14],P0[15],P1[0],P1[1],   pw1[2]=PKW(P0,12),pw1[3]=PKW(P0,14), pw1); \
    VRD(2); SBAR(); GAPA(C0=__builtin_amdgcn_mfma_f32_32x32x16_bf16(kf[4],qr[2],C0,0,0,0),   P1[2],P1[3],P1[4],P1[5],     pw2[0]=PKW(P1,0), pw2[1]=PKW(P1,2), pw2); \
    VRD(6); SBAR(); GAPA(C1=__builtin_amdgcn_mfma_f32_32x32x16_bf16(kf[5],qr[2],C1,0,0,0),   P1[6],P1[7],P1[8],P1[9],     pw2[2]=PKW(P1,4), pw2[3]=PKW(P1,6), pw2); \
    VRD(3); SBAR(); GAPA(C0=__builtin_amdgcn_mfma_f32_32x32x16_bf16(kf[6],qr[3],C0,0,0,0),   P1[10],P1[11],P1[12],P1[13], pw3[0]=PKW(P1,8), pw3[1]=PKW(P1,10), pw3); \
    VRD(7); SBAR(); GAPA(C1=__builtin_amdgcn_mfma_f32_32x32x16_bf16(kf[7],qr[3],C1,0,0,0),   P1[14],P1[15],0.f,0.f,       pw3[2]=PKW(P1,12),pw3[3]=PKW(P1,14), pw3); \
    l_reg+=sacc; \
    if(GK){DMA_K((t)+3,sl_cur);} if(GV){DMA_V((t)+1,sl_next);} \
    CMASK(C0,C1,t); \
    { float a=MX3(C0[0],C0[1],C1[0]),b=MX3(C0[2],C0[3],C1[1]); a=MX3(a,C1[2],C1[3]); \
      _Pragma("unroll") for(int r=4;r<16;r+=4){a=MX3(a,C0[r],C0[r+1]);b=MX3(b,C0[r+2],C0[r+3]);a=MX3(a,C1[r],C1[r+1]);b=MX3(b,C1[r+2],C1[r+3]);} \
      float rm=__builtin_fmaxf(a,b); { auto rr=__builtin_amdgcn_permlane32_swap(__float_as_uint(rm),__float_as_uint(rm),false,false); rm=__builtin_fmaxf(__uint_as_float(rr[0]),__uint_as_float(rr[1])); } \
      resc=false; \
      if(__builtin_expect(__any(rm>(float)THRL),0)){ const float dl=__builtin_fmaxf(rm,0.f); mhat+=dl; \
        _Pragma("unroll") for(int r=0;r<16;++r){C0[r]-=dl;C1[r]-=dl;} \
        _Pragma("unroll") for(int r=0;r<16;++r)negm[r]=-mhat; asm volatile("":"+v"(negm)); \
        const float f=__builtin_amdgcn_exp2f(-dl); l_reg*=f; if(hi==0)wsf[r32]=f; resc=true; } } \
    SBAR(); \
    GAPB(o[0]=__builtin_amdgcn_mfma_f32_32x32x16_bf16(PAF(0),VFR(0),o[0],0,0,0), C0,0); \
    GAPB(o[1]=__builtin_amdgcn_mfma_f32_32x32x16_bf16(PAF(0),VFR(4),o[1],0,0,0), C0,4); \
    KRD(GL,0); GAPB(o[0]=__builtin_amdgcn_mfma_f32_32x32x16_bf16(PAF(1),VFR(1),o[0],0,0,0), C0,8); \
    KRD(GL,1); GAPB(o[1]=__builtin_amdgcn_mfma_f32_32x32x16_bf16(PAF(1),VFR(5),o[1],0,0,0), C0,12); \
    KRD(GL,2); GAPB(o[0]=__builtin_amdgcn_mfma_f32_32x32x16_bf16(PAF(2),VFR(2),o[0],0,0,0), C1,0); \
    KRD(GL,3); GAPB(o[1]=__builtin_amdgcn_mfma_f32_32x32x16_bf16(PAF(2),VFR(6),o[1],0,0,0), C1,4); \
    GAPB(o[0]=__builtin_amdgcn_mfma_f32_32x32x16_bf16(PAF(3),VFR(3),o[0],0,0,0), C1,8); \
    GAPB(o[1]=__builtin_amdgcn_mfma_f32_32x32x16_bf16(PAF(3),VFR(7),o[1],0,0,0), C1,12); \
    }while(0)
  int t=1;
  #undef CMASK
  #define CMASK(P0,P1,t) do{}while(0)
  for(;t+5<NT;t+=2){
    STEP(pB0,pB1,pA0,pA1,t,true,true,true);     WAIT_BAR(2); RESC(); ROT();
    STEP(pA0,pA1,pB0,pB1,t+1,true,true,true);   WAIT_BAR(2); RESC(); ROT();
  }
  #undef CMASK
  #define CMASK(P0,P1,t) do{}while(0)
  #define ENDW(tt) do{ if((tt)+3<NT){WAIT_BAR(2);} else if((tt)+2<NT){WAIT_BAR(1);} else {WAIT_BAR(0);} }while(0)
  for(;t+1<NT;t+=2){
    STEP(pB0,pB1,pA0,pA1,t,(t+3<NT),(t+1<NT),(t+1<NT));       ENDW(t);   RESC(); ROT();
    STEP(pA0,pA1,pB0,pB1,t+1,(t+4<NT),(t+2<NT),(t+2<NT));     ENDW(t+1); RESC(); ROT();
  }
  STEP(pB0,pB1,pA0,pA1,NT-1,false,false,false); RESC();
  { float sacc=pB0[0]+pB0[1]; _Pragma("unroll") for(int r=2;r<16;++r)sacc+=pB0[r]; _Pragma("unroll") for(int r=0;r<16;++r)sacc+=pB1[r]; l_reg+=sacc;
    pw0=(u32x4){PKW(pB0,0),PKW(pB0,2),PKW(pB0,4),PKW(pB0,6)};pw1=(u32x4){PKW(pB0,8),PKW(pB0,10),PKW(pB0,12),PKW(pB0,14)};pw2=(u32x4){PKW(pB1,0),PKW(pB1,2),PKW(pB1,4),PKW(pB1,6)};pw3=(u32x4){PKW(pB1,8),PKW(pB1,10),PKW(pB1,12),PKW(pB1,14)};
    SBAR(); pv(o,vb0+sl_cur,PAF(0),PAF(1),PAF(2),PAF(3)); }
  #undef PKW
  #undef PAF
  #undef VFR
  #undef PIN
  #undef MX3
  #undef GAPA
  #undef GAPB
  #undef EX
  #undef VRD
  #undef KRD
  #undef STEP
  #undef ENDW
  {auto rr=__builtin_amdgcn_permlane32_swap(__float_as_uint(l_reg),__float_as_uint(l_reg),false,false);l_reg=__uint_as_float(rr[0])+__uint_as_float(rr[1]);}
  if(hi==0)wsf[32+r32]=l_reg;asm volatile("s_waitcnt lgkmcnt(0)":::"memory");
  float rli[16];
  #pragma unroll
  for(int r=0;r<16;++r)rli[r]=__builtin_amdgcn_rcpf(wsf[32+crow(r,hi)]);
  bf16*Ow=O+(rowbase+q0+wid*QBLK)*ODM+h*D;
  { bf16*stg=(bf16*)(shm+LDS_OST)+wid*2048;
    #pragma unroll
    for(int r=0;r<16;++r){const int orow=crow(r,hi);
      #pragma unroll
      for(int d0=0;d0<2;++d0)stg[orow*64+d0*32+r32]=__float2bfloat16(o[d0][r]*rli[r]);}
    asm volatile("s_waitcnt lgkmcnt(0)":::"memory");
    #pragma unroll
    for(int i=0;i<4;++i){const int row=i*8+(lane>>3),ch=lane&7; const u32x4 v=*(const u32x4*)(stg+row*64+ch*8); ATTN_STORE16(Ow+(long)row*ODM+ch*8,v);} }
  asm volatile("s_waitcnt lgkmcnt(0)\n\ts_barrier":::"memory");
  #undef DMA_K
  #undef DMA_V
  #undef CMASK
  #undef START
  #undef RESC
  #undef ROT
}
constexpr int ATTN_LDS_BYTES=LDS_BYTES;
struct AttnTensors { const bf16* Q; const bf16* K; const bf16* V; bf16* O; };
struct AttnUnit { int bh; int qb; };
__device__ __forceinline__ void unit_decode(int n,AttnUnit&u){ const int grp=n>>6,wi=n&63; const int b=grp>>1,kvh=grp&1; u.bh=b*NHEAD+kvh*(NHEAD/NKV)+(wi>>4); u.qb=wi&15; }
#undef SBAR
#undef WAIT_BAR
}
constexpr int NWAVES = 8;
constexpr int BATCH = 8, SEQ = 4096, DMODEL = 1024, T = BATCH * SEQ;
constexpr int INW = 5376, QKVW = 768, HGW = 2560, GATEW = 2048;
constexpr int NEXP = 16384, PLED = 256;
constexpr float EPS = 1e-6f;
constexpr size_t MiB = 1u << 20;
constexpr size_t WS_CTL = 0, CTL_ZERO_BYTES = 1 * MiB;
constexpr size_t WS_ROPE = 1 * MiB;
constexpr size_t WS_GINV = WS_ROPE + 256 * 1024, WS_RMS = WS_GINV + 65536 * 4;
constexpr size_t WS_WIN = 2 * MiB;
constexpr size_t WS_WUA = 13 * MiB;
constexpr size_t WS_WOUT = 15 * MiB;
constexpr size_t WS_WPEER = 17 * MiB;
constexpr size_t WS_WPG = 21 * MiB;
constexpr size_t WS_XN = 24 * MiB;
constexpr size_t WS_QKV = 88 * MiB;
constexpr size_t WS_HG = 136 * MiB;
constexpr size_t WS_GATE = 296 * MiB;
constexpr size_t WS_END = 507 * MiB;
constexpr size_t WS_UB8 = 424 * MiB, WS_VB8 = 440 * MiB, WS_US = 456 * MiB;
constexpr size_t WS_IDX = WS_HG + 80 * MiB, WS_GW = WS_HG + 96 * MiB, WS_W = WS_HG + 112 * MiB;
constexpr size_t WS_H8 = 474 * MiB, WS_TSC = 506 * MiB;
constexpr size_t WS_X1B = WS_GATE, WS_PP = WS_GATE + 64 * MiB;
constexpr int CW_BAR = 4096;
constexpr int CW_QUEUE = 16384;
constexpr int CW_ROWSS = 131072;
constexpr int CW_ROWSS2 = CW_ROWSS + 32768;
static_assert((CW_ROWSS2 + 32768) * 4 <= (int)CTL_ZERO_BYTES, "ctl");
constexpr int SCR_BYTES = 147456;
constexpr int LDSCTL_OFF = SCR_BYTES, MISC_OFF = LDSCTL_OFF + 320;
constexpr int LDS_BYTES = SCR_BYTES + 1024;

#define GAS __attribute__((address_space(1)))
#define LAS __attribute__((address_space(3)))
typedef unsigned short bf16;
typedef unsigned v4u __attribute__((ext_vector_type(4)));
typedef unsigned v2u __attribute__((ext_vector_type(2)));
typedef float f32x4 __attribute__((ext_vector_type(4)));
typedef float f32x16 __attribute__((ext_vector_type(16)));
typedef short bf16x8 __attribute__((ext_vector_type(8)));
typedef GAS unsigned gu32;
#define RLX_AGENT __ATOMIC_RELAXED, __HIP_MEMORY_SCOPE_AGENT
#define LDS_WAIT() asm volatile("s_waitcnt lgkmcnt(0)" ::: "memory")
#define VM_WAIT() asm volatile("s_waitcnt vmcnt(0)" ::: "memory")
#define DI __device__ __forceinline__
DI int lane_id() { int l; asm volatile("v_mbcnt_lo_u32_b32 %0, -1, 0\n\tv_mbcnt_hi_u32_b32 %0, -1, %0" : "=v"(l)); return l; }
DI unsigned f2bf(float f) { unsigned u = __builtin_bit_cast(unsigned, f); return (u + 0x7fffu + ((u >> 16) & 1u)) >> 16; }
DI unsigned pk2(float lo, float hi) { typedef float f2 __attribute__((ext_vector_type(2))); typedef __bf16 b2 __attribute__((ext_vector_type(2))); f2 v = {lo, hi}; b2 b = __builtin_convertvector(v, b2); return __builtin_bit_cast(unsigned, b); }
DI float bflo(unsigned w) { return __uint_as_float(w << 16); }
DI float bfhi(unsigned w) { return __uint_as_float(w & 0xffff0000u); }
DI float fsigmoid(float x) { return __builtin_amdgcn_rcpf(1.0f + __builtin_amdgcn_exp2f(-1.4426950408889634f * x)); }
DI float fexp(float x) { return __builtin_amdgcn_exp2f(1.4426950408889634f * x); }
DI float wave_sum(float v) {
#pragma unroll
    for (int o = 1; o < 64; o <<= 1) v += __shfl_xor(v, o);
    return v;
}

#define XB_TMO      128
#define XB_XCNT(j)  (256  + 64 * (j))
#define XB_XSUB(j)  (1280 + 64 * (j))
#define XB_XGEN(j)  (2304 + 64 * (j))
#define XB_TOP      3328
#define XB_TOPGEN   3392
#define XCD_BAR_WORDS 3456
#define XB_SPIN_CAP (1u << 18)
DI unsigned xb_ld(unsigned* p)              { return __hip_atomic_load(p, __ATOMIC_RELAXED, __HIP_MEMORY_SCOPE_AGENT); }
DI unsigned xb_add(unsigned* p, unsigned v) { return __hip_atomic_fetch_add(p, v, __ATOMIC_RELAXED, __HIP_MEMORY_SCOPE_AGENT); }
DI unsigned xb_xcc_id() { return (unsigned)__builtin_amdgcn_s_getreg((3 << 11) | 20) & 0xFu; }
#define XB_SPIN(cond, bar) do { unsigned _sp = 0; while (cond) { __builtin_amdgcn_s_sleep(1); \
    if ((++_sp & 255u) == 0u) { if (xb_ld(&(bar)[XB_TMO])) break; if (_sp > XB_SPIN_CAP) { atomicAdd(&(bar)[XB_TMO], 1u); break; } } } } while (0)
struct XcdBarrier { unsigned* bar; unsigned x; volatile LAS unsigned* st; };
DI XcdBarrier xcd_barrier_post(unsigned* bar, volatile LAS unsigned* st, bool t0) {
    XcdBarrier b; b.bar = bar; b.x = xb_xcc_id(); b.st = st;
    if (t0) st[2] = xb_add(&bar[XB_XCNT(b.x)], 1u);
    return b;
}
DI void xcd_barrier_complete(unsigned* bar, unsigned x, unsigned& nloc, unsigned& nx) {
    const unsigned G = gridDim.x * gridDim.y * gridDim.z;
    unsigned sum, cnt, mine, sp = 0u;
    for (;;) {
        sum = 0u; cnt = 0u; mine = 0u;
#pragma unroll
        for (unsigned j = 0; j < 16; ++j) { const unsigned c = xb_ld(&bar[XB_XCNT(j)]); sum += c; cnt += (c > 0u) ? 1u : 0u; mine = (j == x) ? c : mine; }
        if (sum == G) break;
        __builtin_amdgcn_s_sleep(1);
        if ((++sp & 255u) == 0u) { if (xb_ld(&bar[XB_TMO])) break; if (sp > XB_SPIN_CAP) { atomicAdd(&bar[XB_TMO], 1u); break; } }
    }
    nloc = mine > 0u ? mine : 1u; nx = cnt > 0u ? cnt : 1u;
}
DI void xcd_barrier(const XcdBarrier& b, bool t0) {
    asm volatile("s_waitcnt vmcnt(0)" ::: "memory");
    __syncthreads();
    if (t0) {
        unsigned* bar = b.bar;
        __builtin_amdgcn_s_waitcnt(0);
        unsigned nloc = b.st[0], nx = b.st[1];
        if (nloc == 0u) { xcd_barrier_complete(bar, b.x, nloc, nx); b.st[0] = nloc; b.st[1] = nx; }
        const unsigned old = xb_add(&bar[XB_XSUB(b.x)], 1u);
        const unsigned gen = old / nloc;
        if (old + 1u == (gen + 1u) * nloc) {
            __builtin_amdgcn_fence(__ATOMIC_RELEASE, "agent");
            asm volatile("s_waitcnt vmcnt(0)" ::: "memory");
            const unsigned og = xb_add(&bar[XB_TOP], 1u);
            const unsigned tg = og / nx;
            if (og + 1u == (tg + 1u) * nx) xb_add(&bar[XB_TOPGEN], 1u);
            else XB_SPIN(xb_ld(&bar[XB_TOPGEN]) == tg, bar);
            __builtin_amdgcn_fence(__ATOMIC_ACQUIRE, "agent");
            xb_add(&bar[XB_XGEN(b.x)], 1u);
            asm volatile("s_waitcnt vmcnt(0)" ::: "memory");
        } else {
            XB_SPIN(xb_ld(&bar[XB_XGEN(b.x)]) == gen, bar);
            __builtin_amdgcn_fence(__ATOMIC_ACQUIRE, "agent");
            asm volatile("s_waitcnt vmcnt(0)" ::: "memory");
        }
    }
    __syncthreads();
}
DI void xcd_census(unsigned* bar, unsigned x, int& v, int& nx, int& nloc) {
    int vv = 0, cnt = 0, mine = 1;
#pragma unroll
    for (unsigned j = 0; j < 16; ++j) { const unsigned c = xb_ld(&bar[XB_XCNT(j)]); cnt += (c > 0u) ? 1 : 0; vv += (c > 0u && j < x) ? 1 : 0; if (j == x) mine = (int)c; }
    v = vv; nx = cnt > 0 ? cnt : 1; nloc = mine > 0 ? mine : 1;
}
DI void wg_l1_refresh(bool t0) {
    asm volatile("s_waitcnt vmcnt(0)" ::: "memory");
    __syncthreads();
    if (t0) { __builtin_amdgcn_fence(__ATOMIC_ACQUIRE, "agent"); asm volatile("s_waitcnt vmcnt(0)" ::: "memory"); }
    __syncthreads();
}

struct Frame {
    LAS unsigned char* lds;
    volatile LAS unsigned* MISC;
    gu32* ctl;
    int wave;
    int vcu, G;
    unsigned char* ws;
    float* out;
};
enum { I_X = 0, I_P, I_NORM_MIX, I_W_IN, I_Q_NORM, I_K_NORM, I_HG_LB, I_HG_ONORM, I_W_UP_ATT, I_W_UP_HG, I_W_OUT, I_NORM_FFN, I_PEER_WQ, I_PEER_SK, I_PEER_U, I_PEER_V, I_NORM_PLE, I_PLE_GATE, I_PLE_PROJ };
DI const float* inp(int k) {
    typedef const float* cfp;
    const __attribute__((address_space(4))) char* ka = (const __attribute__((address_space(4))) char*)__builtin_amdgcn_kernarg_segment_ptr();
    return *(const volatile __attribute__((address_space(4))) cfp*)(ka + 8 * k);
}

DI void p0_transpose_item(const float* W, int K, int N, bf16* WT, LAS float* scr, int item, int lane, const float* kgain = nullptr, int ldt = 0, int koff = 0) {
    if (ldt == 0) ldt = K;
    const int nblk = N / 32, kb = item / nblk, nb = item % nblk, k0 = 64 * kb, n0 = 32 * nb;
    float wv_[32];
#pragma unroll
    for (int i = 0; i < 32; ++i) { const int kk = 2 * i + (lane >> 5); wv_[i] = W[(size_t)(k0 + kk) * N + n0 + (lane & 31)]; }
#pragma unroll
    for (int i = 0; i < 32; ++i) { const int kk = 2 * i + (lane >> 5); scr[kk * 33 + (lane & 31)] = wv_[i] * (kgain ? kgain[k0 + kk] : 1.0f); }
    LDS_WAIT(); asm volatile("" ::: "memory");
    const int c = lane & 7;
#pragma unroll
    for (int j = 0; j < 4; ++j) { const int n = (lane >> 3) + 8 * j; const LAS float* s = scr + (8 * c) * 33 + n;
        v4u o; o.x = pk2(s[0 * 33], s[1 * 33]); o.y = pk2(s[2 * 33], s[3 * 33]); o.z = pk2(s[4 * 33], s[5 * 33]); o.w = pk2(s[6 * 33], s[7 * 33]);
        *(GAS v4u*)(WT + (size_t)(n0 + n) * ldt + koff + k0 + 8 * c) = o; }
    LDS_WAIT(); asm volatile("" ::: "memory");
}
DI void rms_row_to_bf16(int lane, const float* xrow, const float* gain, bf16* orow) {
    const GAS f32x4* xr = (const GAS f32x4*)xrow + lane; const GAS f32x4* gr = (const GAS f32x4*)gain + lane;
    f32x4 v[4]; float s = 0.f;
#pragma unroll
    for (int j = 0; j < 4; ++j) { v[j] = xr[64 * j]; s += (v[j].x * v[j].x + v[j].y * v[j].y) + (v[j].z * v[j].z + v[j].w * v[j].w); }
    const float rinv = __builtin_amdgcn_rsqf(wave_sum(s) * (1.f / DMODEL) + EPS);
    GAS unsigned long long* o8 = (GAS unsigned long long*)orow + lane;
#pragma unroll
    for (int j = 0; j < 4; ++j) { const f32x4 g = gr[64 * j]; o8[64 * j] = (unsigned long long)pk2(v[j].x * rinv * g.x, v[j].y * rinv * g.y) | ((unsigned long long)pk2(v[j].z * rinv * g.z, v[j].w * rinv * g.w) << 32); }
}
DI void p0_peer_w_item(Frame& F, int it) {
    const float* peer_subkeys = inp(I_PEER_SK); const float* peer_wq = inp(I_PEER_WQ); const float* norm_ffn = inp(I_NORM_FFN);
    const int hp = it >> 4, k0 = (it & 15) * 64, tid = (F.wave * 64 + lane_id());
    LAS float* skL = (LAS float*)F.lds; LAS float* wqL = (LAS float*)(F.lds + 128 * 132 * 4);
    const float* sk = peer_subkeys + (size_t)hp * 16384;
#pragma unroll
    for (int i = 0; i < 8; ++i) { const int idx = i * 2048 + tid * 4; const f32x4 v = *(const f32x4*)(sk + idx); *(LAS f32x4*)(skL + (idx >> 7) * 132 + (idx & 127)) = v; }
#pragma unroll
    for (int i = 0; i < 4; ++i) { const int idx = i * 2048 + tid * 4; const int k = idx >> 7, c = idx & 127; const f32x4 v = *(const f32x4*)(peer_wq + (size_t)(k0 + k) * 2048 + hp * 128 + c); *(LAS f32x4*)(wqL + k * 132 + c) = v; }
    __syncthreads();
    const int k = tid & 63, n0 = (tid >> 6) * 16;
    float acc[16];
#pragma unroll
    for (int n = 0; n < 16; ++n) acc[n] = 0.f;
    for (int c4 = 0; c4 < 32; ++c4) { const f32x4 wv = *(const LAS f32x4*)(wqL + k * 132 + c4 * 4);
#pragma unroll
        for (int n = 0; n < 16; ++n) { const f32x4 sv = *(const LAS f32x4*)(skL + (n0 + n) * 132 + c4 * 4); acc[n] += (wv.x * sv.x + wv.y * sv.y) + (wv.z * sv.z + wv.w * sv.w); } }
    const float gffn = norm_ffn[k0 + k];
    bf16* WT = (bf16*)(F.ws + WS_WPEER);
#pragma unroll
    for (int n = 0; n < 16; ++n) WT[(size_t)(hp * 128 + n0 + n) * 1024 + k0 + k] = (bf16)f2bf(acc[n] * gffn);
    __syncthreads();
}
DI void p0_prologue(Frame& F) {
    { float* rope = (float*)(F.ws + WS_ROPE);
      for (int e = (int)blockIdx.x * (NWAVES * 64) + (F.wave * 64 + lane_id()); e < 1024; e += F.G * NWAVES * 64) { const int pos = e >> 4, fi = e & 15;
          const float ang = (float)pos * __builtin_powf(10000.0f, -(float)fi * (1.0f / 16.0f)); rope[2 * e] = cosf(ang); rope[2 * e + 1] = sinf(ang);
          ((float*)(F.ws + WS_GINV))[e] = 1.0f / inp(I_NORM_MIX)[e]; } }
    const bool split_ = (F.G == 256);
    if (!split_) { for (int it = blockIdx.x; it < 256; it += F.G) p0_peer_w_item(F, it); }
    else if ((int)blockIdx.x < 128) p0_peer_w_item(F, 128 + (int)blockIdx.x);
    LAS float* scr = (LAS float*)(F.lds + F.wave * 16384);
    const int gw = F.vcu * NWAVES + F.wave, NGW = F.G * NWAVES;
    constexpr int I_IN = (1024 / 64) * (INW / 32), I_UA = (512 / 64) * (1024 / 32), I_OUT = (1024 / 64) * (1024 / 32), I_PP = (256 / 64) * (1024 / 32);
    constexpr int NITEMS = I_IN + 2 * I_UA + 2 * I_OUT + I_PP;
    for (int it = gw; it < NITEMS; it += NGW) {
        int r = it;
        if (r < I_IN) { p0_transpose_item(inp(I_W_IN), 1024, INW, (bf16*)(F.ws + WS_WIN), scr, r, lane_id()); continue; } r -= I_IN;
        if (r < I_UA) { p0_transpose_item(inp(I_W_UP_ATT), 512, 1024, (bf16*)(F.ws + WS_WUA), scr, r, lane_id(), nullptr, 1024, 0); continue; } r -= I_UA;
        if (r < I_UA) { p0_transpose_item(inp(I_W_UP_HG), 512, 1024, (bf16*)(F.ws + WS_WUA), scr, r, lane_id(), nullptr, 1024, 512); continue; } r -= I_UA;
        if (r < I_OUT) { p0_transpose_item(inp(I_W_OUT), 1024, 1024, (bf16*)(F.ws + WS_WOUT), scr, r, lane_id()); continue; } r -= I_OUT;
        if (r < I_OUT) { p0_transpose_item(inp(I_PLE_GATE), 1024, 1024, (bf16*)(F.ws + WS_WPG), scr, r, lane_id(), inp(I_NORM_PLE), 1280, 256); continue; } r -= I_OUT;
        p0_transpose_item(inp(I_PLE_PROJ), 256, 1024, (bf16*)(F.ws + WS_WPG), scr, r, lane_id(), nullptr, 1280, 0);
    }
    bf16* XN = (bf16*)(F.ws + WS_XN);
    const float* x = inp(I_X); const float* norm_mix = inp(I_NORM_MIX);
    {
        int lane_ = lane_id(); asm volatile("" : "+v"(lane_));
        const int lane = lane_;
        f32x4 gq[4], vn[4];
#pragma unroll
        for (int j = 0; j < 4; ++j) gq[j] = ((const GAS f32x4*)norm_mix)[lane + 64 * j];
        const int bx_ = (int)blockIdx.x;
        const int rbase = split_ ? (bx_ < 128 ? 107 * bx_ : 13696 + 149 * (bx_ - 128)) : 0, rend = split_ ? rbase + (bx_ < 128 ? 107 : 149) : T;
        const int rfirst = split_ ? rbase + F.wave : gw, rstep = split_ ? NWAVES : NGW;
        if (rfirst < rend) {
#pragma unroll
            for (int j = 0; j < 4; ++j) vn[j] = ((const GAS f32x4*)(x + (size_t)rfirst * DMODEL))[lane + 64 * j]; }
        for (int m = rfirst; m < rend; m += rstep) {
            f32x4 v[4];
#pragma unroll
            for (int j = 0; j < 4; ++j) v[j] = vn[j];
            if (m + rstep < rend) {
#pragma unroll
                for (int j = 0; j < 4; ++j) vn[j] = ((const GAS f32x4*)(x + (size_t)(m + rstep) * DMODEL))[lane + 64 * j]; }
            float sq = 0.f;
#pragma unroll
            for (int j = 0; j < 4; ++j) sq += (v[j].x * v[j].x + v[j].y * v[j].y) + (v[j].z * v[j].z + v[j].w * v[j].w);
            const float rinv = __builtin_amdgcn_rsqf(wave_sum(sq) * (1.f / DMODEL) + EPS);
            if (lane == 0) ((float*)(F.ws + WS_RMS))[m] = 1.0f / rinv;
            GAS unsigned long long* o8 = (GAS unsigned long long*)(XN + (size_t)m * DMODEL) + lane;
#pragma unroll
            for (int j = 0; j < 4; ++j) o8[64 * j] = (unsigned long long)pk2(v[j].x * rinv * gq[j].x, v[j].y * rinv * gq[j].y) | ((unsigned long long)pk2(v[j].z * rinv * gq[j].z, v[j].w * rinv * gq[j].w) << 32);
        }
    }
}

DI void p1b_rope(Frame& F) {
    const int gw = F.vcu * NWAVES + F.wave, NGW = F.G * NWAVES, lane = lane_id();
    bf16* QKV = (bf16*)(F.ws + WS_QKV);
    const float gq = inp(I_Q_NORM)[lane], gk = inp(I_K_NORM)[lane];
    const int axis = lane >> 5, hf = (lane >> 4) & 1, fi = lane & 15;
    const float inv = __builtin_powf(10000.0f, -(float)fi * (1.0f / 16.0f));
    constexpr float C2 = 0.125f * 1.4426950408889634f;
    for (int m = gw; m < T; m += NGW) {
        const int t = m & (SEQ - 1); const float pos = (float)(axis ? (t & 63) : (t >> 6));
        const float ang = pos * inv; float sn, cs;
        sn = sinf(ang); cs = cosf(ang);
        bf16* row = QKV + (size_t)m * QKVW;
        float xv[10];
#pragma unroll
        for (int hh = 0; hh < 10; ++hh) xv[hh] = __uint_as_float((unsigned)row[hh * 64 + lane] << 16);
#pragma unroll
        for (int hh = 0; hh < 10; ++hh) {
            const float ss = wave_sum(xv[hh] * xv[hh]);
            const float y = xv[hh] * __builtin_amdgcn_rsqf(ss * (1.0f / 64.0f) + EPS) * (hh < 8 ? gq : gk);
            const float yp = __shfl_xor(y, 16);
            float o = hf ? (yp * sn + y * cs) : (y * cs - yp * sn);
            if (hh < 8) o *= C2;
            row[hh * 64 + lane] = (bf16)f2bf(o);
        }
    }
}
#define MFMA32(a, b, c) __builtin_amdgcn_mfma_f32_32x32x16_bf16((a), (b), (c), 0, 0, 0)
DI int crow16(int r, int hi) { return (r & 3) + 8 * (r >> 2) + 4 * hi; }
template <int CTRL, int RM> DI float dpp0(float x) { return __int_as_float(__builtin_amdgcn_update_dpp(0, __float_as_int(x), CTRL, RM, 0xf, false)); }
DI float wave_incl_scan(float x) {
    x += dpp0<0x111, 0xf>(x); x += dpp0<0x112, 0xf>(x); x += dpp0<0x114, 0xf>(x); x += dpp0<0x118, 0xf>(x);
    x += dpp0<0x142, 0xa>(x); x += dpp0<0x143, 0xc>(x);
    return x;
}
template <int K> DI void mma_tile(f32x16& acc, const LAS bf16* A, int lda, int m0, const LAS bf16* Bt, int ldb, int n0, int r32, int hi) {
    const LAS bf16* ap = A + (m0 + r32) * lda + 8 * hi; const LAS bf16* bp = Bt + (n0 + r32) * ldb + 8 * hi;
    bf16x8 a[K / 16], b[K / 16];
#pragma unroll
    for (int k = 0; k < K / 16; ++k) { a[k] = *(const LAS bf16x8*)(ap + 16 * k); b[k] = *(const LAS bf16x8*)(bp + 16 * k); }
    __builtin_amdgcn_sched_barrier(0);
#pragma unroll
    for (int k = 0; k < K / 16; ++k) acc = MFMA32(a[k], b[k], acc);
}
constexpr int HG_LDK = 136, HG_LDS_ = 72;
constexpr int HGO_QT = 0, HGO_KT = HGO_QT + 64 * HG_LDK * 2, HGO_QE = HGO_KT + 64 * HG_LDK * 2, HGO_KDT = HGO_QE + 64 * HG_LDK * 2, HGO_VT = HGO_KDT + 128 * HG_LDS_ * 2,
              HGO_AM = HGO_VT + 128 * HG_LDS_ * 2, HGO_ST = HGO_AM + 64 * HG_LDS_ * 2, HGO_DEC = HGO_ST + 128 * HG_LDK * 2, HGO_END = HGO_DEC + 512;
static_assert(HGO_END <= SCR_BYTES, "hgrn lds");
#ifndef HG_SKIP
#define HG_SKIP 0
#endif
#define LDS_BAR() asm volatile("s_waitcnt lgkmcnt(0)\n\ts_barrier" ::: "memory")
DI void hgrn_item(Frame& F, int item) {
    const int b = item >> 3, h = (item >> 1) & 3, dir = item & 1;
    int tid_ = F.wave * 64 + lane_id(); asm volatile("" : "+v"(tid_));
    const int tid = tid_, lane = tid & 63, w = __builtin_amdgcn_readfirstlane(tid >> 6), r32 = lane & 31, hi = lane >> 5;
    LAS bf16* QT = (LAS bf16*)(F.lds + HGO_QT); LAS bf16* KT = (LAS bf16*)(F.lds + HGO_KT); LAS bf16* QE = (LAS bf16*)(F.lds + HGO_QE);
    LAS bf16* KDT = (LAS bf16*)(F.lds + HGO_KDT); LAS bf16* VT = (LAS bf16*)(F.lds + HGO_VT); LAS bf16* AM = (LAS bf16*)(F.lds + HGO_AM);
    LAS bf16* ST = (LAS bf16*)(F.lds + HGO_ST); LAS float* DEC = (LAS float*)(F.lds + HGO_DEC);
    __syncthreads();
    for (int i = tid; i < (128 * HG_LDK * 2) / 16; i += NWAVES * 64) ((LAS v4u*)ST)[i] = (v4u){0u, 0u, 0u, 0u};
    for (int i = tid; i < (64 * HG_LDS_ * 2) / 16; i += NWAVES * 64) ((LAS v4u*)AM)[i] = (v4u){0u, 0u, 0u, 0u};
    const bf16* HGb = (const bf16*)(F.ws + WS_HG);
    bf16* OD = (bf16*)(F.ws + WS_HG) + 512 * (1 + dir);
    const int colq = h * 128, colf = 512 * (1 + dir) + h * 128, coli = 1536 + h * 128;
    f32x16 s0, s1;
#pragma unroll
    for (int i = 0; i < 16; ++i) { s0[i] = 0.f; s1[i] = 0.f; }
    const int pt0 = tid >> 4, pc8 = (tid & 15) * 8;
    v4u nq[2], nf[2], ni[2];
    unsigned offq[2], offf[2];
#pragma unroll
    for (int pp = 0; pp < 2; ++pp) { const int t = pt0 + 32 * pp; const unsigned ro = (unsigned)((dir ? 63 - t : t) * HGW + pc8) * 2u; offq[pp] = ro + 2u * (unsigned)colq; offf[pp] = ro + 2u * (unsigned)colf; }
    const unsigned offv = (unsigned)((dir ? 63 - lane : lane) * HGW + coli + 16 * w) * 2u;
#define HG_LOADS(ck) do { const unsigned char* lb_ = (const unsigned char*)(HGb + ((size_t)b * SEQ + (size_t)(ck) * 64) * HGW); \
        _Pragma("unroll") for (int pp = 0; pp < 2; ++pp) { nq[pp] = *(const v4u*)(lb_ + offq[pp]); nf[pp] = *(const v4u*)(lb_ + offf[pp]); } \
        ni[0] = *(const v4u*)(lb_ + offv); ni[1] = *(const v4u*)(lb_ + (offv + 16u)); } while (0)
    HG_LOADS(dir ? 63 : 0);
    const int tb = w & 1, eb = w >> 1, db = w & 3, eb2 = 2 * (w >> 2);
    for (int step = 0; step < 64; ++step) {
        const int chunk = dir ? 63 - step : step;
        const size_t tok0 = (size_t)b * SEQ + chunk * 64;
#pragma unroll
        for (int pp = 0; pp < 2; ++pp) { const int t = pt0 + 32 * pp;
            *(LAS v4u*)(QT + t * HG_LDK + pc8) = nq[pp]; *(LAS v4u*)(KT + t * HG_LDK + pc8) = nf[pp]; }
        { const unsigned va[8] = {ni[0].x, ni[0].y, ni[0].z, ni[0].w, ni[1].x, ni[1].y, ni[1].z, ni[1].w};
#pragma unroll
          for (int j = 0; j < 8; ++j) { VT[(16 * w + 2 * j) * HG_LDS_ + lane] = (bf16)(va[j] & 0xffffu); VT[(16 * w + 2 * j + 1) * HG_LDS_ + lane] = (bf16)(va[j] >> 16); } }
        if (step + 1 < 64 && !(HG_SKIP & 16)) HG_LOADS(dir ? 62 - step : step + 1);
        LDS_BAR();
        const v4u cq0 = *(const LAS v4u*)(QT + lane * HG_LDK + 16 * w), cq1 = *(const LAS v4u*)(QT + lane * HG_LDK + 16 * w + 8);
        const v4u cf0 = *(const LAS v4u*)(KT + lane * HG_LDK + 16 * w), cf1 = *(const LAS v4u*)(KT + lane * HG_LDK + 16 * w + 8);
        if (!(HG_SKIP & 1)) {
            const unsigned qa[8] = {cq0.x, cq0.y, cq0.z, cq0.w, cq1.x, cq1.y, cq1.z, cq1.w};
            const unsigned fa[8] = {cf0.x, cf0.y, cf0.z, cf0.w, cf1.x, cf1.y, cf1.z, cf1.w};
            float qt[16], kt[16], qe[16], kd[16];
            {
                float bc[16], kk[16];
#pragma unroll
                for (int j = 0; j < 16; ++j) { bc[j] = (j & 1) ? bfhi(fa[j >> 1]) : bflo(fa[j >> 1]); kk[j] = 1.0f - __builtin_amdgcn_exp2f(bc[j]); }
#pragma unroll
                for (int j = 0; j < 16; ++j) bc[j] += dpp0<0x111, 0xf>(bc[j]);
#pragma unroll
                for (int j = 0; j < 16; ++j) bc[j] += dpp0<0x112, 0xf>(bc[j]);
#pragma unroll
                for (int j = 0; j < 16; ++j) bc[j] += dpp0<0x114, 0xf>(bc[j]);
#pragma unroll
                for (int j = 0; j < 16; ++j) bc[j] += dpp0<0x118, 0xf>(bc[j]);
#define HG_BC(CTL) asm volatile( \
                    "v_add_f32_dpp %0, %0, %0 " CTL "\n\tv_add_f32_dpp %1, %1, %1 " CTL "\n\tv_add_f32_dpp %2, %2, %2 " CTL "\n\tv_add_f32_dpp %3, %3, %3 " CTL "\n\t" \
                    "v_add_f32_dpp %4, %4, %4 " CTL "\n\tv_add_f32_dpp %5, %5, %5 " CTL "\n\tv_add_f32_dpp %6, %6, %6 " CTL "\n\tv_add_f32_dpp %7, %7, %7 " CTL "\n\t" \
                    "v_add_f32_dpp %8, %8, %8 " CTL "\n\tv_add_f32_dpp %9, %9, %9 " CTL "\n\tv_add_f32_dpp %10, %10, %10 " CTL "\n\tv_add_f32_dpp %11, %11, %11 " CTL "\n\t" \
                    "v_add_f32_dpp %12, %12, %12 " CTL "\n\tv_add_f32_dpp %13, %13, %13 " CTL "\n\tv_add_f32_dpp %14, %14, %14 " CTL "\n\tv_add_f32_dpp %15, %15, %15 " CTL \
                    : "+v"(bc[0]), "+v"(bc[1]), "+v"(bc[2]), "+v"(bc[3]), "+v"(bc[4]), "+v"(bc[5]), "+v"(bc[6]), "+v"(bc[7]), "+v"(bc[8]), "+v"(bc[9]), "+v"(bc[10]), "+v"(bc[11]), "+v"(bc[12]), "+v"(bc[13]), "+v"(bc[14]), "+v"(bc[15]))
                asm volatile("s_nop 1");
                HG_BC("row_bcast:15 row_mask:0xa bank_mask:0xf");
                HG_BC("row_bcast:31 row_mask:0xc bank_mask:0xf");
#undef HG_BC
                float e63v[16];
#pragma unroll
                for (int j = 0; j < 16; ++j) {
                    const float q = (j & 1) ? bfhi(qa[j >> 1]) : bflo(qa[j >> 1]);
                    const float E = __builtin_amdgcn_exp2f(bc[j]), R = __builtin_amdgcn_exp2f(-bc[j]);
                    const float E31 = __int_as_float(__builtin_amdgcn_readlane(__float_as_int(E), 31));
                    const float E63 = __int_as_float(__builtin_amdgcn_readlane(__float_as_int(E), 63));
                    const float R31 = __int_as_float(__builtin_amdgcn_readlane(__float_as_int(R), 31));
                    const float kR = kk[j] * R;
                    qe[j] = q * E; qt[j] = qe[j] * R31; kt[j] = kR * E31; kd[j] = kR * E63;
                    e63v[j] = E;
                }
                if (lane == 63) {
#pragma unroll
                    for (int j4 = 0; j4 < 4; ++j4) *(LAS f32x4*)(DEC + 16 * w + 4 * j4) = (f32x4){e63v[4 * j4], e63v[4 * j4 + 1], e63v[4 * j4 + 2], e63v[4 * j4 + 3]}; }
            }
            v4u o;
            o = (v4u){pk2(qt[0], qt[1]), pk2(qt[2], qt[3]), pk2(qt[4], qt[5]), pk2(qt[6], qt[7])}; *(LAS v4u*)(QT + lane * HG_LDK + 16 * w) = o;
            o = (v4u){pk2(qt[8], qt[9]), pk2(qt[10], qt[11]), pk2(qt[12], qt[13]), pk2(qt[14], qt[15])}; *(LAS v4u*)(QT + lane * HG_LDK + 16 * w + 8) = o;
            o = (v4u){pk2(kt[0], kt[1]), pk2(kt[2], kt[3]), pk2(kt[4], kt[5]), pk2(kt[6], kt[7])}; *(LAS v4u*)(KT + lane * HG_LDK + 16 * w) = o;
            o = (v4u){pk2(kt[8], kt[9]), pk2(kt[10], kt[11]), pk2(kt[12], kt[13]), pk2(kt[14], kt[15])}; *(LAS v4u*)(KT + lane * HG_LDK + 16 * w + 8) = o;
            o = (v4u){pk2(qe[0], qe[1]), pk2(qe[2], qe[3]), pk2(qe[4], qe[5]), pk2(qe[6], qe[7])}; *(LAS v4u*)(QE + lane * HG_LDK + 16 * w) = o;
            o = (v4u){pk2(qe[8], qe[9]), pk2(qe[10], qe[11]), pk2(qe[12], qe[13]), pk2(qe[14], qe[15])}; *(LAS v4u*)(QE + lane * HG_LDK + 16 * w + 8) = o;
#pragma unroll
            for (int j = 0; j < 16; j += 2) { const unsigned kp = pk2(kd[j], kd[j + 1]);
                KDT[(16 * w + j) * HG_LDS_ + lane] = (bf16)(kp & 0xffffu); KDT[(16 * w + j + 1) * HG_LDS_ + lane] = (bf16)(kp >> 16);
            }
        }
        LDS_BAR();
        f32x16 o;
#pragma unroll
        for (int i = 0; i < 16; ++i) o[i] = 0.f;
        if (!(HG_SKIP & 2)) mma_tile<128>(o, QE, HG_LDK, tb * 32, ST, HG_LDK, eb * 32, r32, hi);
        if (w < 3 && !(HG_SKIP & 2)) {
            const int ti = (w == 0) ? 0 : 1, sj = (w == 2) ? 1 : 0;
            f32x16 a;
#pragma unroll
            for (int i = 0; i < 16; ++i) a[i] = 0.f;
            mma_tile<128>(a, QT, HG_LDK, ti * 32, KT, HG_LDK, sj * 32, r32, hi);
#pragma unroll
            for (int i = 0; i < 16; i += 2) { const int tl = crow16(i, hi); float v0 = a[i], v1 = a[i + 1]; if (ti == sj && r32 > tl) v0 = 0.f; if (ti == sj && r32 > tl + 1) v1 = 0.f; const unsigned pp = pk2(v0, v1);
                AM[(ti * 32 + tl) * HG_LDS_ + sj * 32 + r32] = (bf16)(pp & 0xffffu); AM[(ti * 32 + tl + 1) * HG_LDS_ + sj * 32 + r32] = (bf16)(pp >> 16); }
        }
        LDS_BAR();
        if (!(HG_SKIP & 4)) { if (tb) mma_tile<64>(o, AM, HG_LDS_, 32, VT, HG_LDS_, eb * 32, r32, hi); else mma_tile<32>(o, AM, HG_LDS_, 0, VT, HG_LDS_, eb * 32, r32, hi); }
        if (!(HG_SKIP & 8))
        {
            unsigned char* obase = (unsigned char*)(OD + tok0 * HGW + h * 128);
            const int tl0 = tb * 32 + 4 * hi;
            const int step_b = dir ? -(HGW * 2) : (HGW * 2);
            const unsigned vbase = (unsigned)((dir ? 63 - tl0 : tl0) * (HGW * 2) + (eb * 32 + r32) * 2);
#pragma unroll
            for (int i = 0; i < 16; i += 2) { const int d = (i & 3) + 8 * (i >> 2);
                const unsigned pp = pk2(o[i], o[i + 1]);
                const unsigned oa = vbase + (unsigned)(d * step_b), ob = oa + (unsigned)step_b;
                *(bf16*)(obase + oa) = (bf16)(pp & 0xffffu); *(bf16*)(obase + ob) = (bf16)(pp >> 16); } }
        if (!(HG_SKIP & 4)) {
            float dc[16];
#pragma unroll
            for (int i = 0; i < 16; ++i) dc[i] = DEC[db * 32 + crow16(i, hi)];
#pragma unroll
            for (int i = 0; i < 16; ++i) { s0[i] *= dc[i]; s1[i] *= dc[i]; }
            mma_tile<64>(s0, KDT, HG_LDS_, db * 32, VT, HG_LDS_, eb2 * 32, r32, hi);
            mma_tile<64>(s1, KDT, HG_LDS_, db * 32, VT, HG_LDS_, (eb2 + 1) * 32, r32, hi);
#pragma unroll
            for (int g4 = 0; g4 < 4; ++g4) {
                v2u p0 = {pk2(s0[4 * g4], s0[4 * g4 + 1]), pk2(s0[4 * g4 + 2], s0[4 * g4 + 3])}; *(LAS v2u*)(ST + (eb2 * 32 + r32) * HG_LDK + db * 32 + 8 * g4 + 4 * hi) = p0;
                v2u p1 = {pk2(s1[4 * g4], s1[4 * g4 + 1]), pk2(s1[4 * g4 + 2], s1[4 * g4 + 3])}; *(LAS v2u*)(ST + ((eb2 + 1) * 32 + r32) * HG_LDK + db * 32 + 8 * g4 + 4 * hi) = p1;
            }
        }
        LDS_BAR();
    }
#undef HG_LOADS
}

DI void p2b_ohn(Frame& F, bf16* AO) {
    int lane_ = lane_id(); asm volatile("" : "+v"(lane_));
    const int gw = F.vcu * NWAVES + F.wave, NGW = F.G * NWAVES, lane = lane_;
    bf16* HGb = (bf16*)(F.ws + WS_HG);
    float gn[8];
#pragma unroll
    for (int j = 0; j < 8; ++j) gn[j] = inp(I_HG_ONORM)[(8 * lane + j) & 127];
    for (int m = gw; m < T; m += NGW) {
        const v4u a = *(const v4u*)(HGb + (size_t)m * HGW + 512 + 8 * lane), bb = *(const v4u*)(HGb + (size_t)m * HGW + 1024 + 8 * lane), gg = *(const v4u*)(HGb + (size_t)m * HGW + 2048 + 8 * lane);
        const unsigned aa[4] = {a.x, a.y, a.z, a.w}, ba[4] = {bb.x, bb.y, bb.z, bb.w}, ga[4] = {gg.x, gg.y, gg.z, gg.w};
        float v[8]; float ss = 0.f;
#pragma unroll
        for (int j = 0; j < 4; ++j) { v[2 * j] = bflo(aa[j]) + bflo(ba[j]); v[2 * j + 1] = bfhi(aa[j]) + bfhi(ba[j]); ss += v[2 * j] * v[2 * j] + v[2 * j + 1] * v[2 * j + 1]; }
        ss += __shfl_xor(ss, 1); ss += __shfl_xor(ss, 2); ss += __shfl_xor(ss, 4); ss += __shfl_xor(ss, 8);
        const float rinv = __builtin_amdgcn_rsqf(ss * (1.0f / 128.0f) + EPS);
        float o[8];
#pragma unroll
        for (int j = 0; j < 8; ++j) { const float hg = (j & 1) ? bfhi(ga[j >> 1]) : bflo(ga[j >> 1]); o[j] = v[j] * rinv * gn[j] * hg; }
        *(v4u*)(AO + (size_t)m * 1024 + 512 + 8 * lane) = (v4u){pk2(o[0], o[1]), pk2(o[2], o[3]), pk2(o[4], o[5]), pk2(o[6], o[7])};
    }
}

DI void cvt_f32_bf16(Frame& F, const float* src, bf16* dst, size_t g_lo, size_t g_hi) {
    for (size_t i = g_lo + (F.wave * 64 + lane_id()); i < g_hi; i += NWAVES * 64) { const f32x4 a = *(const f32x4*)(src + i * 8), b = *(const f32x4*)(src + i * 8 + 4);
        *(v4u*)(dst + i * 8) = (v4u){pk2(a.x, a.y), pk2(a.z, a.w), pk2(b.x, b.y), pk2(b.z, b.w)}; }
}

DI void cvt_p_rows(Frame& F, const float* p, bf16* aple, int r0, int r1) {
    const int tid = F.wave * 64 + lane_id();
    for (int r = r0 + (tid >> 5); r < r1; r += (NWAVES * 64) >> 5) { const int c = (tid & 31) * 8; const f32x4 a = *(const f32x4*)(p + (size_t)r * PLED + c), b = *(const f32x4*)(p + (size_t)r * PLED + c + 4);
        *(v4u*)(aple + (size_t)r * 1280 + c) = (v4u){pk2(a.x, a.y), pk2(a.z, a.w), pk2(b.x, b.y), pk2(b.z, b.w)}; }
}
template <bool SLICED> DI void cvt_rows_fp8(Frame& F, const float* src, unsigned char* dst8, float* scale2, int which, int e0, int e1) {
    int lane_ = lane_id(); asm volatile("" : "+v"(lane_));
    const int lane = lane_;
    for (int e = e0 + F.wave; e < e1; e += NWAVES) {
        const float* r = src + (size_t)e * DMODEL + 16 * lane;
        const f32x4 a = *(const f32x4*)r, b = *(const f32x4*)(r + 4), c = *(const f32x4*)(r + 8), d = *(const f32x4*)(r + 12);
        float m = fmaxf(fmaxf(fmaxf(fabsf(a.x), fabsf(a.y)), fmaxf(fabsf(a.z), fabsf(a.w))), fmaxf(fmaxf(fabsf(b.x), fabsf(b.y)), fmaxf(fabsf(b.z), fabsf(b.w))));
        m = fmaxf(m, fmaxf(fmaxf(fmaxf(fabsf(c.x), fabsf(c.y)), fmaxf(fabsf(c.z), fabsf(c.w))), fmaxf(fmaxf(fabsf(d.x), fabsf(d.y)), fmaxf(fabsf(d.z), fabsf(d.w)))));
#pragma unroll
        for (int o = 1; o < 64; o <<= 1) m = fmaxf(m, __shfl_xor(m, o));
        const float sc = m > 0.f ? m * (1.0f / 256.0f) : 1.0f, inv = 1.0f / sc;
        v4u w;
        { int t = 0; t = __builtin_amdgcn_cvt_pk_fp8_f32(a.x * inv, a.y * inv, t, false); t = __builtin_amdgcn_cvt_pk_fp8_f32(a.z * inv, a.w * inv, t, true); w.x = (unsigned)t; }
        { int t = 0; t = __builtin_amdgcn_cvt_pk_fp8_f32(b.x * inv, b.y * inv, t, false); t = __builtin_amdgcn_cvt_pk_fp8_f32(b.z * inv, b.w * inv, t, true); w.y = (unsigned)t; }
        { int t = 0; t = __builtin_amdgcn_cvt_pk_fp8_f32(c.x * inv, c.y * inv, t, false); t = __builtin_amdgcn_cvt_pk_fp8_f32(c.z * inv, c.w * inv, t, true); w.z = (unsigned)t; }
        { int t = 0; t = __builtin_amdgcn_cvt_pk_fp8_f32(d.x * inv, d.y * inv, t, false); t = __builtin_amdgcn_cvt_pk_fp8_f32(d.z * inv, d.w * inv, t, true); w.w = (unsigned)t; }
        if (SLICED) *(v4u*)(dst8 + ((size_t)(lane >> 3) * NEXP + e) * 128 + (lane & 7) * 16) = w;
        else *(v4u*)(dst8 + (size_t)e * DMODEL + 16 * lane) = w;
        if (lane == 0) scale2[2 * e + which] = sc;
    }
}
DI void cvt_rows_i8(Frame& F, const float* src, unsigned char* dst8, float* scale2, int which, int e0, int e1) {
    int lane_ = lane_id(); asm volatile("" : "+v"(lane_));
    const int lane = lane_;
    for (int e = e0 + F.wave; e < e1; e += NWAVES) {
        const float* r = src + (size_t)e * DMODEL + 16 * lane;
        const f32x4 a = *(const f32x4*)r, b = *(const f32x4*)(r + 4), c = *(const f32x4*)(r + 8), d = *(const f32x4*)(r + 12);
        float m = fmaxf(fmaxf(fmaxf(fabsf(a.x), fabsf(a.y)), fmaxf(fabsf(a.z), fabsf(a.w))), fmaxf(fmaxf(fabsf(b.x), fabsf(b.y)), fmaxf(fabsf(b.z), fabsf(b.w))));
        m = fmaxf(m, fmaxf(fmaxf(fmaxf(fabsf(c.x), fabsf(c.y)), fmaxf(fabsf(c.z), fabsf(c.w))), fmaxf(fmaxf(fabsf(d.x), fabsf(d.y)), fmaxf(fabsf(d.z), fabsf(d.w)))));
#pragma unroll
        for (int o = 1; o < 64; o <<= 1) m = fmaxf(m, __shfl_xor(m, o));
        const float sc = m > 0.f ? m * (1.0f / 127.0f) : 1.0f, inv = 1.0f / sc;
#define PK4I8(v) ((unsigned)((int)__builtin_rintf((v).x * inv) & 0xff) | ((unsigned)((int)__builtin_rintf((v).y * inv) & 0xff) << 8) | ((unsigned)((int)__builtin_rintf((v).z * inv) & 0xff) << 16) | ((unsigned)((int)__builtin_rintf((v).w * inv) & 0xff) << 24))
        const v4u w = {PK4I8(a), PK4I8(b), PK4I8(c), PK4I8(d)};
#undef PK4I8
        *(v4u*)(dst8 + (size_t)e * DMODEL + 16 * lane) = w;
        if (lane == 0) scale2[2 * e + which] = sc;
    }
}
DI void cvt_rows_fp4(Frame& F, const float* src, unsigned char* dst4, float* scale2, int which, int e0, int e1) {
    int lane_ = lane_id(); asm volatile("" : "+v"(lane_));
    const int lane = lane_;
    for (int e = e0 + F.wave; e < e1; e += NWAVES) {
        const float* r = src + (size_t)e * DMODEL + 16 * lane;
        const f32x4 a = *(const f32x4*)r, b = *(const f32x4*)(r + 4), c = *(const f32x4*)(r + 8), d = *(const f32x4*)(r + 12);
        float ss = a.x * a.x + a.y * a.y + a.z * a.z + a.w * a.w + b.x * b.x + b.y * b.y + b.z * b.z + b.w * b.w + c.x * c.x + c.y * c.y + c.z * c.z + c.w * c.w + d.x * d.x + d.y * d.y + d.z * d.z + d.w * d.w;
#pragma unroll
        for (int o = 1; o < 64; o <<= 1) ss += __shfl_xor(ss, o);
        const float sc = ss > 0.f ? 0.5f * __builtin_sqrtf(ss * (1.0f / 1024.0f)) : 1.0f, inv = 1.0f / sc;
        const float xs[16] = {a.x, a.y, a.z, a.w, b.x, b.y, b.z, b.w, c.x, c.y, c.z, c.w, d.x, d.y, d.z, d.w};
        unsigned w[2] = {0u, 0u};
#pragma unroll
        for (int k = 0; k < 16; ++k) { const float m = fabsf(xs[k]) * inv;
            const unsigned code = (m > 0.25f ? 1u : 0u) + (m > 0.75f ? 1u : 0u) + (m > 1.25f ? 1u : 0u) + (m > 1.75f ? 1u : 0u) + (m > 2.5f ? 1u : 0u) + (m > 3.5f ? 1u : 0u) + (m > 5.0f ? 1u : 0u);
            w[k >> 3] |= (code | (xs[k] < 0.f ? 8u : 0u)) << (4 * (k & 7)); }
        *(v2u*)(dst4 + ((size_t)(lane >> 4) * NEXP + e) * 128 + 8 * (lane & 15)) = (v2u){w[0], w[1]};
        if (lane == 0) scale2[2 * e + which] = sc;
    }
}
DI void cvt_rows_i4(Frame& F, const float* src, unsigned char* dst4, float* scale2, int which, int e0, int e1) {
    int lane_ = lane_id(); asm volatile("" : "+v"(lane_));
    const int lane = lane_;
    for (int e = e0 + F.wave; e < e1; e += NWAVES) {
        const float* r = src + (size_t)e * DMODEL + 16 * lane;
        const f32x4 a = *(const f32x4*)r, b = *(const f32x4*)(r + 4), c = *(const f32x4*)(r + 8), d = *(const f32x4*)(r + 12);
        float ss = a.x * a.x + a.y * a.y + a.z * a.z + a.w * a.w + b.x * b.x + b.y * b.y + b.z * b.z + b.w * b.w + c.x * c.x + c.y * c.y + c.z * c.z + c.w * c.w + d.x * d.x + d.y * d.y + d.z * d.z + d.w * d.w;
#pragma unroll
        for (int o = 1; o < 64; o <<= 1) ss += __shfl_xor(ss, o);
        const float sc = ss > 0.f ? 0.355f * __builtin_sqrtf(ss * (1.0f / 1024.0f)) : 1.0f, inv = 1.0f / sc;
#define Q4(v) ((unsigned)((int)fminf(fmaxf(__builtin_rintf((v) * inv), -7.0f), 7.0f)) & 0xfu)
        const v2u w = {Q4(a.x) | (Q4(a.y) << 4) | (Q4(a.z) << 8) | (Q4(a.w) << 12) | (Q4(b.x) << 16) | (Q4(b.y) << 20) | (Q4(b.z) << 24) | (Q4(b.w) << 28),
                       Q4(c.x) | (Q4(c.y) << 4) | (Q4(c.z) << 8) | (Q4(c.w) << 12) | (Q4(d.x) << 16) | (Q4(d.y) << 20) | (Q4(d.z) << 24) | (Q4(d.w) << 28)};
#undef Q4
        *(v2u*)(dst4 + (size_t)e * 512 + 8 * lane) = w;
        if (lane == 0) scale2[2 * e + which] = sc;
    }
}
struct XcdPart { int v, nx, li, nloc; };
DI float gelu_tanh(float a) { const float u = 0.7978845608028654f * (a + 0.044715f * a * a * a); const float e = __builtin_amdgcn_exp2f(2.0f * 1.4426950408889634f * u); const float th = 1.0f - 2.0f * __builtin_amdgcn_rcpf(e + 1.0f); return 0.5f * a * (1.0f + th); }
typedef float f32x2_ __attribute__((ext_vector_type(2)));
DI void dq16(const v4u& w, float (&o)[16]) {
    const unsigned a[4] = {w.x, w.y, w.z, w.w};
#pragma unroll
    for (int j = 0; j < 4; ++j) { const f32x2_ lo = __builtin_amdgcn_cvt_pk_f32_fp8((int)a[j], false), hi = __builtin_amdgcn_cvt_pk_f32_fp8((int)a[j], true); o[4 * j] = lo.x; o[4 * j + 1] = lo.y; o[4 * j + 2] = hi.x; o[4 * j + 3] = hi.y; }
}
DI void p5_quant_h(Frame& F) {
    int lane_ = lane_id(); asm volatile("" : "+v"(lane_));
    const int gw = F.vcu * NWAVES + F.wave, NGW = F.G * NWAVES, lane = lane_;
    const bf16* X1B = (const bf16*)(F.ws + WS_X1B); const float* rowss = (const float*)(F.ws + WS_CTL) + CW_ROWSS;
    unsigned char* H8 = (unsigned char*)(F.ws + WS_H8); float* TSC = (float*)(F.ws + WS_TSC);
    float gn[16];
    { const float* nf = inp(I_NORM_FFN) + 16 * lane;
#pragma unroll
      for (int d = 0; d < 16; ++d) gn[d] = nf[d]; }
    v4u xna, xnb; float rsn = 0.f;
    if (gw < T) { xna = *(const v4u*)(X1B + (size_t)gw * DMODEL + 16 * lane); xnb = *(const v4u*)(X1B + (size_t)gw * DMODEL + 16 * lane + 8); rsn = rowss[gw]; }
    for (int m = gw; m < T; m += NGW) {
        const v4u xa = xna, xb = xnb; const float rs_ = rsn;
        if (m + NGW < T) { xna = *(const v4u*)(X1B + (size_t)(m + NGW) * DMODEL + 16 * lane); xnb = *(const v4u*)(X1B + (size_t)(m + NGW) * DMODEL + 16 * lane + 8); rsn = rowss[m + NGW]; }
        const unsigned xw_[8] = {xa.x, xa.y, xa.z, xa.w, xb.x, xb.y, xb.z, xb.w};
        float hv[16]; float mx = 0.f;
#pragma unroll
        for (int d = 0; d < 8; ++d) { hv[2 * d] = bflo(xw_[d]) * gn[2 * d]; hv[2 * d + 1] = bfhi(xw_[d]) * gn[2 * d + 1]; mx = fmaxf(mx, fmaxf(fabsf(hv[2 * d]), fabsf(hv[2 * d + 1]))); }
#pragma unroll
        for (int o = 1; o < 64; o <<= 1) mx = fmaxf(mx, __shfl_xor(mx, o));
        const float qs = mx > 0.f ? 119.0f / mx : 0.f;
        unsigned pa[2] = {0u, 0u}, pb[2] = {0u, 0u};
#pragma unroll
        for (int d = 0; d < 16; ++d) { const int h = (int)__builtin_rintf(hv[d] * qs); const int a = (h + 8) >> 4, b = h - 16 * a;
            pa[d >> 3] |= ((unsigned)a & 0xfu) << (4 * (d & 7)); pb[d >> 3] |= ((unsigned)b & 0xfu) << (4 * (d & 7)); }
        *(v2u*)(H8 + (size_t)m * DMODEL + 8 * lane) = (v2u){pa[0], pa[1]};
        *(v2u*)(H8 + (size_t)m * DMODEL + 512 + 8 * lane) = (v2u){pb[0], pb[1]};
        if (lane == 0) TSC[m] = (mx > 0.f ? mx * (1.0f / 119.0f) : 0.f) * __builtin_amdgcn_rsqf(rs_ * (1.0f / 1024.0f) + EPS);
    }
}
#ifndef P6_SKIP
#define P6_SKIP 0
#endif
template <int CTRL> DI int dppi0(int x) { return __builtin_amdgcn_update_dpp(0, x, CTRL, 0xf, 0xf, false); }
typedef float f32x2v __attribute__((ext_vector_type(2)));
constexpr int P6A_HSTR = 1024 + 64;
constexpr int P6A_WBYTES = 4096 + 2048 + 4 * P6A_HSTR;
static_assert(8 * P6A_WBYTES <= SCR_BYTES, "p6a lds");
DI void p6a_dots(Frame& F, const XcdPart P) {
    int lane_ = lane_id(); asm volatile("" : "+v"(lane_));
    const int lane = lane_, q = lane >> 4, i = lane & 15, q8 = lane >> 3; const unsigned i16 = 16u * (unsigned)(lane & 7);
    const unsigned char* UB8 = (const unsigned char*)(F.ws + WS_UB8); const f32x2_* US2 = (const f32x2_*)(F.ws + WS_US);
    const unsigned short* IDX = (const unsigned short*)(F.ws + WS_IDX); const float* GWp = (const float*)(F.ws + WS_GW); bf16* Wp = (bf16*)(F.ws + WS_W);
    const unsigned char* H8 = (const unsigned char*)(F.ws + WS_H8); const float* TSC = (const float*)(F.ws + WS_TSC);
    LAS unsigned char* wb = F.lds + F.wave * P6A_WBYTES;
    LAS v2u* list = (LAS v2u*)wb;
    LAS float* res = (LAS float*)(wb + 4096);
    LAS unsigned char* hb = wb + 4096 + 2048;
    const int wrank = P.li * NWAVES + F.wave, wstride = P.nloc * NWAVES;
    for (int s_ = P.v; s_ < 8; s_ += P.nx) {
        const int s = s_ & 3, tlo = (s_ >> 2) * (T / 2), thi = tlo + T / 2;
        v4u ean;
        if (tlo + wrank * 4 < thi) ean = *(const v4u*)(IDX + (size_t)(tlo + wrank * 4 + q) * 128 + 8 * i);
        for (int m0 = tlo + wrank * 4; m0 < thi; m0 += wstride * 4) {
            const int tok = m0 + q;
            const v4u ea = ean;
            if (m0 + wstride * 4 < thi) ean = *(const v4u*)(IDX + (size_t)(tok + wstride * 4) * 128 + 8 * i);
            v4u hv[4];
#pragma unroll
            for (int j = 0; j < 4; ++j) hv[j] = *(const v4u*)(H8 + (size_t)tok * DMODEL + 256 * j + 16 * i);
            const unsigned ev[8] = {ea.x & 0xffffu, ea.x >> 16, ea.y & 0xffffu, ea.y >> 16, ea.z & 0xffffu, ea.z >> 16, ea.w & 0xffffu, ea.w >> 16};
            int cnt = 0;
#pragma unroll
            for (int j = 0; j < 8; ++j) cnt += ((int)(ev[j] >> 12) == s) ? 1 : 0;
            int pre = cnt;
            pre += dppi0<0x111>(pre); pre += dppi0<0x112>(pre); pre += dppi0<0x114>(pre); pre += dppi0<0x118>(pre);
            const int n0 = __builtin_amdgcn_readlane(pre, 15), n1 = __builtin_amdgcn_readlane(pre, 31), n2 = __builtin_amdgcn_readlane(pre, 47), n3 = __builtin_amdgcn_readlane(pre, 63);
            const int p0 = (n0 + 1) & ~1, p1 = (n1 + 1) & ~1, p2 = (n2 + 1) & ~1, p3 = (n3 + 1) & ~1;
            const int ntot = p0 + p1 + p2 + p3;
            const int offq = (q > 0 ? p0 : 0) + (q > 1 ? p1 : 0) + (q > 2 ? p2 : 0), nq = q == 0 ? n0 : q == 1 ? n1 : q == 2 ? n2 : n3;
            int pos = pre - cnt + offq; unsigned fe = 0u;
#pragma unroll
            for (int j = 0; j < 8; ++j) if ((int)(ev[j] >> 12) == s) { list[pos] = (v2u){ev[j], (unsigned)(8 * i + j) | ((unsigned)q << 8)}; fe = ev[j]; ++pos; }
            if ((nq & 1) && cnt > 0) list[offq + nq] = (v2u){fe, 0x80000000u | ((unsigned)q << 8)};
#pragma unroll
            for (int j = 0; j < 4; ++j) *(LAS v4u*)(hb + q * P6A_HSTR + 256 * j + 16 * i) = hv[j];
            f32x2_ fsc = {0.f, 0.f}, fsc1 = {0.f, 0.f}; float fg = 0.f, ftsc = 0.f, fg1 = 0.f, ftsc1 = 0.f; size_t fo = 0, fo1 = 0; bool fv = false, fv1 = false;
            if (lane < ntot) { const v2u ek = list[lane]; fv = !(ek.y >> 31); const int tq = (int)(ek.y >> 8) & 3; fo = (size_t)(m0 + tq) * 128 + (ek.y & 255u); if (fv) { fsc = US2[ek.x]; fg = GWp[fo]; ftsc = TSC[m0 + tq]; } }
            if (lane + 64 < ntot) { const v2u ek = list[lane + 64]; fv1 = !(ek.y >> 31); const int tq = (int)(ek.y >> 8) & 3; fo1 = (size_t)(m0 + tq) * 128 + (ek.y & 255u); if (fv1) { fsc1 = US2[ek.x]; fg1 = GWp[fo1]; ftsc1 = TSC[m0 + tq]; } }
#define P6A_LOAD(U, TQ, base_) do { _Pragma("unroll") for (int st = 0; st < 2; ++st) if ((base_) + 16 * st < ntot) { const int slot = (base_) + 16 * st + 2 * q8; const int sl = slot < ntot ? slot : ntot - 2; \
                    const v4u ek2 = *(const LAS v4u*)(list + sl); TQ[st] = (int)(ek2.y >> 8) & 3; \
                    const unsigned ro0 = (ek2.x << 9) | i16, ro1 = (ek2.z << 9) | i16; \
                    _Pragma("unroll") for (int j = 0; j < 4; ++j) { U[st][0][j] = *(const v4u*)(UB8 + (ro0 + 128u * j)); U[st][1][j] = *(const v4u*)(UB8 + (ro1 + 128u * j)); } } } while (0)
#define P6A_DOT4(acc_, uu, hh) do { acc_ = __builtin_amdgcn_sdot8((int)(uu).x, (int)(hh).x, acc_, false); acc_ = __builtin_amdgcn_sdot8((int)(uu).y, (int)(hh).y, acc_, false); \
                    acc_ = __builtin_amdgcn_sdot8((int)(uu).z, (int)(hh).z, acc_, false); acc_ = __builtin_amdgcn_sdot8((int)(uu).w, (int)(hh).w, acc_, false); } while (0)
#define P6A_COMP(U, TQ, base_) do { _Pragma("unroll") for (int st = 0; st < 2; ++st) if ((base_) + 16 * st < ntot) { const LAS unsigned char* hp_ = hb + TQ[st] * P6A_HSTR + i16; \
                    v4u ha[4], hb4[4]; _Pragma("unroll") for (int j = 0; j < 4; ++j) { ha[j] = *(const LAS v4u*)(hp_ + 128 * j); hb4[j] = *(const LAS v4u*)(hp_ + 512 + 128 * j); } \
                    __builtin_amdgcn_sched_barrier(0);        \
                    int isa0 = 0, isb0 = 0, isa1 = 0, isb1 = 0; \
                    _Pragma("unroll") for (int j = 0; j < 4; ++j) { P6A_DOT4(isa0, U[st][0][j], ha[j]); P6A_DOT4(isb0, U[st][0][j], hb4[j]); P6A_DOT4(isa1, U[st][1][j], ha[j]); P6A_DOT4(isb1, U[st][1][j], hb4[j]); } \
                    int is0 = 16 * isa0 + isb0, is1 = 16 * isa1 + isb1; \
                    is0 += dppi0<0x111>(is0); is1 += dppi0<0x111>(is1); is0 += dppi0<0x112>(is0); is1 += dppi0<0x112>(is1); is0 += dppi0<0x114>(is0); is1 += dppi0<0x114>(is1); \
                    if ((lane & 7) == 7 && (base_) + 16 * st + 2 * q8 < ntot) *(LAS f32x2_*)(res + (base_) + 16 * st + 2 * q8) = (f32x2_){(float)is0, (float)is1}; } } while (0)
            v4u UA[2][2][4], UB[2][2][4]; int TA[2], TB[2];
            if (ntot > 0) P6A_LOAD(UA, TA, 0);
            if (ntot > 32) P6A_LOAD(UB, TB, 32);
            for (int base = 0; base < ntot; base += 64) {
                if (base > 0 && base + 32 < ntot) P6A_LOAD(UB, TB, base + 32);
                P6A_COMP(UA, TA, base);
                if (base + 64 < ntot) P6A_LOAD(UA, TA, base + 64);
                if (base + 32 < ntot) P6A_COMP(UB, TB, base + 32);
            }
#undef P6A_LOAD
#undef P6A_COMP
#undef P6A_DOT4
            if (fv) Wp[fo] = (bf16)f2bf(gelu_tanh(res[lane] * ftsc * fsc.x) * fg * fsc.y);
            if (fv1) Wp[fo1] = (bf16)f2bf(gelu_tanh(res[lane + 64] * ftsc1 * fsc1.x) * fg1 * fsc1.y);
            for (int idx = 128 + lane; idx < ntot; idx += 64) { const v2u ek = list[idx]; if (ek.y >> 31) continue; const f32x2_ sc = US2[ek.x]; const int tq = (int)(ek.y >> 8) & 3; const size_t o = (size_t)(m0 + tq) * 128 + (ek.y & 255u);
                Wp[o] = (bf16)f2bf(gelu_tanh(res[idx] * TSC[m0 + tq] * sc.x) * GWp[o] * sc.y); }
        }
    }
}
constexpr int P6B_RSTR = 160;
static_assert(8 * 64 * P6B_RSTR <= SCR_BYTES, "p6b lds");
DI void p6b_axpy(Frame& F, const XcdPart P) {
    int lane_ = lane_id(); asm volatile("" : "+v"(lane_));
    const int lane = lane_, c = lane & 7, g = lane >> 3;
    const unsigned short* IDX = (const unsigned short*)(F.ws + WS_IDX); const bf16* Wp = (const bf16*)(F.ws + WS_W);
    float* rowss2 = (float*)(F.ws + WS_CTL) + CW_ROWSS2;
    bf16* X2B = (bf16*)(F.ws + WS_XN) + 256;
    const bf16* X1B = (const bf16*)(F.ws + WS_X1B);
    const int wrank = P.li * NWAVES + F.wave, wstride = P.nloc * NWAVES;
    const int j4 = 4 * g;
    LAS unsigned char* redw = F.lds + F.wave * (64 * P6B_RSTR) + lane * P6B_RSTR;
    const LAS unsigned char* redr = F.lds + F.wave * (64 * P6B_RSTR) + c * P6B_RSTR + 16 * g;
    for (int s = P.v; s < 8; s += P.nx) {
        const unsigned char* Vb = (const unsigned char*)(F.ws + WS_VB8) + (size_t)(s & 3) * NEXP * 128;
        const unsigned c16 = (unsigned)c * 16u;
        const int ch = (s & 3) * 256 + 32 * c + j4;
        const int tlo = (s >> 2) * (T / 2), thi = tlo + T / 2;
#define P6B_GATHER(R, E) do { const unsigned e_[8] = {E[0].x, E[0].y, E[0].z, E[0].w, E[1].x, E[1].y, E[1].z, E[1].w}; _Pragma("unroll") for (int j = 0; j < 8; ++j) { \
            R[2 * j] = *(const v4u*)(Vb + (((e_[j] & 0xffffu) << 7) | c16)); R[2 * j + 1] = *(const v4u*)(Vb + (((e_[j] >> 16) << 7) | c16)); } } while (0)
#define P6B_TOKEN(R, W, m) do { const unsigned w_[8] = {W[0].x, W[0].y, W[0].z, W[0].w, W[1].x, W[1].y, W[1].z, W[1].w}; \
            const v2u x1w = *(const v2u*)(X1B + (size_t)(m) * DMODEL + ch);        \
            f32x2v acc[16]; _Pragma("unroll") for (int k = 0; k < 16; ++k) acc[k] = (f32x2v){0.f, 0.f}; \
            _Pragma("unroll") for (int j = 0; j < 16; ++j) { const float wj = (j & 1) ? bfhi(w_[j >> 1]) : bflo(w_[j >> 1]); const f32x2v w2 = {wj, wj}; const unsigned ua[4] = {R[j].x, R[j].y, R[j].z, R[j].w}; \
                _Pragma("unroll") for (int k = 0; k < 4; ++k) { \
                    acc[4 * k] = __builtin_elementwise_fma(w2, __builtin_amdgcn_cvt_scalef32_pk_f32_fp4(ua[k], 1.0f, 0), acc[4 * k]); acc[4 * k + 1] = __builtin_elementwise_fma(w2, __builtin_amdgcn_cvt_scalef32_pk_f32_fp4(ua[k], 1.0f, 1), acc[4 * k + 1]); \
                    acc[4 * k + 2] = __builtin_elementwise_fma(w2, __builtin_amdgcn_cvt_scalef32_pk_f32_fp4(ua[k], 1.0f, 2), acc[4 * k + 2]); acc[4 * k + 3] = __builtin_elementwise_fma(w2, __builtin_amdgcn_cvt_scalef32_pk_f32_fp4(ua[k], 1.0f, 3), acc[4 * k + 3]); } } \
            _Pragma("unroll") for (int k = 0; k < 16; ++k) *(LAS f32x2v*)(redw + 8 * k) = acc[k]; \
            f32x4 q4v = *(const LAS f32x4*)(redr); _Pragma("unroll") for (int gg = 1; gg < 8; ++gg) { const f32x4 t_ = *(const LAS f32x4*)(redr + gg * 8 * P6B_RSTR); q4v.x += t_.x; q4v.y += t_.y; q4v.z += t_.z; q4v.w += t_.w; } \
            const float q4[4] = {q4v.x, q4v.y, q4v.z, q4v.w}; \
            const float x20 = bflo(x1w.x) + q4[0], x21 = bfhi(x1w.x) + q4[1], x22 = bflo(x1w.y) + q4[2], x23 = bfhi(x1w.y) + q4[3]; \
            *(v2u*)(X2B + (size_t)(m) * 1280 + ch) = (v2u){pk2(x20, x21), pk2(x22, x23)}; \
            const float tot = wave_incl_scan(x20 * x20 + x21 * x21 + x22 * x22 + x23 * x23); \
            if (lane == 63) atomicAdd(rowss2 + (m), tot); } while (0)
#define P6B_LDE(E, tokn) do { E[0] = *(const v4u*)(IDX + (size_t)(tokn) * 128 + 16 * g); E[1] = *(const v4u*)(IDX + (size_t)(tokn) * 128 + 16 * g + 8); } while (0)
#define P6B_LDW(W, tokn) do { W[0] = *(const v4u*)(Wp + (size_t)(tokn) * 128 + 16 * g); W[1] = *(const v4u*)(Wp + (size_t)(tokn) * 128 + 16 * g + 8); } while (0)
        v4u EA[2], EB[2], RA[16], RB[16], WCA[2], WCB[2];
        const int m_0 = tlo + wrank;
        if (m_0 < thi) { P6B_LDE(EA, m_0); P6B_LDW(WCA, m_0); P6B_GATHER(RA, EA); }
        if (m_0 + wstride < thi) { P6B_LDE(EB, m_0 + wstride); P6B_LDW(WCB, m_0 + wstride); P6B_GATHER(RB, EB); }
        if (m_0 + 2 * wstride < thi) P6B_LDE(EA, m_0 + 2 * wstride);
        if (m_0 + 3 * wstride < thi) P6B_LDE(EB, m_0 + 3 * wstride);
        for (int m = m_0; m < thi; m += 2 * wstride) {
            const int mb = m + wstride;
            P6B_TOKEN(RA, WCA, m);
            if (m + 2 * wstride < thi) { P6B_GATHER(RA, EA); P6B_LDW(WCA, m + 2 * wstride); if (m + 4 * wstride < thi) P6B_LDE(EA, m + 4 * wstride); }
            if (mb < thi) { P6B_TOKEN(RB, WCB, mb);
                if (mb + 2 * wstride < thi) { P6B_GATHER(RB, EB); P6B_LDW(WCB, mb + 2 * wstride); if (mb + 4 * wstride < thi) P6B_LDE(EB, mb + 4 * wstride); } }
        }
#undef P6B_LDE
#undef P6B_LDW
#undef P6B_GATHER
#undef P6B_TOKEN
    }
}
#ifndef PH_MASK
#define PH_MASK 0xffff
#endif
#define PH(k) (PH_MASK & (1 << (k)))
#ifndef DBG_SKIP
#define DBG_SKIP 0
#endif
struct Args { const float* in[19]; float* out; unsigned char* ws; };
__global__ void __launch_bounds__(NWAVES * 64, 2) fwd_megakernel(Args args) {
    extern __shared__ __attribute__((aligned(16))) unsigned char lds[];
    Frame F;
    F.lds = (LAS unsigned char*)lds;
    F.MISC = (volatile LAS unsigned*)(F.lds + MISC_OFF);
    F.wave = __builtin_amdgcn_readfirstlane((int)threadIdx.x >> 6);
    F.G = gridDim.x; { const int bx = blockIdx.x; F.vcu = (F.G % 8 == 0) ? (bx % 8) * (F.G / 8) + bx / 8 : bx; }
    F.ws = args.ws; F.ctl = (gu32*)(args.ws + WS_CTL); F.out = args.out;
    for (int u = threadIdx.x; u < (LDS_BYTES - LDSCTL_OFF) / 4; u += NWAVES * 64) ((LAS unsigned*)(F.lds + LDSCTL_OFF))[u] = 0u;
    __syncthreads();
    XcdBarrier bar = xcd_barrier_post((unsigned*)(F.ctl + CW_BAR), F.MISC + 8, threadIdx.x == 0);
#ifdef TIMING_A
#ifndef TIMING_QUANT
#define TIMING_QUANT 50.0f
#endif
    unsigned long long ts_[16]; int nts_ = 0;
#define STAMP() do { if (nts_ < 16) ts_[nts_++] = __builtin_amdgcn_s_memrealtime(); } while (0)
#else
#define STAMP() do {} while (0)
#endif
    STAMP();
#define T0() (F.wave == 0 && lane_id() == 0)
#define GRID_BAR() do { xcd_barrier(bar, T0()); STAMP(); } while (0)
    unsigned char* ws = args.ws;
    bf16* XN = (bf16*)(ws + WS_XN); bf16* QKV = (bf16*)(ws + WS_QKV); bf16* HGB = (bf16*)(ws + WS_HG); bf16* GATE = (bf16*)(ws + WS_GATE);
    float* rowss = (float*)(ws + WS_CTL) + CW_ROWSS;

    if (PH(0)) p0_prologue(F);
    GRID_BAR();
    if (!(DBG_SKIP & 1)) {
    if (PH(1)) {   pg8::Gemm g{XN, (const bf16*)(ws + WS_WIN), T, INW, 1024, 1024, 1024}; pg8::StaticOrder S; S.init(T, INW, F.G, (int)blockIdx.x);
        pg8::EpiRoute E{QKV, HGB, GATE, I_HG_LB, I_Q_NORM, I_K_NORM, (const float*)(ws + WS_ROPE), (LAS float*)(F.lds + 131072)};
        if (F.G == 256 && (int)blockIdx.x >= 128) p0_peer_w_item(F, (int)blockIdx.x - 128);
        pg8::gemm_phase<pg8::EpiRoute, pg8::StaticOrder, true, true>(F.lds, g, S, E, F.wave); }
    GRID_BAR();
    {
        volatile LAS unsigned* qslot = F.MISC + 16;
        bool first_ = true;
        for (;;) {
            __syncthreads();
            if (!first_ && (F.wave * 64 + lane_id()) == 0) *qslot = F.G + __hip_atomic_fetch_add((unsigned*)(F.ctl + CW_QUEUE), 1u, __ATOMIC_RELAXED, __HIP_MEMORY_SCOPE_AGENT);
            __syncthreads();
            const int n = first_ ? (int)blockIdx.x : (int)__builtin_amdgcn_readfirstlane(*qslot);
            first_ = false;
            if (n >= 64 + 1024 + 256) break;
            if (n >= 64 + 1024) {
                const int c = n - (64 + 1024);
                cvt_rows_i4(F, inp(I_PEER_U), ws + WS_UB8, (float*)(ws + WS_US), 0, 64 * c, 64 * c + 64);
                cvt_rows_fp4(F, inp(I_PEER_V), ws + WS_VB8, (float*)(ws + WS_US), 1, 64 * c, 64 * c + 64);
                continue; }
#ifdef TIMING_Q
            const unsigned long long tq0_ = __builtin_amdgcn_s_memrealtime();
#endif
            if (n < 64) { if (PH(3)) hgrn_item(F, n); }
            else if (PH(4)) { attn_body::AttnUnit u; attn_body::unit_decode(n - 64, u);
                attn_body::attn_unit<8>(F.wave, u.bh / attn_body::NHEAD, u.bh % attn_body::NHEAD, u.qb, (const attn_body::bf16*)QKV, (const attn_body::bf16*)(QKV + 512), (const attn_body::bf16*)(QKV + 640), (attn_body::bf16*)F.out, (char*)lds); }
#ifdef TIMING_Q
            if (n == TIMING_Q && T0()) F.ctl[CW_QUEUE + 64] = (unsigned)(__builtin_amdgcn_s_memrealtime() - tq0_);
#endif
        }
    }
    GRID_BAR();
    if (PH(5)) p2b_ohn(F, (bf16*)F.out);
    GRID_BAR();
    if (PH(6)) {   pg8::Gemm g{(const bf16*)F.out, (const bf16*)(ws + WS_WUA), T, 1024, 1024, 1024, 1024}; pg8::StaticOrder S; S.init(T, 1024, F.G, (int)blockIdx.x);
        pg8::EpiMergeFused E{(bf16*)(ws + WS_HG), (const unsigned char*)GATE};
        pg8::gemm_phase<pg8::EpiMergeFused, pg8::StaticOrder, true, true>(F.lds, g, S, E, F.wave); }
    GRID_BAR();
    }
    if (PH(8) && !(DBG_SKIP & 1)) {
        pg8::Gemm g{(const bf16*)(ws + WS_HG), (const bf16*)(ws + WS_WOUT), T, 1024, 1024, 1024, 1024}; pg8::StaticOrder S; S.init(T, 1024, F.G, (int)blockIdx.x);
        pg8::EpiResid E{XN, (const float*)(ws + WS_GINV), (bf16*)(ws + WS_X1B), rowss};
        pg8::gemm_phase<pg8::EpiResid, pg8::StaticOrder, true, true>(F.lds, g, S, E, F.wave);
    }
    GRID_BAR();
    if (PH(9) && !(DBG_SKIP & 2)) {
        pg8::Gemm g{(const bf16*)(ws + WS_X1B), (const bf16*)(ws + WS_WPEER), T, 2048, 1024, 1024, 1024}; pg8::StaticOrder S; S.init(T, 2048, F.G, (int)blockIdx.x);
        pg8::EpiTopk E{rowss, (unsigned short*)(ws + WS_IDX), (float*)(ws + WS_GW), EPS};
        pg8::OneUnit one;
        for (int i = 0; S.next(i, one.u); ++i) pg8::gemm_phase<pg8::EpiTopk, pg8::OneUnit, false, true>(F.lds, g, one, E, F.wave);
    }
    if (PH(9)) p5_quant_h(F);
    GRID_BAR();
    {   XcdPart P; xcd_census((unsigned*)(F.ctl + CW_BAR), bar.x, P.v, P.nx, P.nloc); P.li = (int)__builtin_amdgcn_readfirstlane(F.MISC[10]);
        if (PH(10)) { const int rpb = (T + F.G - 1) / F.G; const int r0 = (int)blockIdx.x * rpb; cvt_p_rows(F, inp(I_P), (bf16*)(ws + WS_XN), r0, min(r0 + rpb, T)); }
        if (PH(10)) p6a_dots(F, P);
        GRID_BAR();
        if (PH(10)) p6b_axpy(F, P);
    }
    GRID_BAR();
    if (PH(12)) {   pg8::Gemm g{XN, (const bf16*)(ws + WS_WPG), T, 1024, 1280, 1280, 1280}; pg8::StaticOrder S; S.init(T, 1024, F.G, (int)blockIdx.x);
        pg8::EpiPleFused E{F.out, (bf16*)(ws + WS_PP), rowss + 32768, EPS, XN};
        pg8::gemm_phase<pg8::EpiPleFused, pg8::StaticOrder, true, true>(F.lds, g, S, E, F.wave); }
#ifdef TIMING_A
    GRID_BAR();
    if (blockIdx.x == 0 && (F.wave * 64 + lane_id()) == 0) {
#ifdef TIMING_Q
        const float dq_ = 4.0f * __builtin_rintf((float)__hip_atomic_load((unsigned*)(F.ctl + CW_QUEUE + 64), __ATOMIC_RELAXED, __HIP_MEMORY_SCOPE_AGENT) * (0.01f / 20.0f));
        F.out[2] += dq_;
#endif
#if TIMING_A >= 100
        const float da = (TIMING_QUANT / 20.0f) * __builtin_rintf((float)(ts_[nts_ - 1] - ts_[0]) * (0.01f / TIMING_QUANT));
#else
        const float da = (TIMING_QUANT / 5.0f) * __builtin_rintf((float)(ts_[TIMING_A + 1] - ts_[TIMING_A]) * (0.01f / TIMING_QUANT));
#endif
        F.out[0] += da;
#ifdef TIMING_B
        const float db = (float)(ts_[TIMING_B + 1] - ts_[TIMING_B]) * (0.01f / 5.0f);
        F.out[1] += db;
#endif
    }
#endif
}

extern "C" void kernel_launch(void* const* d_in, const int* in_sizes, int n_in, void* d_out, int out_size, void* d_ws, size_t ws_size, hipStream_t stream) {
    static int grid = 0;
    if (grid == 0) {
        if (n_in != 19 || out_size != T * DMODEL || ws_size < WS_END) { fprintf(stderr, "kernel_launch: unexpected shapes (n_in %d out %d ws %zu)\n", n_in, out_size, ws_size); grid = -1; return; }
        int dev = 0, cus = 0, per_cu = 0;
        if (hipGetDevice(&dev) != hipSuccess || hipDeviceGetAttribute(&cus, hipDeviceAttributeMultiprocessorCount, dev) != hipSuccess) { grid = -1; return; }
        if (hipFuncSetAttribute((const void*)fwd_megakernel, hipFuncAttributeMaxDynamicSharedMemorySize, LDS_BYTES) != hipSuccess) { fprintf(stderr, "kernel_launch: hipFuncSetAttribute failed\n"); grid = -1; return; }
        if (hipOccupancyMaxActiveBlocksPerMultiprocessor(&per_cu, (const void*)fwd_megakernel, NWAVES * 64, LDS_BYTES) != hipSuccess || per_cu < 1) fprintf(stderr, "kernel_launch: occupancy query says %d\n", per_cu);
        (void)hipGetLastError();
        grid = cus;
    }
    if (grid < 0) return;
    (void)hipMemsetAsync((char*)d_ws + WS_CTL, 0, CTL_ZERO_BYTES, stream);
    Args a{};
    for (int i = 0; i < 19; ++i) a.in[i] = (const float*)d_in[i];
    a.out = (float*)d_out; a.ws = (unsigned char*)d_ws;
    hipLaunchKernelGGL(fwd_megakernel, dim3(grid), dim3(NWAVES * 64), LDS_BYTES, stream, a);
}
```
